# Optimizing an MI355X kernel written in HIP

```python
import jax
import jax.numpy as jnp
from jax import lax
import numpy as np

D_MODEL = 1024
BATCH = 16
SEQ = 2048
DEPTH = 4

N_MIXERS = 3
D_FF = 4 * D_MODEL
N_GROUPS = 4
GROUP_DIM = D_MODEL // N_GROUPS
POOL_WINDOWS = (2, 4, 8, 16)
CONV_WIDTH = 31
CONV_PAD = CONV_WIDTH // 2
D_CONV = D_MODEL
NORM_EPS = 1e-6
LN_EPS = 1e-5
RES_SCALE = (2 * DEPTH) ** -0.5

kernel_name = 'hybrid_pool_conv_fourier_encoder'


def rms_norm(x, g):
    xf = x.astype(jnp.float32)
    y = xf * lax.rsqrt(jnp.mean(xf * xf, axis=-1, keepdims=True) + NORM_EPS)
    return (y * g.astype(jnp.float32)).astype(x.dtype)


def pool_mixer(h, w_in, w_group, scale, w_out):
    b, s, d = h.shape
    u = (h @ w_in).reshape(b, s, N_GROUPS, GROUP_DIM).astype(jnp.float32)
    csum = jnp.pad(jnp.cumsum(u, axis=1), ((0, 0), (1, 0), (0, 0), (0, 0)))
    pos = jnp.arange(s)
    groups = []
    for g, w in enumerate(POOL_WINDOWS):
        lo = jnp.clip(pos - w // 2, 0, s)
        hi = jnp.clip(pos + w // 2, 0, s)
        cnt = (hi - lo).astype(jnp.float32)[None, :, None]
        mean = (csum[:, hi, g] - csum[:, lo, g]) / cnt
        groups.append(mean - u[:, :, g])
    p = jnp.stack(groups, axis=2).astype(h.dtype)
    y = jnp.einsum('bsgc,gcd->bsgd', p, w_group).reshape(b, s, d) * scale
    return y @ w_out


def conv_module(h, w_in, dw, dw_bias, ln_g, ln_b, w_out):
    val, gate = jnp.split(h @ w_in, 2, axis=-1)
    v = val * jax.nn.sigmoid(gate)
    v = lax.conv_general_dilated(
        v, dw[:, None, :].astype(v.dtype), window_strides=(1,),
        padding=((CONV_PAD, CONV_PAD),),
        dimension_numbers=('NWC', 'WIO', 'NWC'),
        feature_group_count=D_CONV) + dw_bias
    vf = v.astype(jnp.float32)
    mu = jnp.mean(vf, axis=-1, keepdims=True)
    var = jnp.mean(jnp.square(vf - mu), axis=-1, keepdims=True)
    vn = (vf - mu) * lax.rsqrt(var + LN_EPS) * ln_g.astype(jnp.float32) + ln_b.astype(jnp.float32)
    return jax.nn.silu(vn).astype(h.dtype) @ w_out


def fourier_mixer(h, w_in, w_out):
    b, s, d = h.shape
    u = (h @ w_in).reshape(b, s, N_GROUPS, GROUP_DIM).astype(jnp.float32)
    f = jnp.fft.fft2(u, axes=(1, 3), norm='ortho').real
    return f.reshape(b, s, d).astype(h.dtype) @ w_out


def sq_relu_mlp(h, w_up, w_down):
    a = jax.nn.relu(h @ w_up)
    return (a * a) @ w_down


def setup_inputs(seed: int = 0) -> dict:
    key = jax.random.key(seed)
    keys = iter(jax.random.split(key, 64))
    f32 = jnp.float32

    def dense(shape, fan_in, scale=1.0):
        return jax.random.normal(next(keys), shape, f32) * (scale * fan_in ** -0.5)

    def gain(n):
        return 1.0 + 0.02 * jax.random.normal(next(keys), (n,), f32)

    def bias(n):
        return 0.02 * jax.random.normal(next(keys), (n,), f32)

    inp = {'x': jax.random.normal(next(keys), (BATCH, SEQ, D_MODEL), f32)}

    def mlp_params(i):
        inp[f'l{i}_norm_mlp'] = gain(D_MODEL)
        inp[f'l{i}_mlp_up'] = dense((D_MODEL, D_FF), D_MODEL)
        inp[f'l{i}_mlp_down'] = dense((D_FF, D_MODEL), D_FF, RES_SCALE)

    def pool_params(i):
        inp[f'l{i}_norm_mix'] = gain(D_MODEL)
        inp[f'l{i}_pool_w_in'] = dense((D_MODEL, D_MODEL), D_MODEL)
        inp[f'l{i}_pool_w_group'] = dense((N_GROUPS, GROUP_DIM, GROUP_DIM), GROUP_DIM)
        inp[f'l{i}_pool_scale'] = gain(D_MODEL)
        inp[f'l{i}_pool_w_out'] = dense((D_MODEL, D_MODEL), D_MODEL, RES_SCALE)
        mlp_params(i)

    def conv_params(i):
        inp[f'l{i}_norm_mix'] = gain(D_MODEL)
        inp[f'l{i}_conv_w_in'] = dense((D_MODEL, 2 * D_CONV), D_MODEL)
        inp[f'l{i}_conv_dw'] = dense((CONV_WIDTH, D_CONV), CONV_WIDTH)
        inp[f'l{i}_conv_dw_bias'] = bias(D_CONV)
        inp[f'l{i}_conv_ln_g'] = gain(D_CONV)
        inp[f'l{i}_conv_ln_b'] = bias(D_CONV)
        inp[f'l{i}_conv_w_out'] = dense((D_CONV, D_MODEL), D_CONV, RES_SCALE)
        mlp_params(i)

    def fourier_params(i):
        inp[f'l{i}_norm_mix'] = gain(D_MODEL)
        inp[f'l{i}_fourier_w_in'] = dense((D_MODEL, D_MODEL), D_MODEL)
        inp[f'l{i}_fourier_w_out'] = dense((D_MODEL, D_MODEL), D_MODEL, RES_SCALE)
        mlp_params(i)

    pool_params(0)
    conv_params(1)
    fourier_params(2)
    pool_params(3)
    inp['final_norm'] = gain(D_MODEL)
    return inp


def reference(x,
              l0_norm_mix, l0_pool_w_in, l0_pool_w_group, l0_pool_scale, l0_pool_w_out,
              l0_norm_mlp, l0_mlp_up, l0_mlp_down,
              l1_norm_mix, l1_conv_w_in, l1_conv_dw, l1_conv_dw_bias, l1_conv_ln_g, l1_conv_ln_b,
              l1_conv_w_out, l1_norm_mlp, l1_mlp_up, l1_mlp_down,
              l2_norm_mix, l2_fourier_w_in, l2_fourier_w_out,
              l2_norm_mlp, l2_mlp_up, l2_mlp_down,
              l3_norm_mix, l3_pool_w_in, l3_pool_w_group, l3_pool_scale, l3_pool_w_out,
              l3_norm_mlp, l3_mlp_up, l3_mlp_down,
              final_norm):
    mixers = (
        lambda h: pool_mixer(h, l0_pool_w_in, l0_pool_w_group, l0_pool_scale, l0_pool_w_out),
        lambda h: conv_module(h, l1_conv_w_in, l1_conv_dw, l1_conv_dw_bias, l1_conv_ln_g,
                              l1_conv_ln_b, l1_conv_w_out),
        lambda h: fourier_mixer(h, l2_fourier_w_in, l2_fourier_w_out),
        lambda h: pool_mixer(h, l3_pool_w_in, l3_pool_w_group, l3_pool_scale, l3_pool_w_out),
    )
    norm_mix = (l0_norm_mix, l1_norm_mix, l2_norm_mix, l3_norm_mix)
    norm_mlp = (l0_norm_mlp, l1_norm_mlp, l2_norm_mlp, l3_norm_mlp)
    mlp_up = (l0_mlp_up, l1_mlp_up, l2_mlp_up, l3_mlp_up)
    mlp_down = (l0_mlp_down, l1_mlp_down, l2_mlp_down, l3_mlp_down)
    for i in range(DEPTH):
        x = x + mixers[i](rms_norm(x, norm_mix[i]))
        x = x + sq_relu_mlp(rms_norm(x, norm_mlp[i]), mlp_up[i], mlp_down[i])
    return rms_norm(x, final_norm)
```

```cpp
#include <hip/hip_runtime.h>
#include <hip/hip_cooperative_groups.h>
#include <cstdio>
#include <cstdint>
namespace cg = cooperative_groups;

#define LAS __attribute__((address_space(3)))
typedef unsigned short bf16_t;
typedef short bf16x8 __attribute__((ext_vector_type(8)));
typedef float f32x4 __attribute__((ext_vector_type(4)));
typedef float f32x2 __attribute__((ext_vector_type(2)));
typedef unsigned u32x4 __attribute__((ext_vector_type(4)));
typedef unsigned u32x2 __attribute__((ext_vector_type(2)));

constexpr int NB = 16, S = 2048, D = 1024, M = NB * S, FF = 4096;
constexpr float NORM_EPS = 1e-6f, LN_EPS = 1e-5f;
constexpr size_t MiB = 1u << 20;
constexpr size_t WS_ROWSQ = 1 * MiB;
constexpr size_t WS_DCS = 3 * MiB;
constexpr size_t WS_T = 4 * MiB;
constexpr size_t WS_WUP = 20 * MiB;
constexpr size_t WS_WDN = 28 * MiB;
constexpr size_t WS_MIX = 84 * MiB;
constexpr size_t WS_MIXB = 104 * MiB;
constexpr size_t WS_XB = 116 * MiB;
constexpr size_t WS_H = 180 * MiB;
constexpr size_t WS_ACT1 = WS_H, WS_ACT2 = WS_H + 64 * MiB, WS_YT = WS_H + 128 * MiB, WS_ACT3 = WS_H + 128 * MiB;
constexpr size_t WS_END = WS_H + 256 * MiB;
constexpr int LDS_BYTES = 147456;

__device__ __forceinline__ unsigned cvt_pk_bf16(float lo, float hi) { unsigned r; asm volatile("v_cvt_pk_bf16_f32 %0, %1, %2" : "=v"(r) : "v"(lo), "v"(hi)); return r; }
__device__ __forceinline__ float bflo(unsigned w) { return __uint_as_float(w << 16); }
__device__ __forceinline__ float bfhi(unsigned w) { return __uint_as_float(w & 0xffff0000u); }

namespace pg8 {
constexpr int BM = 256, BK = 64, HALF = 128, HTB = HALF * BK * 2, STAGE_BYTES = 8 * HTB, NXCD = 8, WGM = 8;
__host__ __device__ __forceinline__ int lds_byte(int r, int c) { const int st = (r >> 4) * 2 + (c >> 5), rr = r & 15, cc = c & 31, ob = rr * 64 + cc * 2; return st * 1024 + (ob ^ (((ob >> 9) & 1) << 5)); }
__host__ __device__ __forceinline__ void stage_rc(int b, int& R, int& C) { const int st = b / 1024, sb = b % 1024, swz = sb ^ (((sb >> 9) & 1) << 5); R = (st >> 1) * 16 + swz / 64; C = (st & 1) * 32 + (swz % 64) / 2; }
__host__ __device__ __forceinline__ int perm32(int rho) { const int n = rho >> 4, i = rho & 15; return 8 * (i >> 2) + 4 * n + (i & 3); }

struct Unit { long aoff, boff; int row0, col0; };
struct Gemm { const bf16_t* A; const bf16_t* Bt; int lda, ldb, K; };

struct Order {
    int mode, nM, nN, nwg, G, c, lda, ldb; long a_pn_bytes;
    __device__ __forceinline__ void init(int mode_, int Mr, int Nc, int G_, int c_, int lda_, int ldb_, long apn) { mode = mode_; nM = Mr / BM; nN = Nc / BM; nwg = nM * nN; G = G_; c = c_; lda = lda_; ldb = ldb_; a_pn_bytes = apn; }
    __device__ __forceinline__ bool next(int i, Unit& u) const {
        const long L = (long)i * G + c; if (L >= nwg) return false;
        if (mode == 0) {
            int wgid = (int)L; { const int q = nwg / NXCD, r = nwg % NXCD, xcd = wgid % NXCD, off = wgid / NXCD; wgid = (xcd < r ? xcd * (q + 1) : r * (q + 1) + (xcd - r) * q) + off; }
            const int nig = WGM * nN, gid = wgid / nig, fm = gid * WGM, gsz = (nM - fm) < WGM ? (nM - fm) : WGM;
            const int pm = fm + ((wgid % nig) % gsz), pn = (wgid % nig) / gsz;
            u.aoff = (long)pm * BM * lda * 2 + (long)pn * a_pn_bytes; u.boff = (long)pn * BM * ldb * 2; u.row0 = pm * BM; u.col0 = pn * BM;
        } else if (mode == 1) {
            const int w = (int)L, cs = w & 1, pt = (w >> 1) & 7, g = (w >> 4) & 3, b = w >> 6;
            u.aoff = (long)cs * 256 * 256 * 2; u.boff = ((long)(b * S + pt * 256) * D + g * 256) * 2; u.row0 = b * 1024 + g * 256; u.col0 = cs * 2048 + pt * 256;
        } else {
            int b, pm, pn;
            if (G == 256) { const int xcd = c & 7, loc = c >> 3; b = i * 8 + xcd; pm = loc & 7; pn = loc >> 3; }
            else { const int w = (int)L; b = w >> 5; pm = w & 7; pn = (w >> 3) & 3; }
            u.aoff = (long)pm * 256 * 4096 * 2; u.boff = ((long)b * 1024 + pn * 256) * 4096 * 2; u.row0 = b * S + pm * 256; u.col0 = pn * 256;
        }
        return true;
    }
};

__device__ __forceinline__ float row_rstd(const float* rowsq, int row) {
    const f32x4* q = (const f32x4*)(rowsq + (size_t)row * 16);
    const f32x4 a = q[0], b = q[1], c = q[2], d = q[3];
    const f32x4 s = (a + b) + (c + d);
    const float t = (s[0] + s[1]) + (s[2] + s[3]);
    return __builtin_amdgcn_rsqf(t * (1.0f / D) + NORM_EPS);
}
template <int ACT> struct EpiBf16 {
    static constexpr bool PERM = true;
    bf16_t* O; int ldc; const float* rowsq; float post;
    __device__ __forceinline__ void operator()(const f32x4 (&acc)[2][2][4][2], const Unit& u, int wr, int wc, int fr, int fq) const {
        const int row0 = u.row0 + wr * 64 + fr;
        const int col0 = (ACT == 2 ? (u.col0 >> 1) : u.col0) + wc * 32 + 8 * fq;
#pragma unroll
        for (int ai = 0; ai < 2; ++ai)
#pragma unroll
            for (int m = 0; m < 4; ++m) {
                const int row = row0 + ai * HALF + m * 16;
                float sc = post; if (rowsq) sc *= row_rstd(rowsq, row);
                bf16_t* rowp = O + (size_t)row * ldc + col0;
                if (ACT == 2) {
                    f32x4 v0 = acc[ai][0][m][0] * sc, v1 = acc[ai][0][m][1] * sc, g0 = acc[ai][1][m][0] * sc, g1 = acc[ai][1][m][1] * sc;
#pragma unroll
                    for (int i = 0; i < 4; ++i) {
                        v0[i] = v0[i] * __builtin_amdgcn_rcpf(1.0f + __builtin_amdgcn_exp2f(-1.44269504089f * g0[i]));
                        v1[i] = v1[i] * __builtin_amdgcn_rcpf(1.0f + __builtin_amdgcn_exp2f(-1.44269504089f * g1[i])); }
                    u32x4 w; w.x = cvt_pk_bf16(v0[0], v0[1]); w.y = cvt_pk_bf16(v0[2], v0[3]); w.z = cvt_pk_bf16(v1[0], v1[1]); w.w = cvt_pk_bf16(v1[2], v1[3]);
                    *(u32x4*)rowp = w;
                } else {
#pragma unroll
                    for (int bj = 0; bj < 2; ++bj) {
                        f32x4 v0 = acc[ai][bj][m][0] * sc, v1 = acc[ai][bj][m][1] * sc;
                        if (ACT == 1) {
#pragma unroll
                            for (int i = 0; i < 4; ++i) { const float a = fmaxf(v0[i], 0.f), b = fmaxf(v1[i], 0.f); v0[i] = a * a; v1[i] = b * b; } }
                        u32x4 w; w.x = cvt_pk_bf16(v0[0], v0[1]); w.y = cvt_pk_bf16(v0[2], v0[3]); w.z = cvt_pk_bf16(v1[0], v1[1]); w.w = cvt_pk_bf16(v1[2], v1[3]);
                        *(u32x4*)(rowp + bj * HALF) = w; }
                }
                asm volatile("" ::: "memory");
            }
    }
};
struct EpiRes {
    static constexpr bool PERM = false;
    const float* base; float* out; bf16_t* xb; float* rowsq;
    __device__ __forceinline__ void operator()(const f32x4 (&acc)[2][2][4][2], const Unit& u, int wr, int wc, int fr, int fq) const {
        const int colb = u.col0 + wc * 32 + 4 * fq, slot = (u.col0 >> 8) * 4 + wc;
#pragma unroll
        for (int ai = 0; ai < 2; ++ai)
#pragma unroll
            for (int m = 0; m < 4; ++m) {
                const int row = u.row0 + ai * HALF + wr * 64 + m * 16 + fr; const size_t off = (size_t)row * D + colb; float ss = 0.f;
#pragma unroll
                for (int bj = 0; bj < 2; ++bj)
#pragma unroll
                    for (int n = 0; n < 2; ++n) {
                        const f32x4 bs = *(const f32x4*)(base + off + bj * HALF + n * 16); const f32x4 o = bs + acc[ai][bj][m][n];
                        *(f32x4*)(out + off + bj * HALF + n * 16) = o; ss += (o[0] * o[0] + o[1] * o[1]) + (o[2] * o[2] + o[3] * o[3]);
                        u32x2 w; w.x = cvt_pk_bf16(o[0], o[1]); w.y = cvt_pk_bf16(o[2], o[3]); *(u32x2*)(xb + off + bj * HALF + n * 16) = w; }
                ss += __shfl_xor(ss, 16); ss += __shfl_xor(ss, 32);
                if (fq == 0) rowsq[(size_t)row * 16 + slot] = ss;
                asm volatile("" ::: "memory");
            }
    }
};

template <class Epi>
__device__ __forceinline__ void gemm_phase(LAS unsigned char* lds, const Gemm g, const Order& S, const Epi& E) {
    int tid_ = threadIdx.x; asm volatile("" : "+v"(tid_));
    const int tid = tid_, wid = __builtin_amdgcn_readfirstlane(tid >> 6), lane = tid & 63, wr = wid >> 2, wc = wid & 3, fr = lane & 15, fq = lane >> 4;
    const int K = g.K, nt = K / BK;
    unsigned voffA[2], voffB[2];
#pragma unroll
    for (int i = 0; i < 2; ++i) { int R, C; stage_rc(tid * 16 + i * 8192, R, C); const int Rb = Epi::PERM ? ((R & ~31) + perm32(R & 31)) : R;
        voffA[i] = (unsigned)(R * g.lda + C) * 2u; voffB[i] = (unsigned)(Rb * g.ldb + C) * 2u; }
    const size_t kstep = (size_t)(BK * 2);
    const size_t hstepA = (size_t)HALF * g.lda * 2, hstepB = (size_t)HALF * g.ldb * 2;
    const unsigned ldsw = (unsigned)wid * 1024u;
    const int aoff = lds_byte(wr * 64 + fr, fq * 8), boff = lds_byte(wc * 32 + fr, fq * 8);
#define PG8_SA(b, h) (((b) * 2 + (h)) * HTB)
#define PG8_SB(b, h) ((4 + (b) * 2 + (h)) * HTB)
#define PG8_STAGE(bufoff, gbase, voff) do { _Pragma("unroll") for (int _i = 0; _i < 2; ++_i) \
        __builtin_amdgcn_global_load_lds((const unsigned*)((const char*)(gbase) + (voff)[_i]), (LAS unsigned*)(lds + (bufoff) + ldsw + _i * 8192), 16, 0, 0); } while (0)
#define PG8_LDA(dst, b, h) do { _Pragma("unroll") for (int m = 0; m < 4; ++m) _Pragma("unroll") for (int k = 0; k < 2; ++k) dst[m][k] = *(const LAS bf16x8*)(lds + PG8_SA(b, h) + aoff + m * 2048 + k * 1024); } while (0)
#define PG8_LDB(dst, b, h) do { _Pragma("unroll") for (int n = 0; n < 2; ++n) _Pragma("unroll") for (int k = 0; k < 2; ++k) dst[n][k] = *(const LAS bf16x8*)(lds + PG8_SB(b, h) + boff + n * 2048 + k * 1024); } while (0)
#define PG8_MMA(ai, bj, At, Bt) do { __builtin_amdgcn_s_setprio(1); _Pragma("unroll") for (int m = 0; m < 4; ++m) _Pragma("unroll") for (int n = 0; n < 2; ++n) _Pragma("unroll") for (int k = 0; k < 2; ++k) \
        acc[ai][bj][m][n] = __builtin_amdgcn_mfma_f32_16x16x32_bf16(Bt[n][k], At[m][k], acc[ai][bj][m][n], 0, 0, 0); __builtin_amdgcn_s_setprio(0); } while (0)
#define PG8_WAIT_V(n) asm volatile("s_waitcnt vmcnt(" #n ")" ::: "memory")
#define PG8_WAIT_L(n) asm volatile("s_waitcnt lgkmcnt(" #n ")" ::: "memory")
#define PG8_BAR __builtin_amdgcn_s_barrier()
#define PG8_SCHED __builtin_amdgcn_sched_barrier(0)
    Unit cur, nxt; int ui = 0;
    if (!S.next(0, cur)) return;
    f32x4 acc[2][2][4][2];
#pragma unroll
    for (int a = 0; a < 2; ++a)
#pragma unroll
        for (int b = 0; b < 2; ++b)
#pragma unroll
            for (int m = 0; m < 4; ++m)
#pragma unroll
                for (int n = 0; n < 2; ++n) acc[a][b][m][n] = (f32x4){0.f, 0.f, 0.f, 0.f};
    bf16x8 At[4][2], B0[2][2], B1[2][2];
    const char* cA = (const char*)g.A + cur.aoff; const char* cB = (const char*)g.Bt + cur.boff;
    PG8_STAGE(PG8_SB(0, 0), cB, voffB); PG8_STAGE(PG8_SB(0, 1), cB + hstepB, voffB); PG8_STAGE(PG8_SA(0, 0), cA, voffA); PG8_STAGE(PG8_SA(0, 1), cA + hstepA, voffA);
    if (wr == 1) PG8_BAR;
    PG8_WAIT_V(2); PG8_BAR;
    PG8_STAGE(PG8_SB(1, 0), cB + kstep, voffB); PG8_STAGE(PG8_SA(1, 0), cA + kstep, voffA); PG8_STAGE(PG8_SB(1, 1), cB + hstepB + kstep, voffB);
    PG8_WAIT_V(6); PG8_BAR;
    for (;;) {
        const bool has_next = S.next(ui + 1, nxt);
        const char* nA = has_next ? (const char*)g.A + nxt.aoff : cA; const char* nB = has_next ? (const char*)g.Bt + nxt.boff : cB;
        for (int t = 0; t < nt; t += 2) {
            const bool last = (t == nt - 2);
            const char* a1 = cA + (size_t)(t + 1) * kstep;
            const char* a2 = last ? nA : cA + (size_t)(t + 2) * kstep; const char* b2 = last ? nB : cB + (size_t)(t + 2) * kstep;
            const char* a3 = a2 + kstep; const char* b3 = b2 + kstep;
            PG8_LDB(B0, 0, 0); PG8_LDB(B1, 0, 1); PG8_SCHED; PG8_LDA(At, 0, 0); PG8_STAGE(PG8_SA(1, 1), a1 + hstepA, voffA);
            PG8_WAIT_V(8); PG8_WAIT_L(0); PG8_BAR; PG8_MMA(0, 0, At, B0); PG8_MMA(0, 1, At, B1); PG8_BAR; PG8_SCHED;
            PG8_LDA(At, 0, 1); PG8_STAGE(PG8_SB(0, 0), b2, voffB); PG8_STAGE(PG8_SB(0, 1), b2 + hstepB, voffB); PG8_STAGE(PG8_SA(0, 0), a2, voffA);
            PG8_WAIT_V(8); PG8_WAIT_L(0); PG8_BAR; PG8_MMA(1, 0, At, B0); PG8_MMA(1, 1, At, B1); PG8_BAR; PG8_SCHED;
            PG8_LDB(B0, 1, 0); PG8_LDB(B1, 1, 1); PG8_SCHED; PG8_LDA(At, 1, 0); PG8_STAGE(PG8_SA(0, 1), a2 + hstepA, voffA);
            PG8_WAIT_V(8); PG8_WAIT_L(0); PG8_BAR; PG8_MMA(0, 0, At, B0); PG8_MMA(0, 1, At, B1); PG8_BAR; PG8_SCHED;
            PG8_LDA(At, 1, 1); PG8_STAGE(PG8_SB(1, 0), b3, voffB); PG8_STAGE(PG8_SB(1, 1), b3 + hstepB, voffB); PG8_STAGE(PG8_SA(1, 0), a3, voffA);
            PG8_WAIT_V(8); PG8_WAIT_L(0); PG8_BAR; PG8_MMA(1, 0, At, B0); PG8_MMA(1, 1, At, B1); PG8_BAR; PG8_SCHED;
        }
        if (wr == 0) PG8_BAR;
        E(acc, cur, wr, wc, fr, fq);
        if (!has_next) break;
#pragma unroll
        for (int a = 0; a < 2; ++a)
#pragma unroll
            for (int b = 0; b < 2; ++b)
#pragma unroll
                for (int m = 0; m < 4; ++m)
#pragma unroll
                    for (int n = 0; n < 2; ++n) acc[a][b][m][n] = (f32x4){0.f, 0.f, 0.f, 0.f};
        cur = nxt; cA = nA; cB = nB; ++ui;
        if (wr == 1) PG8_BAR;
    }
    PG8_WAIT_V(0);
    PG8_BAR;
#undef PG8_SA
#undef PG8_SB
#undef PG8_STAGE
#undef PG8_LDA
#undef PG8_LDB
#undef PG8_MMA
#undef PG8_WAIT_V
#undef PG8_WAIT_L
#undef PG8_BAR
#undef PG8_SCHED
}
}

struct Frame { LAS unsigned char* lds; int G, bid; };
#define OPAQUE_TID() int tid_ = threadIdx.x; asm volatile("" : "+v"(tid_)); const int tid = tid_, lane = tid & 63, wave = __builtin_amdgcn_readfirstlane(tid >> 6); (void)lane; (void)wave
__device__ __forceinline__ float wave_sum(float v) {
#pragma unroll
    for (int o = 1; o < 64; o <<= 1) v += __shfl_xor(v, o);
    return v;
}
#define LDS_WAIT() asm volatile("s_waitcnt lgkmcnt(0)" ::: "memory")

__device__ __forceinline__ void transpose_item(const float* W, int K, int N, bf16_t* WT, int ldt, const float* kscale, const float* nscale, bool glu, LAS float* scr, int item, int lane) {
    const int nblk = N / 32, kb = item / nblk, nb = item % nblk, k0 = 64 * kb, n0 = 32 * nb;
    const float ns = nscale ? nscale[n0 + (lane & 31)] : 1.0f;
#pragma unroll 8
    for (int i = 0; i < 32; ++i) { const int kk = 2 * i + (lane >> 5); const float ks = kscale ? kscale[k0 + kk] : 1.0f; scr[kk * 33 + (lane & 31)] = W[(size_t)(k0 + kk) * N + n0 + (lane & 31)] * ks * ns; }
    LDS_WAIT(); asm volatile("" ::: "memory");
    int r0 = n0; if (glu) { const int c = n0 & 1023, gate = n0 >> 10; r0 = (c >> 7) * 256 + gate * 128 + (c & 127); }
    const int c = lane & 7;
#pragma unroll
    for (int j = 0; j < 4; ++j) { const int n = (lane >> 3) + 8 * j; const LAS float* s = scr + (8 * c) * 33 + n;
        u32x4 o; o.x = cvt_pk_bf16(s[0 * 33], s[1 * 33]); o.y = cvt_pk_bf16(s[2 * 33], s[3 * 33]); o.z = cvt_pk_bf16(s[4 * 33], s[5 * 33]); o.w = cvt_pk_bf16(s[6 * 33], s[7 * 33]);
        *(u32x4*)(WT + (size_t)(r0 + n) * ldt + k0 + 8 * c) = o; }
    LDS_WAIT(); asm volatile("" ::: "memory");
}

struct Args { const float* in[34]; float* out; unsigned char* ws; };

__device__ __forceinline__ void prep_phase(const Frame& F, const Args& a) {
    OPAQUE_TID();
    unsigned char* ws = a.ws;
    LAS float* scr = (LAS float*)(F.lds + wave * 16384);
    const int gw = F.bid * 8 + wave, NGW = F.G * 8;
    constexpr int I_SQ = (D / 64) * (D / 32), I_UP = (D / 64) * (FF / 32), I_DN = (FF / 64) * (D / 32), I_GRP = 4 * (256 / 64) * (256 / 32), I_CIN = (D / 64) * (2 * D / 32);
    constexpr int I_MLP = I_UP + I_DN;
    constexpr int I_POOL = 2 * I_SQ + I_GRP + I_MLP, I_CONV = I_CIN + I_SQ + I_MLP, I_FOUR = 2 * I_SQ + I_MLP;
    constexpr int NITEMS = 2 * I_POOL + I_CONV + I_FOUR;
#define JOB(W, K_, N_, DST, LDT, KS, NS, GLU) if (r < ((K_) / 64) * ((N_) / 32)) { transpose_item((W), (K_), (N_), (bf16_t*)(DST), (LDT), (KS), (NS), (GLU), scr, r, lane); continue; } r -= ((K_) / 64) * ((N_) / 32);
#define JOB_MLP(L, i0) JOB(a.in[(i0) + 1], D, FF, ws + WS_WUP + (L) * 16 * MiB, D, a.in[(i0)], nullptr, false) \
                       JOB(a.in[(i0) + 2], FF, D, ws + WS_WDN + (L) * 16 * MiB, FF, nullptr, nullptr, false)
#define JOB_POOL(L, i0) JOB(a.in[(i0) + 1], D, D, ws + WS_MIX + (L) * 5 * MiB, D, a.in[(i0)], nullptr, false) \
                        if (r < I_GRP) { const int g = r / (I_GRP / 4); transpose_item(a.in[(i0) + 2] + g * 65536, 256, 256, (bf16_t*)(ws + WS_MIXB + (L) * 3 * MiB) + g * 65536, 256, nullptr, a.in[(i0) + 3] + g * 256, false, scr, r % (I_GRP / 4), lane); continue; } r -= I_GRP; \
                        JOB(a.in[(i0) + 4], D, D, ws + WS_MIXB + (L) * 3 * MiB + MiB, D, nullptr, nullptr, false) \
                        JOB_MLP(L, (i0) + 5)
    for (int it = gw; it < NITEMS; it += NGW) {
        int r = it;
        JOB_POOL(0, 1)
        JOB(a.in[10], D, 2 * D, ws + WS_MIX + 1 * 5 * MiB, D, a.in[9], nullptr, true)
        JOB(a.in[15], D, D, ws + WS_MIXB + 1 * 3 * MiB + MiB, D, nullptr, nullptr, false)
        JOB_MLP(1, 16)
        JOB(a.in[20], D, D, ws + WS_MIX + 2 * 5 * MiB, D, a.in[19], nullptr, false)
        JOB(a.in[21], D, D, ws + WS_MIXB + 2 * 3 * MiB + MiB, D, nullptr, nullptr, false)
        JOB_MLP(2, 22)
        JOB_POOL(3, 25)
    }
#undef JOB
#undef JOB_MLP
#undef JOB_POOL
    {
        const float* x = a.in[0]; bf16_t* XB = (bf16_t*)(ws + WS_XB); float* rowsq = (float*)(ws + WS_ROWSQ);
        for (int m = gw; m < M; m += NGW) {
            const f32x4* xr = (const f32x4*)(x + (size_t)m * D) + lane; f32x4 v[4]; float s = 0.f;
#pragma unroll
            for (int j = 0; j < 4; ++j) { v[j] = xr[64 * j]; s += (v[j][0] * v[j][0] + v[j][1] * v[j][1]) + (v[j][2] * v[j][2] + v[j][3] * v[j][3]); }
            s = wave_sum(s);
            u32x2* o8 = (u32x2*)(XB + (size_t)m * D) + lane;
#pragma unroll
            for (int j = 0; j < 4; ++j) { u32x2 w; w.x = cvt_pk_bf16(v[j][0], v[j][1]); w.y = cvt_pk_bf16(v[j][2], v[j][3]); o8[64 * j] = w; }
            if (lane < 16) rowsq[(size_t)m * 16 + lane] = (lane == 0) ? s : 0.f;
        }
    }
    {
        const int gt = F.bid * 512 + tid, GT = F.G * 512;
        bf16_t* Dcs = (bf16_t*)(ws + WS_DCS); bf16_t* T = (bf16_t*)(ws + WS_T);
        for (int it = gt; it < 2 * 256 * 256 / 8; it += GT) {
            const int e0 = it * 8, cs = e0 >> 16, j = (e0 >> 8) & 255, c0 = e0 & 255; float v[8];
#pragma unroll
            for (int k = 0; k < 8; ++k) { const float xx = (float)((j * (c0 + k)) & 255) * (1.0f / 128.0f); v[k] = (cs ? sinpif(xx) : cospif(xx)) * 0.0625f; }
            u32x4 w; w.x = cvt_pk_bf16(v[0], v[1]); w.y = cvt_pk_bf16(v[2], v[3]); w.z = cvt_pk_bf16(v[4], v[5]); w.w = cvt_pk_bf16(v[6], v[7]);
            *(u32x4*)(Dcs + e0) = w;
        }
        for (int it = gt; it < 2048 * 4096 / 8; it += GT) {
            const int e0 = it * 8, p = e0 >> 12, q = e0 & 4095, cs = q >> 11, s0 = q & 2047; float v[8];
#pragma unroll
            for (int k = 0; k < 8; ++k) { const float xx = (float)((p * (s0 + k)) & 2047) * (1.0f / 1024.0f); v[k] = (cs ? -sinpif(xx) : cospif(xx)) * 0.03125f; }
            u32x4 w; w.x = cvt_pk_bf16(v[0], v[1]); w.y = cvt_pk_bf16(v[2], v[3]); w.z = cvt_pk_bf16(v[4], v[5]); w.w = cvt_pk_bf16(v[6], v[7]);
            *(u32x4*)(T + e0) = w;
        }
    }
}

__device__ __forceinline__ void pool_phase(const Frame& F, const bf16_t* U, bf16_t* P) {
    OPAQUE_TID();
    const int gt = F.bid * 512 + tid, GT = F.G * 512;
    for (int it = gt; it < M * 128; it += GT) {
        const int row = it >> 7, ch = it & 127, g = ch >> 5, hw = 1 << g, s = row & (S - 1);
        const int lo = (s - hw) > 0 ? (s - hw) : 0, hi = (s + hw) < S ? (s + hw) : S;
        const bf16_t* base = U + (size_t)(row - s) * D + ch * 8;
        float a[8];
#pragma unroll
        for (int k = 0; k < 8; ++k) a[k] = 0.f;
        for (int t = lo; t < hi; ++t) { const u32x4 w = *(const u32x4*)(base + (size_t)t * D);
#pragma unroll
            for (int k = 0; k < 4; ++k) { a[2 * k] += bflo(w[k]); a[2 * k + 1] += bfhi(w[k]); } }
        const u32x4 c = *(const u32x4*)(base + (size_t)s * D);
        const float inv = 1.0f / (float)(hi - lo);
        u32x4 o;
#pragma unroll
        for (int k = 0; k < 4; ++k) o[k] = cvt_pk_bf16(a[2 * k] * inv - bflo(c[k]), a[2 * k + 1] * inv - bfhi(c[k]));
        *(u32x4*)(P + (size_t)row * D + ch * 8) = o;
    }
}

__device__ __forceinline__ void conv_phase(const Frame& F, const bf16_t* V, bf16_t* Aout, const float* dw, const float* dwb, const float* lng, const float* lnb) {
    OPAQUE_TID();
    f32x2 wv[31];
    { const float* p = dw + 2 * tid;
#pragma unroll
      for (int j = 0; j < 31; ++j) { wv[j] = *(const f32x2*)p; p += D; if ((j & 3) == 3) asm volatile("" ::: "memory"); } }
    const f32x2 bb = *(const f32x2*)(dwb + 2 * tid), gg = *(const f32x2*)(lng + 2 * tid), lb = *(const f32x2*)(lnb + 2 * tid);
    constexpr int TILE_BYTES = 46 * D * 2;
    LAS unsigned char* tl = F.lds;
    LAS float* part = (LAS float*)(F.lds + 98304);
    LAS float* stat = (LAS float*)(F.lds + 98304 + 1024);
    for (int tile = F.bid; tile < M / 16; tile += F.G) {
        const int r0 = tile * 16, s0 = r0 & (S - 1);
        const char* tb = (const char*)V + ((long)r0 - 15) * (D * 2);
#pragma unroll
        for (int i = 0; i < 12; ++i) {
            const int q = i * 8 + wave;
            if (q < TILE_BYTES / 1024) {
                const int t = s0 - 15 + (q >> 1);
                if (t >= 0 && t < S) __builtin_amdgcn_global_load_lds((const unsigned*)(tb + q * 1024 + lane * 16), (LAS unsigned*)(tl + q * 1024), 16, 0, 0);
                else *(LAS u32x4*)(tl + q * 1024 + lane * 16) = (u32x4){0u, 0u, 0u, 0u};
            }
        }
        asm volatile("s_waitcnt vmcnt(0) lgkmcnt(0)" ::: "memory");
        __syncthreads();
#pragma unroll 1
        for (int h = 0; h < 2; ++h) {
            const LAS unsigned char* tlh = tl + h * 8 * (D * 2) + tid * 4;
            f32x2 av[8];
#pragma unroll
            for (int o = 0; o < 8; ++o) av[o] = bb;
#pragma unroll
            for (int tt = 0; tt < 38; ++tt) {
                const unsigned w = *(const LAS unsigned*)(tlh + tt * (D * 2));
                const f32x2 xv = (f32x2){bflo(w), bfhi(w)};
#pragma unroll
                for (int o = 0; o < 8; ++o) { const int j = tt - o; if (j >= 0 && j <= 30) av[o] = __builtin_elementwise_fma(xv, wv[j], av[o]); }
                if ((tt & 7) == 7) asm volatile("" ::: "memory");
            }
            float vals[16];
#pragma unroll
            for (int o = 0; o < 8; ++o) { vals[o] = av[o][0] + av[o][1]; vals[8 + o] = av[o][0] * av[o][0] + av[o][1] * av[o][1]; }
#pragma unroll
            for (int step = 0; step < 4; ++step) {
                const int half = 8 >> step; const bool up = (lane >> step) & 1;
#pragma unroll
                for (int i = 0; i < half; ++i) { const float keep = up ? vals[i + half] : vals[i], send = up ? vals[i] : vals[i + half]; vals[i] = keep + __shfl_xor(send, 1 << step); }
            }
            vals[0] += __shfl_xor(vals[0], 16); vals[0] += __shfl_xor(vals[0], 32);
            if (lane < 16) { const int l = lane; const int idx = ((l & 1) << 3) | ((l & 2) << 1) | ((l & 4) >> 1) | ((l & 8) >> 3); part[wave * 16 + idx] = vals[0]; }
            __syncthreads();
            if (tid < 8) { float s1 = 0.f, s2 = 0.f;
#pragma unroll
                for (int w = 0; w < 8; ++w) { s1 += part[w * 16 + tid]; s2 += part[w * 16 + 8 + tid]; }
                const float mean = s1 * (1.0f / D), var = s2 * (1.0f / D) - mean * mean;
                stat[2 * tid] = mean; stat[2 * tid + 1] = __builtin_amdgcn_rsqf(fmaxf(var, 0.f) + LN_EPS); }
            __syncthreads();
            unsigned* op = (unsigned*)(Aout + (size_t)(r0 + h * 8) * D) + tid;
#pragma unroll
            for (int o = 0; o < 8; ++o) {
                const float mean = stat[2 * o], rstd = stat[2 * o + 1];
                const float y0 = (av[o][0] - mean) * rstd * gg[0] + lb[0], y1 = (av[o][1] - mean) * rstd * gg[1] + lb[1];
                const float z0 = y0 * __builtin_amdgcn_rcpf(1.0f + __builtin_amdgcn_exp2f(-1.44269504089f * y0)), z1 = y1 * __builtin_amdgcn_rcpf(1.0f + __builtin_amdgcn_exp2f(-1.44269504089f * y1));
                *op = cvt_pk_bf16(z0, z1); op += D / 2;
                if ((o & 3) == 3) asm volatile("" ::: "memory");
            }
        }
    }
}

__device__ __forceinline__ void final_phase(const Frame& F, float* out, const float* rowsq, const float* g) {
    OPAQUE_TID();
    const int gw = F.bid * 8 + wave, NGW = F.G * 8;
    f32x4 gv[4];
#pragma unroll
    for (int j = 0; j < 4; ++j) gv[j] = ((const f32x4*)g)[lane + 64 * j];
    for (int m = gw; m < M; m += NGW) {
        const float q = lane < 16 ? rowsq[(size_t)m * 16 + lane] : 0.f;
        const float rstd = __builtin_amdgcn_rsqf(wave_sum(q) * (1.0f / D) + NORM_EPS);
        f32x4* xr = (f32x4*)(out + (size_t)m * D) + lane;
#pragma unroll
        for (int j = 0; j < 4; ++j) { const f32x4 v = xr[64 * j]; xr[64 * j] = v * rstd * gv[j]; }
    }
}

__global__ void __launch_bounds__(512, 2) fwd_megakernel(Args args) {
    extern __shared__ __attribute__((aligned(16))) unsigned char lds_raw[];
    cg::grid_group grid = cg::this_grid();
    Frame F; F.lds = (LAS unsigned char*)lds_raw; F.G = gridDim.x; F.bid = blockIdx.x;
    unsigned char* ws = args.ws;
    float* X = args.out;
    bf16_t* XB = (bf16_t*)(ws + WS_XB); float* ROWSQ = (float*)(ws + WS_ROWSQ);
    bf16_t* ACT1 = (bf16_t*)(ws + WS_ACT1); bf16_t* ACT2 = (bf16_t*)(ws + WS_ACT2); bf16_t* ACT3 = (bf16_t*)(ws + WS_ACT3); bf16_t* YT = (bf16_t*)(ws + WS_YT); bf16_t* HB = (bf16_t*)(ws + WS_H);
#define GSYNC() grid.sync()
#define RUN_GEMM(EPI, A_, B_, LDA, LDB, K_, MODE, MR, NC, APN, ...) do { pg8::Gemm g_{(A_), (B_), (LDA), (LDB), (K_)}; pg8::Order S_; S_.init((MODE), (MR), (NC), F.G, F.bid, (LDA), (LDB), (APN)); \
        EPI E_{__VA_ARGS__}; pg8::gemm_phase<EPI>(F.lds, g_, S_, E_); } while (0)

    prep_phase(F, args);
    GSYNC();
#pragma unroll 1
    for (int l = 0; l < 4; ++l) {
        const bf16_t* Win = (const bf16_t*)(ws + WS_MIX + (size_t)l * 5 * MiB);
        const bf16_t* Wgrp = (const bf16_t*)(ws + WS_MIXB + (size_t)l * 3 * MiB);
        const bf16_t* Wout = (const bf16_t*)(ws + WS_MIXB + (size_t)l * 3 * MiB + MiB);
        const float* resbase = (l == 0) ? args.in[0] : X;
        if (l == 0 || l == 3) {
            RUN_GEMM(pg8::EpiBf16<0>, XB, Win, D, D, D, 0, M, D, 0, ACT1, D, ROWSQ, 1.0f);
            GSYNC();
            pool_phase(F, ACT1, ACT2);
            GSYNC();
            RUN_GEMM(pg8::EpiBf16<0>, ACT2, Wgrp, D, 256, 256, 0, M, D, 512, ACT3, D, nullptr, 1.0f);
            GSYNC();
            RUN_GEMM(pg8::EpiRes, ACT3, Wout, D, D, D, 0, M, D, 0, resbase, X, XB, ROWSQ);
            GSYNC();
        } else if (l == 1) {
            RUN_GEMM(pg8::EpiBf16<2>, XB, Win, D, D, D, 0, M, 2 * D, 0, ACT1, D, ROWSQ, 1.0f);
            GSYNC();
            conv_phase(F, ACT1, ACT2, args.in[11], args.in[12], args.in[13], args.in[14]);
            GSYNC();
            RUN_GEMM(pg8::EpiRes, ACT2, Wout, D, D, D, 0, M, D, 0, resbase, X, XB, ROWSQ);
            GSYNC();
        } else {
            RUN_GEMM(pg8::EpiBf16<0>, XB, Win, D, D, D, 0, M, D, 0, ACT1, D, ROWSQ, 1.0f);
            GSYNC();
            RUN_GEMM(pg8::EpiBf16<0>, (const bf16_t*)(ws + WS_DCS), ACT1, 256, D, 256, 1, 256 * 1024, 256, 0, YT, 4096, nullptr, 1.0f);
            GSYNC();
            RUN_GEMM(pg8::EpiBf16<0>, (const bf16_t*)(ws + WS_T), YT, 4096, 4096, 4096, 2, 256 * 512, 256, 0, ACT2, D, nullptr, 0.70710678118f);
            GSYNC();
            RUN_GEMM(pg8::EpiRes, ACT2, Wout, D, D, D, 0, M, D, 0, resbase, X, XB, ROWSQ);
            GSYNC();
        }
        RUN_GEMM(pg8::EpiBf16<1>, XB, (const bf16_t*)(ws + WS_WUP + (size_t)l * 16 * MiB), D, D, D, 0, M, FF, 0, HB, FF, ROWSQ, 1.0f);
        GSYNC();
        RUN_GEMM(pg8::EpiRes, HB, (const bf16_t*)(ws + WS_WDN + (size_t)l * 16 * MiB), FF, FF, FF, 0, M, D, 0, X, X, XB, ROWSQ);
        GSYNC();
    }
    final_phase(F, X, ROWSQ, args.in[33]);
}

extern "C" void kernel_launch(void* const* d_in, const int* in_sizes, int n_in, void* d_out, int out_size, void* d_ws, size_t ws_size, hipStream_t stream) {
    static int grid = 0;
    if (grid == 0) {
        if (n_in != 34 || out_size != M * D || ws_size < WS_END) { fprintf(stderr, "kernel_launch: unexpected problem (n_in %d, out %d, ws %zu < %zu)\n", n_in, out_size, ws_size, (size_t)WS_END); grid = -1; return; }
        int dev = 0, cus = 0, per_cu = 0;
        if (hipGetDevice(&dev) != hipSuccess || hipDeviceGetAttribute(&cus, hipDeviceAttributeMultiprocessorCount, dev) != hipSuccess) { grid = -1; return; }
        if (hipFuncSetAttribute((const void*)fwd_megakernel, hipFuncAttributeMaxDynamicSharedMemorySize, LDS_BYTES) != hipSuccess) { fprintf(stderr, "hipFuncSetAttribute failed\n"); grid = -1; return; }
        if (hipOccupancyMaxActiveBlocksPerMultiprocessor(&per_cu, (const void*)fwd_megakernel, 512, LDS_BYTES) != hipSuccess || per_cu < 1) { fprintf(stderr, "occupancy query: %d\n", per_cu); }
        (void)hipGetLastError();
        grid = cus;
    }
    if (grid < 0) return;
    Args a{};
    for (int i = 0; i < 34; ++i) a.in[i] = (const float*)d_in[i];
    a.out = (float*)d_out; a.ws = (unsigned char*)d_ws;
    void* kargs[] = {&a};
    hipError_t e = hipLaunchCooperativeKernel((const void*)fwd_megakernel, dim3(grid), dim3(512), kargs, LDS_BYTES, stream);
    if (e != hipSuccess) fprintf(stderr, "cooperative launch failed: %s (grid %d)\n", hipGetErrorString(e), grid);
}
```

```cpp
#include <hip/hip_runtime.h>
#include <hip/hip_cooperative_groups.h>
#include <cstdio>
#include <cstdint>
namespace cg = cooperative_groups;

#define LAS __attribute__((address_space(3)))
typedef unsigned short bf16_t;
typedef short bf16x8 __attribute__((ext_vector_type(8)));
typedef float f32x4 __attribute__((ext_vector_type(4)));
typedef float f32x2 __attribute__((ext_vector_type(2)));
typedef unsigned u32x4 __attribute__((ext_vector_type(4)));
typedef unsigned u32x2 __attribute__((ext_vector_type(2)));

constexpr int NB = 16, S = 2048, D = 1024, M = NB * S, FF = 4096;
constexpr float NORM_EPS = 1e-6f, LN_EPS = 1e-5f;
constexpr size_t MiB = 1u << 20;
constexpr size_t WS_ROWSQ = 1 * MiB;
constexpr size_t WS_DCS = 3 * MiB;
constexpr size_t WS_T = 4 * MiB;
constexpr size_t WS_WUP = 20 * MiB;
constexpr size_t WS_WDN = 28 * MiB;
constexpr size_t WS_MIX = 84 * MiB;
constexpr size_t WS_MIXB = 104 * MiB;
constexpr size_t WS_XB = 116 * MiB;
constexpr size_t WS_H = 180 * MiB;
constexpr size_t WS_ACT1 = WS_H, WS_ACT2 = WS_H + 64 * MiB, WS_YT = WS_H + 128 * MiB, WS_ACT3 = WS_H + 128 * MiB;
constexpr size_t WS_END = WS_H + 256 * MiB;
constexpr int LDS_BYTES = 147456;

__device__ __forceinline__ unsigned cvt_pk_bf16(float lo, float hi) { unsigned r; asm volatile("v_cvt_pk_bf16_f32 %0, %1, %2" : "=v"(r) : "v"(lo), "v"(hi)); return r; }
__device__ __forceinline__ float bflo(unsigned w) { return __uint_as_float(w << 16); }
__device__ __forceinline__ float bfhi(unsigned w) { return __uint_as_float(w & 0xffff0000u); }

namespace pg8 {
constexpr int BM = 256, BK = 64, HALF = 128, HTB = HALF * BK * 2, STAGE_BYTES = 8 * HTB, NXCD = 8, WGM = 8;
__host__ __device__ __forceinline__ int lds_byte(int r, int c) { const int st = (r >> 4) * 2 + (c >> 5), rr = r & 15, cc = c & 31, ob = rr * 64 + cc * 2; return st * 1024 + (ob ^ (((ob >> 9) & 1) << 5)); }
__host__ __device__ __forceinline__ void stage_rc(int b, int& R, int& C) { const int st = b / 1024, sb = b % 1024, swz = sb ^ (((sb >> 9) & 1) << 5); R = (st >> 1) * 16 + swz / 64; C = (st & 1) * 32 + (swz % 64) / 2; }
__host__ __device__ __forceinline__ int perm32(int rho) { const int n = rho >> 4, i = rho & 15; return 8 * (i >> 2) + 4 * n + (i & 3); }

struct Unit { long aoff, boff; int row0, col0; };
struct Gemm { const bf16_t* A; const bf16_t* Bt; int lda, ldb, K; };

struct Order {
    int mode, nM, nN, nwg, G, c, lda, ldb; long a_pn_bytes;
    __device__ __forceinline__ void init(int mode_, int Mr, int Nc, int G_, int c_, int lda_, int ldb_, long apn) { mode = mode_; nM = Mr / BM; nN = Nc / BM; nwg = nM * nN; G = G_; c = c_; lda = lda_; ldb = ldb_; a_pn_bytes = apn; }
    __device__ __forceinline__ bool next(int i, Unit& u) const {
        const long L = (long)i * G + c; if (L >= nwg) return false;
        if (mode == 0) {
            int wgid = (int)L; { const int q = nwg / NXCD, r = nwg % NXCD, xcd = wgid % NXCD, off = wgid / NXCD; wgid = (xcd < r ? xcd * (q + 1) : r * (q + 1) + (xcd - r) * q) + off; }
            const int nig = WGM * nN, gid = wgid / nig, fm = gid * WGM, gsz = (nM - fm) < WGM ? (nM - fm) : WGM;
            const int pm = fm + ((wgid % nig) % gsz), pn = (wgid % nig) / gsz;
            u.aoff = (long)pm * BM * lda * 2 + (long)pn * a_pn_bytes; u.boff = (long)pn * BM * ldb * 2; u.row0 = pm * BM; u.col0 = pn * BM;
        } else if (mode == 1) {
            const int w = (int)L, cs = w & 1, pt = (w >> 1) & 7, g = (w >> 4) & 3, b = w >> 6;
            u.aoff = (long)cs * 256 * 256 * 2; u.boff = ((long)(b * S + pt * 256) * D + g * 256) * 2; u.row0 = b * 1024 + g * 256; u.col0 = cs * 2048 + pt * 256;
        } else {
            int b, pm, pn;
            if (G == 256) { const int xcd = c & 7, loc = c >> 3; b = i * 8 + xcd; pm = loc & 7; pn = loc >> 3; }
            else { const int w = (int)L; b = w >> 5; pm = w & 7; pn = (w >> 3) & 3; }
            u.aoff = (long)pm * 256 * 4096 * 2; u.boff = ((long)b * 1024 + pn * 256) * 4096 * 2; u.row0 = b * S + pm * 256; u.col0 = pn * 256;
        }
        return true;
    }
};

__device__ __forceinline__ float row_rstd(const float* rowsq, int row) {
    const f32x4* q = (const f32x4*)(rowsq + (size_t)row * 16);
    const f32x4 a = q[0], b = q[1], c = q[2], d = q[3];
    const f32x4 s = (a + b) + (c + d);
    const float t = (s[0] + s[1]) + (s[2] + s[3]);
    return __builtin_amdgcn_rsqf(t * (1.0f / D) + NORM_EPS);
}
template <int ACT> struct EpiBf16 {
    static constexpr bool PERM = true;
    bf16_t* O; int ldc; const float* rowsq; float post;
    __device__ __forceinline__ void operator()(const f32x4 (&acc)[2][2][4][2], const Unit& u, int wr, int wc, int fr, int fq) const {
        const int row0 = u.row0 + wr * 64 + fr;
        const int col0 = (ACT == 2 ? (u.col0 >> 1) : u.col0) + wc * 32 + 8 * fq;
#pragma unroll
        for (int ai = 0; ai < 2; ++ai)
#pragma unroll
            for (int m = 0; m < 4; ++m) {
                const int row = row0 + ai * HALF + m * 16;
                float sc = post; if (rowsq) sc *= row_rstd(rowsq, row);
                bf16_t* rowp = O + (size_t)row * ldc + col0;
                if (ACT == 2) {
                    f32x4 v0 = acc[ai][0][m][0] * sc, v1 = acc[ai][0][m][1] * sc, g0 = acc[ai][1][m][0] * sc, g1 = acc[ai][1][m][1] * sc;
#pragma unroll
                    for (int i = 0; i < 4; ++i) {
                        v0[i] = v0[i] * __builtin_amdgcn_rcpf(1.0f + __builtin_amdgcn_exp2f(-1.44269504089f * g0[i]));
                        v1[i] = v1[i] * __builtin_amdgcn_rcpf(1.0f + __builtin_amdgcn_exp2f(-1.44269504089f * g1[i])); }
                    u32x4 w; w.x = cvt_pk_bf16(v0[0], v0[1]); w.y = cvt_pk_bf16(v0[2], v0[3]); w.z = cvt_pk_bf16(v1[0], v1[1]); w.w = cvt_pk_bf16(v1[2], v1[3]);
                    *(u32x4*)rowp = w;
                } else {
#pragma unroll
                    for (int bj = 0; bj < 2; ++bj) {
                        f32x4 v0 = acc[ai][bj][m][0] * sc, v1 = acc[ai][bj][m][1] * sc;
                        if (ACT == 1) {
#pragma unroll
                            for (int i = 0; i < 4; ++i) { const float a = fmaxf(v0[i], 0.f), b = fmaxf(v1[i], 0.f); v0[i] = a * a; v1[i] = b * b; } }
                        u32x4 w; w.x = cvt_pk_bf16(v0[0], v0[1]); w.y = cvt_pk_bf16(v0[2], v0[3]); w.z = cvt_pk_bf16(v1[0], v1[1]); w.w = cvt_pk_bf16(v1[2], v1[3]);
                        *(u32x4*)(rowp + bj * HALF) = w; }
                }
                asm volatile("" ::: "memory");
            }
    }
};
struct EpiRes {
    static constexpr bool PERM = false;
    const float* base; float* out; bf16_t* xb; float* rowsq;
    __device__ __forceinline__ void operator()(const f32x4 (&acc)[2][2][4][2], const Unit& u, int wr, int wc, int fr, int fq) const {
        const int colb = u.col0 + wc * 32 + 4 * fq, slot = (u.col0 >> 8) * 4 + wc;
#pragma unroll
        for (int ai = 0; ai < 2; ++ai)
#pragma unroll
            for (int m = 0; m < 4; ++m) {
                const int row = u.row0 + ai * HALF + wr * 64 + m * 16 + fr; const size_t off = (size_t)row * D + colb; float ss = 0.f;
#pragma unroll
                for (int bj = 0; bj < 2; ++bj)
#pragma unroll
                    for (int n = 0; n < 2; ++n) {
                        const f32x4 bs = *(const f32x4*)(base + off + bj * HALF + n * 16); const f32x4 o = bs + acc[ai][bj][m][n];
                        *(f32x4*)(out + off + bj * HALF + n * 16) = o; ss += (o[0] * o[0] + o[1] * o[1]) + (o[2] * o[2] + o[3] * o[3]);
                        u32x2 w; w.x = cvt_pk_bf16(o[0], o[1]); w.y = cvt_pk_bf16(o[2], o[3]); *(u32x2*)(xb + off + bj * HALF + n * 16) = w; }
                ss += __shfl_xor(ss, 16); ss += __shfl_xor(ss, 32);
                if (fq == 0) rowsq[(size_t)row * 16 + slot] = ss;
                asm volatile("" ::: "memory");
            }
    }
};

template <class Epi>
__device__ __forceinline__ void gemm_phase(LAS unsigned char* lds, const Gemm g, const Order& S, const Epi& E) {
    int tid_ = threadIdx.x; asm volatile("" : "+v"(tid_));
    const int tid = tid_, wid = __builtin_amdgcn_readfirstlane(tid >> 6), lane = tid & 63, wr = wid >> 2, wc = wid & 3, fr = lane & 15, fq = lane >> 4;
    const int K = g.K, nt = K / BK;
    unsigned voffA[2], voffB[2];
#pragma unroll
    for (int i = 0; i < 2; ++i) { int R, C; stage_rc(tid * 16 + i * 8192, R, C); const int Rb = Epi::PERM ? ((R & ~31) + perm32(R & 31)) : R;
        voffA[i] = (unsigned)(R * g.lda + C) * 2u; voffB[i] = (unsigned)(Rb * g.ldb + C) * 2u; }
    const size_t kstep = (size_t)(BK * 2);
    const size_t hstepA = (size_t)HALF * g.lda * 2, hstepB = (size_t)HALF * g.ldb * 2;
    const unsigned ldsw = (unsigned)wid * 1024u;
    const int aoff = lds_byte(wr * 64 + fr, fq * 8), boff = lds_byte(wc * 32 + fr, fq * 8);
#define PG8_SA(b, h) (((b) * 2 + (h)) * HTB)
#define PG8_SB(b, h) ((4 + (b) * 2 + (h)) * HTB)
#define PG8_STAGE(bufoff, gbase, voff) do { _Pragma("unroll") for (int _i = 0; _i < 2; ++_i) \
        __builtin_amdgcn_global_load_lds((const unsigned*)((const char*)(gbase) + (voff)[_i]), (LAS unsigned*)(lds + (bufoff) + ldsw + _i * 8192), 16, 0, 0); } while (0)
#define PG8_LDA(dst, b, h) do { _Pragma("unroll") for (int m = 0; m < 4; ++m) _Pragma("unroll") for (int k = 0; k < 2; ++k) dst[m][k] = *(const LAS bf16x8*)(lds + PG8_SA(b, h) + aoff + m * 2048 + k * 1024); } while (0)
#define PG8_LDB(dst, b, h) do { _Pragma("unroll") for (int n = 0; n < 2; ++n) _Pragma("unroll") for (int k = 0; k < 2; ++k) dst[n][k] = *(const LAS bf16x8*)(lds + PG8_SB(b, h) + boff + n * 2048 + k * 1024); } while (0)
#define PG8_MMA(ai, bj, At, Bt) do { __builtin_amdgcn_s_setprio(1); _Pragma("unroll") for (int m = 0; m < 4; ++m) _Pragma("unroll") for (int n = 0; n < 2; ++n) _Pragma("unroll") for (int k = 0; k < 2; ++k) \
        acc[ai][bj][m][n] = __builtin_amdgcn_mfma_f32_16x16x32_bf16(Bt[n][k], At[m][k], acc[ai][bj][m][n], 0, 0, 0); __builtin_amdgcn_s_setprio(0); } while (0)
#define PG8_WAIT_V(n) asm volatile("s_waitcnt vmcnt(" #n ")" ::: "memory")
#define PG8_WAIT_L(n) asm volatile("s_waitcnt lgkmcnt(" #n ")" ::: "memory")
#define PG8_BAR __builtin_amdgcn_s_barrier()
#define PG8_SCHED __builtin_amdgcn_sched_barrier(0)
    Unit cur, nxt; int ui = 0;
    if (!S.next(0, cur)) return;
    f32x4 acc[2][2][4][2];
#pragma unroll
    for (int a = 0; a < 2; ++a)
#pragma unroll
        for (int b = 0; b < 2; ++b)
#pragma unroll
            for (int m = 0; m < 4; ++m)
#pragma unroll
                for (int n = 0; n < 2; ++n) acc[a][b][m][n] = (f32x4){0.f, 0.f, 0.f, 0.f};
    bf16x8 At[4][2], B0[2][2], B1[2][2];
    const char* cA = (const char*)g.A + cur.aoff; const char* cB = (const char*)g.Bt + cur.boff;
    PG8_STAGE(PG8_SB(0, 0), cB, voffB); PG8_STAGE(PG8_SB(0, 1), cB + hstepB, voffB); PG8_STAGE(PG8_SA(0, 0), cA, voffA); PG8_STAGE(PG8_SA(0, 1), cA + hstepA, voffA);
    if (wr == 1) PG8_BAR;
    PG8_WAIT_V(2); PG8_BAR;
    PG8_STAGE(PG8_SB(1, 0), cB + kstep, voffB); PG8_STAGE(PG8_SA(1, 0), cA + kstep, voffA); PG8_STAGE(PG8_SB(1, 1), cB + hstepB + kstep, voffB);
    PG8_WAIT_V(6); PG8_BAR;
    for (;;) {
        const bool has_next = S.next(ui + 1, nxt);
        const char* nA = has_next ? (const char*)g.A + nxt.aoff : cA; const char* nB = has_next ? (const char*)g.Bt + nxt.boff : cB;
        for (int t = 0; t < nt; t += 2) {
            const bool last = (t == nt - 2);
            const char* a1 = cA + (size_t)(t + 1) * kstep;
            const char* a2 = last ? nA : cA + (size_t)(t + 2) * kstep; const char* b2 = last ? nB : cB + (size_t)(t + 2) * kstep;
            const char* a3 = a2 + kstep; const char* b3 = b2 + kstep;
            PG8_LDB(B0, 0, 0); PG8_LDB(B1, 0, 1); PG8_SCHED; PG8_LDA(At, 0, 0); PG8_STAGE(PG8_SA(1, 1), a1 + hstepA, voffA);
            PG8_WAIT_V(8); PG8_WAIT_L(0); PG8_BAR; PG8_MMA(0, 0, At, B0); PG8_MMA(0, 1, At, B1); PG8_BAR; PG8_SCHED;
            PG8_LDA(At, 0, 1); PG8_STAGE(PG8_SB(0, 0), b2, voffB); PG8_STAGE(PG8_SB(0, 1), b2 + hstepB, voffB); PG8_STAGE(PG8_SA(0, 0), a2, voffA);
            PG8_WAIT_V(8); PG8_WAIT_L(0); PG8_BAR; PG8_MMA(1, 0, At, B0); PG8_MMA(1, 1, At, B1); PG8_BAR; PG8_SCHED;
            PG8_LDB(B0, 1, 0); PG8_LDB(B1, 1, 1); PG8_SCHED; PG8_LDA(At, 1, 0); PG8_STAGE(PG8_SA(0, 1), a2 + hstepA, voffA);
            PG8_WAIT_V(8); PG8_WAIT_L(0); PG8_BAR; PG8_MMA(0, 0, At, B0); PG8_MMA(0, 1, At, B1); PG8_BAR; PG8_SCHED;
            PG8_LDA(At, 1, 1); PG8_STAGE(PG8_SB(1, 0), b3, voffB); PG8_STAGE(PG8_SB(1, 1), b3 + hstepB, voffB); PG8_STAGE(PG8_SA(1, 0), a3, voffA);
            PG8_WAIT_V(8); PG8_WAIT_L(0); PG8_BAR; PG8_MMA(1, 0, At, B0); PG8_MMA(1, 1, At, B1); PG8_BAR; PG8_SCHED;
        }
        if (wr == 0) PG8_BAR;
        E(acc, cur, wr, wc, fr, fq);
        if (!has_next) break;
#pragma unroll
        for (int a = 0; a < 2; ++a)
#pragma unroll
            for (int b = 0; b < 2; ++b)
#pragma unroll
                for (int m = 0; m < 4; ++m)
#pragma unroll
                    for (int n = 0; n < 2; ++n) acc[a][b][m][n] = (f32x4){0.f, 0.f, 0.f, 0.f};
        cur = nxt; cA = nA; cB = nB; ++ui;
        if (wr == 1) PG8_BAR;
    }
    PG8_WAIT_V(0);
    PG8_BAR;
#undef PG8_SA
#undef PG8_SB
#undef PG8_STAGE
#undef PG8_LDA
#undef PG8_LDB
#undef PG8_MMA
#undef PG8_WAIT_V
#undef PG8_WAIT_L
#undef PG8_BAR
#undef PG8_SCHED
}
}


#define XB_TMO      128
#define XB_XCNT(j)  (256  + 64 * (j))
#define XB_XSUB(j)  (1280 + 64 * (j))
#define XB_XGEN(j)  (2304 + 64 * (j))
#define XB_TOP      3328
#define XB_TOPGEN   3392
#define XCD_BAR_WORDS 3456
#define XB_SPIN_CAP (1u << 22)
__device__ __forceinline__ unsigned xb_ld(unsigned* p)              { return __hip_atomic_load(p, __ATOMIC_RELAXED, __HIP_MEMORY_SCOPE_AGENT); }
__device__ __forceinline__ unsigned xb_add(unsigned* p, unsigned v) { return __hip_atomic_fetch_add(p, v, __ATOMIC_RELAXED, __HIP_MEMORY_SCOPE_AGENT); }
__device__ __forceinline__ unsigned xb_xcc_id() { return (unsigned)__builtin_amdgcn_s_getreg((3 << 11) | 20) & 0xFu; }
#define XB_SPIN(cond, bar) do { unsigned _sp = 0; while (cond) { __builtin_amdgcn_s_sleep(1); \
    if ((++_sp & 255u) == 0u) { if (xb_ld(&(bar)[XB_TMO])) break; if (_sp > XB_SPIN_CAP) { atomicAdd(&(bar)[XB_TMO], 1u); break; } } } } while (0)
struct XcdBarrier { unsigned* bar; unsigned x; volatile LAS unsigned* st; };
__device__ __forceinline__ XcdBarrier xcd_barrier_post(unsigned* bar, volatile LAS unsigned* st) {
    XcdBarrier b; b.bar = bar; b.x = xb_xcc_id(); b.st = st;
    if (threadIdx.x == 0) (void)xb_add(&bar[XB_XCNT(b.x)], 1u);
    return b;
}
__device__ __forceinline__ void xcd_barrier_complete(unsigned* bar, unsigned x, unsigned& nloc, unsigned& nx) {
    const unsigned G = gridDim.x * gridDim.y * gridDim.z;
    unsigned sum, cnt, mine, sp = 0u;
    for (;;) {
        sum = 0u; cnt = 0u; mine = 0u;
#pragma unroll
        for (unsigned j = 0; j < 16; ++j) { const unsigned c = xb_ld(&bar[XB_XCNT(j)]); sum += c; cnt += (c > 0u) ? 1u : 0u; mine = (j == x) ? c : mine; }
        if (sum == G) break;
        __builtin_amdgcn_s_sleep(1);
        if ((++sp & 255u) == 0u) { if (xb_ld(&bar[XB_TMO])) break; if (sp > XB_SPIN_CAP) { atomicAdd(&bar[XB_TMO], 1u); break; } }
    }
    nloc = mine > 0u ? mine : 1u; nx = cnt > 0u ? cnt : 1u;
}
__device__ __forceinline__ void xcd_barrier(const XcdBarrier& b) {
    asm volatile("s_waitcnt vmcnt(0)" ::: "memory");
    __syncthreads();
    if (threadIdx.x == 0) {
        unsigned* bar = b.bar;
        __builtin_amdgcn_s_waitcnt(0);
        unsigned nloc = b.st[0], nx = b.st[1];
        if (nloc == 0u) { xcd_barrier_complete(bar, b.x, nloc, nx); b.st[0] = nloc; b.st[1] = nx; }
        const unsigned old = xb_add(&bar[XB_XSUB(b.x)], 1u);
        const unsigned gen = old / nloc;
        if (old + 1u == (gen + 1u) * nloc) {
            __builtin_amdgcn_fence(__ATOMIC_RELEASE, "agent");
            asm volatile("s_waitcnt vmcnt(0)" ::: "memory");
            const unsigned og = xb_add(&bar[XB_TOP], 1u);
            const unsigned tg = og / nx;
            if (og + 1u == (tg + 1u) * nx) xb_add(&bar[XB_TOPGEN], 1u);
            else XB_SPIN(xb_ld(&bar[XB_TOPGEN]) == tg, bar);
            __builtin_amdgcn_fence(__ATOMIC_ACQUIRE, "agent");
            xb_add(&bar[XB_XGEN(b.x)], 1u);
            asm volatile("s_waitcnt vmcnt(0)" ::: "memory");
        } else {
            XB_SPIN(xb_ld(&bar[XB_XGEN(b.x)]) == gen, bar);
            __builtin_amdgcn_fence(__ATOMIC_ACQUIRE, "agent");
            asm volatile("s_waitcnt vmcnt(0)" ::: "memory");
        }
    }
    __syncthreads();
}

struct Frame { LAS unsigned char* lds; int G, bid; };
#define OPAQUE_TID() int tid_ = threadIdx.x; asm volatile("" : "+v"(tid_)); const int tid = tid_, lane = tid & 63, wave = __builtin_amdgcn_readfirstlane(tid >> 6); (void)lane; (void)wave
__device__ __forceinline__ float wave_sum(float v) {
#pragma unroll
    for (int o = 1; o < 64; o <<= 1) v += __shfl_xor(v, o);
    return v;
}
#define LDS_WAIT() asm volatile("s_waitcnt lgkmcnt(0)" ::: "memory")

__device__ __forceinline__ void transpose_item(const float* W, int K, int N, bf16_t* WT, int ldt, const float* kscale, const float* nscale, bool glu, LAS float* scr, int item, int lane) {
    const int nblk = N / 32, kb = item / nblk, nb = item % nblk, k0 = 64 * kb, n0 = 32 * nb;
    const float ns = nscale ? nscale[n0 + (lane & 31)] : 1.0f;
#pragma unroll 8
    for (int i = 0; i < 32; ++i) { const int kk = 2 * i + (lane >> 5); const float ks = kscale ? kscale[k0 + kk] : 1.0f; scr[kk * 33 + (lane & 31)] = W[(size_t)(k0 + kk) * N + n0 + (lane & 31)] * ks * ns; }
    LDS_WAIT(); asm volatile("" ::: "memory");
    int r0 = n0; if (glu) { const int c = n0 & 1023, gate = n0 >> 10; r0 = (c >> 7) * 256 + gate * 128 + (c & 127); }
    const int c = lane & 7;
#pragma unroll
    for (int j = 0; j < 4; ++j) { const int n = (lane >> 3) + 8 * j; const LAS float* s = scr + (8 * c) * 33 + n;
        u32x4 o; o.x = cvt_pk_bf16(s[0 * 33], s[1 * 33]); o.y = cvt_pk_bf16(s[2 * 33], s[3 * 33]); o.z = cvt_pk_bf16(s[4 * 33], s[5 * 33]); o.w = cvt_pk_bf16(s[6 * 33], s[7 * 33]);
        *(u32x4*)(WT + (size_t)(r0 + n) * ldt + k0 + 8 * c) = o; }
    LDS_WAIT(); asm volatile("" ::: "memory");
}

struct Args { const float* in[34]; float* out; unsigned char* ws; };

__device__ __forceinline__ void prep_phase(const Frame& F, const Args& a) {
    OPAQUE_TID();
    unsigned char* ws = a.ws;
    LAS float* scr = (LAS float*)(F.lds + wave * 16384);
    const int gw = F.bid * 8 + wave, NGW = F.G * 8;
    constexpr int I_SQ = (D / 64) * (D / 32), I_UP = (D / 64) * (FF / 32), I_DN = (FF / 64) * (D / 32), I_GRP = 4 * (256 / 64) * (256 / 32), I_CIN = (D / 64) * (2 * D / 32);
    constexpr int I_MLP = I_UP + I_DN;
    constexpr int I_POOL = 2 * I_SQ + I_GRP + I_MLP, I_CONV = I_CIN + I_SQ + I_MLP, I_FOUR = 2 * I_SQ + I_MLP;
    constexpr int NITEMS = 2 * I_POOL + I_CONV + I_FOUR;
#define JOB(W, K_, N_, DST, LDT, KS, NS, GLU) if (r < ((K_) / 64) * ((N_) / 32)) { transpose_item((W), (K_), (N_), (bf16_t*)(DST), (LDT), (KS), (NS), (GLU), scr, r, lane); continue; } r -= ((K_) / 64) * ((N_) / 32);
#define JOB_MLP(L, i0) JOB(a.in[(i0) + 1], D, FF, ws + WS_WUP + (L) * 16 * MiB, D, a.in[(i0)], nullptr, false) \
                       JOB(a.in[(i0) + 2], FF, D, ws + WS_WDN + (L) * 16 * MiB, FF, nullptr, nullptr, false)
#define JOB_POOL(L, i0) JOB(a.in[(i0) + 1], D, D, ws + WS_MIX + (L) * 5 * MiB, D, a.in[(i0)], nullptr, false) \
                        if (r < I_GRP) { const int g = r / (I_GRP / 4); transpose_item(a.in[(i0) + 2] + g * 65536, 256, 256, (bf16_t*)(ws + WS_MIXB + (L) * 3 * MiB) + g * 65536, 256, nullptr, a.in[(i0) + 3] + g * 256, false, scr, r % (I_GRP / 4), lane); continue; } r -= I_GRP; \
                        JOB(a.in[(i0) + 4], D, D, ws + WS_MIXB + (L) * 3 * MiB + MiB, D, nullptr, nullptr, false) \
                        JOB_MLP(L, (i0) + 5)
    for (int it = gw; it < NITEMS; it += NGW) {
        int r = it;
        JOB_POOL(0, 1)
        JOB(a.in[10], D, 2 * D, ws + WS_MIX + 1 * 5 * MiB, D, a.in[9], nullptr, true)
        JOB(a.in[15], D, D, ws + WS_MIXB + 1 * 3 * MiB + MiB, D, nullptr, nullptr, false)
        JOB_MLP(1, 16)
        JOB(a.in[20], D, D, ws + WS_MIX + 2 * 5 * MiB, D, a.in[19], nullptr, false)
        JOB(a.in[21], D, D, ws + WS_MIXB + 2 * 3 * MiB + MiB, D, nullptr, nullptr, false)
        JOB_MLP(2, 22)
        JOB_POOL(3, 25)
    }
#undef JOB
#undef JOB_MLP
#undef JOB_POOL
    {
        const float* x = a.in[0]; bf16_t* XB = (bf16_t*)(ws + WS_XB); float* rowsq = (float*)(ws + WS_ROWSQ);
        for (int m = gw; m < M; m += NGW) {
            const f32x4* xr = (const f32x4*)(x + (size_t)m * D) + lane; f32x4 v[4]; float s = 0.f;
#pragma unroll
            for (int j = 0; j < 4; ++j) { v[j] = xr[64 * j]; s += (v[j][0] * v[j][0] + v[j][1] * v[j][1]) + (v[j][2] * v[j][2] + v[j][3] * v[j][3]); }
            s = wave_sum(s);
            u32x2* o8 = (u32x2*)(XB + (size_t)m * D) + lane;
#pragma unroll
            for (int j = 0; j < 4; ++j) { u32x2 w; w.x = cvt_pk_bf16(v[j][0], v[j][1]); w.y = cvt_pk_bf16(v[j][2], v[j][3]); o8[64 * j] = w; }
            if (lane < 16) rowsq[(size_t)m * 16 + lane] = (lane == 0) ? s : 0.f;
        }
    }
    {
        const int gt = F.bid * 512 + tid, GT = F.G * 512;
        bf16_t* Dcs = (bf16_t*)(ws + WS_DCS); bf16_t* T = (bf16_t*)(ws + WS_T);
        for (int it = gt; it < 2 * 256 * 256 / 8; it += GT) {
            const int e0 = it * 8, cs = e0 >> 16, j = (e0 >> 8) & 255, c0 = e0 & 255; float v[8];
#pragma unroll
            for (int k = 0; k < 8; ++k) { const float xx = (float)((j * (c0 + k)) & 255) * (1.0f / 128.0f); v[k] = (cs ? sinpif(xx) : cospif(xx)) * 0.0625f; }
            u32x4 w; w.x = cvt_pk_bf16(v[0], v[1]); w.y = cvt_pk_bf16(v[2], v[3]); w.z = cvt_pk_bf16(v[4], v[5]); w.w = cvt_pk_bf16(v[6], v[7]);
            *(u32x4*)(Dcs + e0) = w;
        }
        for (int it = gt; it < 2048 * 4096 / 8; it += GT) {
            const int e0 = it * 8, p = e0 >> 12, q = e0 & 4095, cs = q >> 11, s0 = q & 2047; float v[8];
#pragma unroll
            for (int k = 0; k < 8; ++k) { const float xx = (float)((p * (s0 + k)) & 2047) * (1.0f / 1024.0f); v[k] = (cs ? -sinpif(xx) : cospif(xx)) * 0.03125f; }
            u32x4 w; w.x = cvt_pk_bf16(v[0], v[1]); w.y = cvt_pk_bf16(v[2], v[3]); w.z = cvt_pk_bf16(v[4], v[5]); w.w = cvt_pk_bf16(v[6], v[7]);
            *(u32x4*)(T + e0) = w;
        }
    }
}

__device__ __forceinline__ void pool_phase(const Frame& F, const bf16_t* U, bf16_t* P) {
    OPAQUE_TID();
    const int gt = F.bid * 512 + tid, GT = F.G * 512;
    for (int it = gt; it < M * 128; it += GT) {
        const int row = it >> 7, ch = it & 127, g = ch >> 5, hw = 1 << g, s = row & (S - 1);
        const int lo = (s - hw) > 0 ? (s - hw) : 0, hi = (s + hw) < S ? (s + hw) : S;
        const bf16_t* base = U + (size_t)(row - s) * D + ch * 8;
        float a[8];
#pragma unroll
        for (int k = 0; k < 8; ++k) a[k] = 0.f;
        for (int t = lo; t < hi; ++t) { const u32x4 w = *(const u32x4*)(base + (size_t)t * D);
#pragma unroll
            for (int k = 0; k < 4; ++k) { a[2 * k] += bflo(w[k]); a[2 * k + 1] += bfhi(w[k]); } }
        const u32x4 c = *(const u32x4*)(base + (size_t)s * D);
        const float inv = 1.0f / (float)(hi - lo);
        u32x4 o;
#pragma unroll
        for (int k = 0; k < 4; ++k) o[k] = cvt_pk_bf16(a[2 * k] * inv - bflo(c[k]), a[2 * k + 1] * inv - bfhi(c[k]));
        *(u32x4*)(P + (size_t)row * D + ch * 8) = o;
    }
}

__device__ __forceinline__ void conv_phase(const Frame& F, const bf16_t* V, bf16_t* Aout, const float* dw, const float* dwb, const float* lng, const float* lnb) {
    OPAQUE_TID();
    f32x2 wv[31];
    { const float* p = dw + 2 * tid;
#pragma unroll
      for (int j = 0; j < 31; ++j) { wv[j] = *(const f32x2*)p; p += D; if ((j & 3) == 3) asm volatile("" ::: "memory"); } }
    const f32x2 bb = *(const f32x2*)(dwb + 2 * tid), gg = *(const f32x2*)(lng + 2 * tid), lb = *(const f32x2*)(lnb + 2 * tid);
    constexpr int TILE_BYTES = 46 * D * 2;
    LAS unsigned char* tl = F.lds;
    LAS float* part = (LAS float*)(F.lds + 98304);
    LAS float* stat = (LAS float*)(F.lds + 98304 + 1024);
    for (int tile = F.bid; tile < M / 16; tile += F.G) {
        const int r0 = tile * 16, s0 = r0 & (S - 1);
        const char* tb = (const char*)V + ((long)r0 - 15) * (D * 2);
#pragma unroll
        for (int i = 0; i < 12; ++i) {
            const int q = i * 8 + wave;
            if (q < TILE_BYTES / 1024) {
                const int t = s0 - 15 + (q >> 1);
                if (t >= 0 && t < S) __builtin_amdgcn_global_load_lds((const unsigned*)(tb + q * 1024 + lane * 16), (LAS unsigned*)(tl + q * 1024), 16, 0, 0);
                else *(LAS u32x4*)(tl + q * 1024 + lane * 16) = (u32x4){0u, 0u, 0u, 0u};
            }
        }
        asm volatile("s_waitcnt vmcnt(0) lgkmcnt(0)" ::: "memory");
        __syncthreads();
#pragma unroll 1
        for (int h = 0; h < 2; ++h) {
            const LAS unsigned char* tlh = tl + h * 8 * (D * 2) + tid * 4;
            f32x2 av[8];
#pragma unroll
            for (int o = 0; o < 8; ++o) av[o] = bb;
#pragma unroll
            for (int tt = 0; tt < 38; ++tt) {
                const unsigned w = *(const LAS unsigned*)(tlh + tt * (D * 2));
                const f32x2 xv = (f32x2){bflo(w), bfhi(w)};
#pragma unroll
                for (int o = 0; o < 8; ++o) { const int j = tt - o; if (j >= 0 && j <= 30) av[o] = __builtin_elementwise_fma(xv, wv[j], av[o]); }
                if ((tt & 7) == 7) asm volatile("" ::: "memory");
            }
            float vals[16];
#pragma unroll
            for (int o = 0; o < 8; ++o) { vals[o] = av[o][0] + av[o][1]; vals[8 + o] = av[o][0] * av[o][0] + av[o][1] * av[o][1]; }
#pragma unroll
            for (int step = 0; step < 4; ++step) {
                const int half = 8 >> step; const bool up = (lane >> step) & 1;
#pragma unroll
                for (int i = 0; i < half; ++i) { const float keep = up ? vals[i + half] : vals[i], send = up ? vals[i] : vals[i + half]; vals[i] = keep + __shfl_xor(send, 1 << step); }
            }
            vals[0] += __shfl_xor(vals[0], 16); vals[0] += __shfl_xor(vals[0], 32);
            if (lane < 16) { const int l = lane; const int idx = ((l & 1) << 3) | ((l & 2) << 1) | ((l & 4) >> 1) | ((l & 8) >> 3); part[wave * 16 + idx] = vals[0]; }
            __syncthreads();
            if (tid < 8) { float s1 = 0.f, s2 = 0.f;
#pragma unroll
                for (int w = 0; w < 8; ++w) { s1 += part[w * 16 + tid]; s2 += part[w * 16 + 8 + tid]; }
                const float mean = s1 * (1.0f / D), var = s2 * (1.0f / D) - mean * mean;
                stat[2 * tid] = mean; stat[2 * tid + 1] = __builtin_amdgcn_rsqf(fmaxf(var, 0.f) + LN_EPS); }
            __syncthreads();
            unsigned* op = (unsigned*)(Aout + (size_t)(r0 + h * 8) * D) + tid;
#pragma unroll
            for (int o = 0; o < 8; ++o) {
                const float mean = stat[2 * o], rstd = stat[2 * o + 1];
                const float y0 = (av[o][0] - mean) * rstd * gg[0] + lb[0], y1 = (av[o][1] - mean) * rstd * gg[1] + lb[1];
                const float z0 = y0 * __builtin_amdgcn_rcpf(1.0f + __builtin_amdgcn_exp2f(-1.44269504089f * y0)), z1 = y1 * __builtin_amdgcn_rcpf(1.0f + __builtin_amdgcn_exp2f(-1.44269504089f * y1));
                *op = cvt_pk_bf16(z0, z1); op += D / 2;
                if ((o & 3) == 3) asm volatile("" ::: "memory");
            }
        }
    }
}

__device__ __forceinline__ void final_phase(const Frame& F, float* out, const float* rowsq, const float* g) {
    OPAQUE_TID();
    const int gw = F.bid * 8 + wave, NGW = F.G * 8;
    f32x4 gv[4];
#pragma unroll
    for (int j = 0; j < 4; ++j) gv[j] = ((const f32x4*)g)[lane + 64 * j];
    for (int m = gw; m < M; m += NGW) {
        const float q = lane < 16 ? rowsq[(size_t)m * 16 + lane] : 0.f;
        const float rstd = __builtin_amdgcn_rsqf(wave_sum(q) * (1.0f / D) + NORM_EPS);
        f32x4* xr = (f32x4*)(out + (size_t)m * D) + lane;
#pragma unroll
        for (int j = 0; j < 4; ++j) { const f32x4 v = xr[64 * j]; xr[64 * j] = v * rstd * gv[j]; }
    }
}

__global__ void __launch_bounds__(512, 2) fwd_megakernel(Args args) {
    extern __shared__ __attribute__((aligned(16))) unsigned char lds_raw[];
    cg::grid_group grid = cg::this_grid();
    Frame F; F.lds = (LAS unsigned char*)lds_raw; F.G = gridDim.x; F.bid = blockIdx.x;
    unsigned char* ws = args.ws;
    float* X = args.out;
    bf16_t* XB = (bf16_t*)(ws + WS_XB); float* ROWSQ = (float*)(ws + WS_ROWSQ);
    bf16_t* ACT1 = (bf16_t*)(ws + WS_ACT1); bf16_t* ACT2 = (bf16_t*)(ws + WS_ACT2); bf16_t* ACT3 = (bf16_t*)(ws + WS_ACT3); bf16_t* YT = (bf16_t*)(ws + WS_YT); bf16_t* HB = (bf16_t*)(ws + WS_H);
    volatile LAS unsigned* bst = (volatile LAS unsigned*)(F.lds + 131072 + 512);
    if (threadIdx.x < 2) bst[threadIdx.x] = 0u;
    __syncthreads();
    const XcdBarrier xbar = xcd_barrier_post((unsigned*)ws, bst);
#define GSYNC() xcd_barrier(xbar)
#define RUN_GEMM(EPI, A_, B_, LDA, LDB, K_, MODE, MR, NC, APN, ...) do { pg8::Gemm g_{(A_), (B_), (LDA), (LDB), (K_)}; pg8::Order S_; S_.init((MODE), (MR), (NC), F.G, F.bid, (LDA), (LDB), (APN)); \
        EPI E_{__VA_ARGS__}; pg8::gemm_phase<EPI>(F.lds, g_, S_, E_); } while (0)

    prep_phase(F, args);
    grid.sync();
#pragma unroll 1
    for (int l = 0; l < 4; ++l) {
        const bf16_t* Win = (const bf16_t*)(ws + WS_MIX + (size_t)l * 5 * MiB);
        const bf16_t* Wgrp = (const bf16_t*)(ws + WS_MIXB + (size_t)l * 3 * MiB);
        const bf16_t* Wout = (const bf16_t*)(ws + WS_MIXB + (size_t)l * 3 * MiB + MiB);
        const float* resbase = (l == 0) ? args.in[0] : X;
        if (l == 0 || l == 3) {
            RUN_GEMM(pg8::EpiBf16<0>, XB, Win, D, D, D, 0, M, D, 0, ACT1, D, ROWSQ, 1.0f);
            GSYNC();
            pool_phase(F, ACT1, ACT2);
            GSYNC();
            RUN_GEMM(pg8::EpiBf16<0>, ACT2, Wgrp, D, 256, 256, 0, M, D, 512, ACT3, D, nullptr, 1.0f);
            GSYNC();
            RUN_GEMM(pg8::EpiRes, ACT3, Wout, D, D, D, 0, M, D, 0, resbase, X, XB, ROWSQ);
            GSYNC();
        } else if (l == 1) {
            RUN_GEMM(pg8::EpiBf16<2>, XB, Win, D, D, D, 0, M, 2 * D, 0, ACT1, D, ROWSQ, 1.0f);
            GSYNC();
            conv_phase(F, ACT1, ACT2, args.in[11], args.in[12], args.in[13], args.in[14]);
            GSYNC();
            RUN_GEMM(pg8::EpiRes, ACT2, Wout, D, D, D, 0, M, D, 0, resbase, X, XB, ROWSQ);
            GSYNC();
        } else {
            RUN_GEMM(pg8::EpiBf16<0>, XB, Win, D, D, D, 0, M, D, 0, ACT1, D, ROWSQ, 1.0f);
            GSYNC();
            RUN_GEMM(pg8::EpiBf16<0>, (const bf16_t*)(ws + WS_DCS), ACT1, 256, D, 256, 1, 256 * 1024, 256, 0, YT, 4096, nullptr, 1.0f);
            GSYNC();
            RUN_GEMM(pg8::EpiBf16<0>, (const bf16_t*)(ws + WS_T), YT, 4096, 4096, 4096, 2, 256 * 512, 256, 0, ACT2, D, nullptr, 0.70710678118f);
            GSYNC();
            RUN_GEMM(pg8::EpiRes, ACT2, Wout, D, D, D, 0, M, D, 0, resbase, X, XB, ROWSQ);
            GSYNC();
        }
        RUN_GEMM(pg8::EpiBf16<1>, XB, (const bf16_t*)(ws + WS_WUP + (size_t)l * 16 * MiB), D, D, D, 0, M, FF, 0, HB, FF, ROWSQ, 1.0f);
        GSYNC();
        RUN_GEMM(pg8::EpiRes, HB, (const bf16_t*)(ws + WS_WDN + (size_t)l * 16 * MiB), FF, FF, FF, 0, M, D, 0, X, X, XB, ROWSQ);
        GSYNC();
    }
    final_phase(F, X, ROWSQ, args.in[33]);
}

extern "C" void kernel_launch(void* const* d_in, const int* in_sizes, int n_in, void* d_out, int out_size, void* d_ws, size_t ws_size, hipStream_t stream) {
    static int grid = 0;
    if (grid == 0) {
        if (n_in != 34 || out_size != M * D || ws_size < WS_END) { fprintf(stderr, "kernel_launch: unexpected problem (n_in %d, out %d, ws %zu < %zu)\n", n_in, out_size, ws_size, (size_t)WS_END); grid = -1; return; }
        int dev = 0, cus = 0, per_cu = 0;
        if (hipGetDevice(&dev) != hipSuccess || hipDeviceGetAttribute(&cus, hipDeviceAttributeMultiprocessorCount, dev) != hipSuccess) { grid = -1; return; }
        if (hipFuncSetAttribute((const void*)fwd_megakernel, hipFuncAttributeMaxDynamicSharedMemorySize, LDS_BYTES) != hipSuccess) { fprintf(stderr, "hipFuncSetAttribute failed\n"); grid = -1; return; }
        if (hipOccupancyMaxActiveBlocksPerMultiprocessor(&per_cu, (const void*)fwd_megakernel, 512, LDS_BYTES) != hipSuccess || per_cu < 1) { fprintf(stderr, "occupancy query: %d\n", per_cu); }
        (void)hipGetLastError();
        grid = cus;
    }
    if (grid < 0) return;
    if (hipMemsetAsync(d_ws, 0, 16384, stream) != hipSuccess) { fprintf(stderr, "kernel_launch: memset failed\n"); return; }
    Args a{};
    for (int i = 0; i < 34; ++i) a.in[i] = (const float*)d_in[i];
    a.out = (float*)d_out; a.ws = (unsigned char*)d_ws;
    void* kargs[] = {&a};
    hipError_t e = hipLaunchCooperativeKernel((const void*)fwd_megakernel, dim3(grid), dim3(512), kargs, LDS_BYTES, stream);
    if (e != hipSuccess) fprintf(stderr, "cooperative launch failed: %s (grid %d)\n", hipGetErrorString(e), grid);
}
```

```cpp
#include <hip/hip_runtime.h>
#include <hip/hip_cooperative_groups.h>
#include <cstdio>
#include <cstdint>
namespace cg = cooperative_groups;

#define LAS __attribute__((address_space(3)))
typedef unsigned short bf16_t;
typedef short bf16x8 __attribute__((ext_vector_type(8)));
typedef float f32x4 __attribute__((ext_vector_type(4)));
typedef float f32x2 __attribute__((ext_vector_type(2)));
typedef unsigned u32x4 __attribute__((ext_vector_type(4)));
typedef unsigned u32x2 __attribute__((ext_vector_type(2)));

constexpr int NB = 16, S = 2048, D = 1024, M = NB * S, FF = 4096;
constexpr float NORM_EPS = 1e-6f, LN_EPS = 1e-5f;
constexpr size_t MiB = 1u << 20;
constexpr size_t WS_ROWSQ = 1 * MiB;
constexpr size_t WS_DCS = 3 * MiB;
constexpr size_t WS_T = 4 * MiB;
constexpr size_t WS_WUP = 20 * MiB;
constexpr size_t WS_WDN = 28 * MiB;
constexpr size_t WS_MIX = 84 * MiB;
constexpr size_t WS_MIXB = 104 * MiB;
constexpr size_t WS_XB = 116 * MiB;
constexpr size_t WS_H = 180 * MiB;
constexpr size_t WS_ACT1 = WS_H, WS_ACT2 = WS_H + 64 * MiB, WS_YT = WS_H + 128 * MiB, WS_ACT3 = WS_H + 128 * MiB;
constexpr size_t WS_END = WS_H + 256 * MiB;
constexpr int LDS_BYTES = 147456;

__device__ __forceinline__ unsigned cvt_pk_bf16(float lo, float hi) { unsigned r; asm volatile("v_cvt_pk_bf16_f32 %0, %1, %2" : "=v"(r) : "v"(lo), "v"(hi)); return r; }
__device__ __forceinline__ float bflo(unsigned w) { return __uint_as_float(w << 16); }
__device__ __forceinline__ float bfhi(unsigned w) { return __uint_as_float(w & 0xffff0000u); }

namespace pg8 {
constexpr int BM = 256, BK = 64, HALF = 128, HTB = HALF * BK * 2, STAGE_BYTES = 8 * HTB, NXCD = 8, WGM = 8;
__host__ __device__ __forceinline__ int lds_byte(int r, int c) { const int st = (r >> 4) * 2 + (c >> 5), rr = r & 15, cc = c & 31, ob = rr * 64 + cc * 2; return st * 1024 + (ob ^ (((ob >> 9) & 1) << 5)); }
__host__ __device__ __forceinline__ void stage_rc(int b, int& R, int& C) { const int st = b / 1024, sb = b % 1024, swz = sb ^ (((sb >> 9) & 1) << 5); R = (st >> 1) * 16 + swz / 64; C = (st & 1) * 32 + (swz % 64) / 2; }
__host__ __device__ __forceinline__ int perm32(int rho) { const int n = rho >> 4, i = rho & 15; return 8 * (i >> 2) + 4 * n + (i & 3); }

struct Unit { long aoff, boff; int row0, col0; };
struct Gemm { const bf16_t* A; const bf16_t* Bt; int lda, ldb, K; };

struct Order {
    int mode, nM, nN, nwg, G, c, lda, ldb; long a_pn_bytes;
    __device__ __forceinline__ void init(int mode_, int Mr, int Nc, int G_, int c_, int lda_, int ldb_, long apn) { mode = mode_; nM = Mr / BM; nN = Nc / BM; nwg = nM * nN; G = G_; c = c_; lda = lda_; ldb = ldb_; a_pn_bytes = apn; }
    __device__ __forceinline__ bool next(int i, Unit& u) const {
        const long L = (long)i * G + c; if (L >= nwg) return false;
        if (mode == 0) {
            int wgid = (int)L; { const int q = nwg / NXCD, r = nwg % NXCD, xcd = wgid % NXCD, off = wgid / NXCD; wgid = (xcd < r ? xcd * (q + 1) : r * (q + 1) + (xcd - r) * q) + off; }
            const int nig = WGM * nN, gid = wgid / nig, fm = gid * WGM, gsz = (nM - fm) < WGM ? (nM - fm) : WGM;
            const int pm = fm + ((wgid % nig) % gsz), pn = (wgid % nig) / gsz;
            u.aoff = (long)pm * BM * lda * 2 + (long)pn * a_pn_bytes; u.boff = (long)pn * BM * ldb * 2; u.row0 = pm * BM; u.col0 = pn * BM;
        } else if (mode == 1) {
            const int w = (int)L, cs = w & 1, pt = (w >> 1) & 7, g = (w >> 4) & 3, b = w >> 6;
            u.aoff = (long)cs * 256 * 256 * 2; u.boff = ((long)(b * S + pt * 256) * D + g * 256) * 2; u.row0 = b * 1024 + g * 256; u.col0 = cs * 2048 + pt * 256;
        } else if (mode == 3) {
            const int w = (int)L, layer = w >> 4, pm = (w >> 2) & 3, pn = w & 3;
            u.aoff = (long)layer * 9 * 1048576 + (long)pm * 256 * 256 * 2; u.boff = (long)layer * 15 * 1048576 + (long)pn * 256 * 1024 * 2 + pm * 512; u.row0 = layer * 7680 + pm * 256; u.col0 = pn * 256;
        } else {
            int b, pm, pn;
            if (G == 256) { const int xcd = c & 7, loc = c >> 3; b = i * 8 + xcd; pm = loc & 7; pn = loc >> 3; }
            else { const int w = (int)L; b = w >> 5; pm = w & 7; pn = (w >> 3) & 3; }
            u.aoff = (long)pm * 256 * 4096 * 2; u.boff = ((long)b * 1024 + pn * 256) * 4096 * 2; u.row0 = b * S + pm * 256; u.col0 = pn * 256;
        }
        return true;
    }
};

__device__ __forceinline__ float row_rstd(const float* rowsq, int row) {
    const f32x4* q = (const f32x4*)(rowsq + (size_t)row * 16);
    const f32x4 a = q[0], b = q[1], c = q[2], d = q[3];
    const f32x4 s = (a + b) + (c + d);
    const float t = (s[0] + s[1]) + (s[2] + s[3]);
    return __builtin_amdgcn_rsqf(t * (1.0f / D) + NORM_EPS);
}
template <int ACT> struct EpiBf16 {
    static constexpr bool PERM = true;
    bf16_t* O; int ldc; const float* rowsq; float post;
    __device__ __forceinline__ void operator()(const f32x4 (&acc)[2][2][4][2], const Unit& u, int wr, int wc, int fr, int fq) const {
        const int row0 = u.row0 + wr * 64 + fr;
        const int col0 = (ACT == 2 ? (u.col0 >> 1) : u.col0) + wc * 32 + 8 * fq;
#pragma unroll
        for (int ai = 0; ai < 2; ++ai)
#pragma unroll
            for (int m = 0; m < 4; ++m) {
                const int row = row0 + ai * HALF + m * 16;
                float sc = post; if (rowsq) sc *= row_rstd(rowsq, row);
                bf16_t* rowp = O + (size_t)row * ldc + col0;
                if (ACT == 2) {
                    f32x4 v0 = acc[ai][0][m][0] * sc, v1 = acc[ai][0][m][1] * sc, g0 = acc[ai][1][m][0] * sc, g1 = acc[ai][1][m][1] * sc;
#pragma unroll
                    for (int i = 0; i < 4; ++i) {
                        v0[i] = v0[i] * __builtin_amdgcn_rcpf(1.0f + __builtin_amdgcn_exp2f(-1.44269504089f * g0[i]));
                        v1[i] = v1[i] * __builtin_amdgcn_rcpf(1.0f + __builtin_amdgcn_exp2f(-1.44269504089f * g1[i])); }
                    u32x4 w; w.x = cvt_pk_bf16(v0[0], v0[1]); w.y = cvt_pk_bf16(v0[2], v0[3]); w.z = cvt_pk_bf16(v1[0], v1[1]); w.w = cvt_pk_bf16(v1[2], v1[3]);
                    *(u32x4*)rowp = w;
                } else {
#pragma unroll
                    for (int bj = 0; bj < 2; ++bj) {
                        f32x4 v0 = acc[ai][bj][m][0] * sc, v1 = acc[ai][bj][m][1] * sc;
                        if (ACT == 1) {
#pragma unroll
                            for (int i = 0; i < 4; ++i) { const float a = fmaxf(v0[i], 0.f), b = fmaxf(v1[i], 0.f); v0[i] = a * a; v1[i] = b * b; } }
                        u32x4 w; w.x = cvt_pk_bf16(v0[0], v0[1]); w.y = cvt_pk_bf16(v0[2], v0[3]); w.z = cvt_pk_bf16(v1[0], v1[1]); w.w = cvt_pk_bf16(v1[2], v1[3]);
                        *(u32x4*)(rowp + bj * HALF) = w; }
                }
                asm volatile("" ::: "memory");
            }
    }
};
struct EpiRes {
    static constexpr bool PERM = false;
    const float* base; float* out; bf16_t* xb; float* rowsq;
    __device__ __forceinline__ void operator()(const f32x4 (&acc)[2][2][4][2], const Unit& u, int wr, int wc, int fr, int fq) const {
        const int colb = u.col0 + wc * 32 + 4 * fq, slot = (u.col0 >> 8) * 4 + wc;
#pragma unroll
        for (int ai = 0; ai < 2; ++ai)
#pragma unroll
            for (int m = 0; m < 4; ++m) {
                const int row = u.row0 + ai * HALF + wr * 64 + m * 16 + fr; const size_t off = (size_t)row * D + colb; float ss = 0.f;
#pragma unroll
                for (int bj = 0; bj < 2; ++bj)
#pragma unroll
                    for (int n = 0; n < 2; ++n) {
                        const f32x4 bs = *(const f32x4*)(base + off + bj * HALF + n * 16); const f32x4 o = bs + acc[ai][bj][m][n];
                        *(f32x4*)(out + off + bj * HALF + n * 16) = o; ss += (o[0] * o[0] + o[1] * o[1]) + (o[2] * o[2] + o[3] * o[3]);
                        u32x2 w; w.x = cvt_pk_bf16(o[0], o[1]); w.y = cvt_pk_bf16(o[2], o[3]); *(u32x2*)(xb + off + bj * HALF + n * 16) = w; }
                ss += __shfl_xor(ss, 16); ss += __shfl_xor(ss, 32);
                if (fq == 0) rowsq[(size_t)row * 16 + slot] = ss;
                asm volatile("" ::: "memory");
            }
    }
};

template <class Epi>
__device__ __forceinline__ void gemm_phase(LAS unsigned char* lds, const Gemm g, const Order& S, const Epi& E) {
    int tid_ = threadIdx.x; asm volatile("" : "+v"(tid_));
    const int tid = tid_, wid = __builtin_amdgcn_readfirstlane(tid >> 6), lane = tid & 63, wr = wid >> 2, wc = wid & 3, fr = lane & 15, fq = lane >> 4;
    const int K = g.K, nt = K / BK;
    unsigned voffA[2], voffB[2];
#pragma unroll
    for (int i = 0; i < 2; ++i) { int R, C; stage_rc(tid * 16 + i * 8192, R, C); const int Rb = Epi::PERM ? ((R & ~31) + perm32(R & 31)) : R;
        voffA[i] = (unsigned)(R * g.lda + C) * 2u; voffB[i] = (unsigned)(Rb * g.ldb + C) * 2u; }
    const size_t kstep = (size_t)(BK * 2);
    const size_t hstepA = (size_t)HALF * g.lda * 2, hstepB = (size_t)HALF * g.ldb * 2;
    const unsigned ldsw = (unsigned)wid * 1024u;
    const int aoff = lds_byte(wr * 64 + fr, fq * 8), boff = lds_byte(wc * 32 + fr, fq * 8);
#define PG8_SA(b, h) (((b) * 2 + (h)) * HTB)
#define PG8_SB(b, h) ((4 + (b) * 2 + (h)) * HTB)
#define PG8_STAGE(bufoff, gbase, voff) do { _Pragma("unroll") for (int _i = 0; _i < 2; ++_i) \
        __builtin_amdgcn_global_load_lds((const unsigned*)((const char*)(gbase) + (voff)[_i]), (LAS unsigned*)(lds + (bufoff) + ldsw + _i * 8192), 16, 0, 0); } while (0)
#define PG8_LDA(dst, b, h) do { _Pragma("unroll") for (int m = 0; m < 4; ++m) _Pragma("unroll") for (int k = 0; k < 2; ++k) dst[m][k] = *(const LAS bf16x8*)(lds + PG8_SA(b, h) + aoff + m * 2048 + k * 1024); } while (0)
#define PG8_LDB(dst, b, h) do { _Pragma("unroll") for (int n = 0; n < 2; ++n) _Pragma("unroll") for (int k = 0; k < 2; ++k) dst[n][k] = *(const LAS bf16x8*)(lds + PG8_SB(b, h) + boff + n * 2048 + k * 1024); } while (0)
#define PG8_MMA(ai, bj, At, Bt) do { __builtin_amdgcn_s_setprio(1); _Pragma("unroll") for (int m = 0; m < 4; ++m) _Pragma("unroll") for (int n = 0; n < 2; ++n) _Pragma("unroll") for (int k = 0; k < 2; ++k) \
        acc[ai][bj][m][n] = __builtin_amdgcn_mfma_f32_16x16x32_bf16(Bt[n][k], At[m][k], acc[ai][bj][m][n], 0, 0, 0); __builtin_amdgcn_s_setprio(0); } while (0)
#define PG8_WAIT_V(n) asm volatile("s_waitcnt vmcnt(" #n ")" ::: "memory")
#define PG8_WAIT_L(n) asm volatile("s_waitcnt lgkmcnt(" #n ")" ::: "memory")
#define PG8_BAR __builtin_amdgcn_s_barrier()
#define PG8_SCHED __builtin_amdgcn_sched_barrier(0)
    Unit cur, nxt; int ui = 0;
    if (!S.next(0, cur)) return;
    f32x4 acc[2][2][4][2];
#pragma unroll
    for (int a = 0; a < 2; ++a)
#pragma unroll
        for (int b = 0; b < 2; ++b)
#pragma unroll
            for (int m = 0; m < 4; ++m)
#pragma unroll
                for (int n = 0; n < 2; ++n) acc[a][b][m][n] = (f32x4){0.f, 0.f, 0.f, 0.f};
    bf16x8 At[4][2], B0[2][2], B1[2][2];
    const char* cA = (const char*)g.A + cur.aoff; const char* cB = (const char*)g.Bt + cur.boff;
    PG8_STAGE(PG8_SB(0, 0), cB, voffB); PG8_STAGE(PG8_SB(0, 1), cB + hstepB, voffB); PG8_STAGE(PG8_SA(0, 0), cA, voffA); PG8_STAGE(PG8_SA(0, 1), cA + hstepA, voffA);
    if (wr == 1) PG8_BAR;
    PG8_WAIT_V(2); PG8_BAR;
    PG8_STAGE(PG8_SB(1, 0), cB + kstep, voffB); PG8_STAGE(PG8_SA(1, 0), cA + kstep, voffA); PG8_STAGE(PG8_SB(1, 1), cB + hstepB + kstep, voffB);
    PG8_WAIT_V(6); PG8_BAR;
    for (;;) {
        const bool has_next = S.next(ui + 1, nxt);
        const char* nA = has_next ? (const char*)g.A + nxt.aoff : cA; const char* nB = has_next ? (const char*)g.Bt + nxt.boff : cB;
        for (int t = 0; t < nt; t += 2) {
            const bool last = (t == nt - 2);
            const char* a1 = cA + (size_t)(t + 1) * kstep;
            const char* a2 = last ? nA : cA + (size_t)(t + 2) * kstep; const char* b2 = last ? nB : cB + (size_t)(t + 2) * kstep;
            const char* a3 = a2 + kstep; const char* b3 = b2 + kstep;
            PG8_LDB(B0, 0, 0); PG8_LDB(B1, 0, 1); PG8_SCHED; PG8_LDA(At, 0, 0); PG8_STAGE(PG8_SA(1, 1), a1 + hstepA, voffA);
            PG8_WAIT_V(8); PG8_WAIT_L(0); PG8_BAR; PG8_MMA(0, 0, At, B0); PG8_MMA(0, 1, At, B1); PG8_BAR; PG8_SCHED;
            PG8_LDA(At, 0, 1); PG8_STAGE(PG8_SB(0, 0), b2, voffB); PG8_STAGE(PG8_SB(0, 1), b2 + hstepB, voffB); PG8_STAGE(PG8_SA(0, 0), a2, voffA);
            PG8_WAIT_V(8); PG8_WAIT_L(0); PG8_BAR; PG8_MMA(1, 0, At, B0); PG8_MMA(1, 1, At, B1); PG8_BAR; PG8_SCHED;
            PG8_LDB(B0, 1, 0); PG8_LDB(B1, 1, 1); PG8_SCHED; PG8_LDA(At, 1, 0); PG8_STAGE(PG8_SA(0, 1), a2 + hstepA, voffA);
            PG8_WAIT_V(8); PG8_WAIT_L(0); PG8_BAR; PG8_MMA(0, 0, At, B0); PG8_MMA(0, 1, At, B1); PG8_BAR; PG8_SCHED;
            PG8_LDA(At, 1, 1); PG8_STAGE(PG8_SB(1, 0), b3, voffB); PG8_STAGE(PG8_SB(1, 1), b3 + hstepB, voffB); PG8_STAGE(PG8_SA(1, 0), a3, voffA);
            PG8_WAIT_V(8); PG8_WAIT_L(0); PG8_BAR; PG8_MMA(1, 0, At, B0); PG8_MMA(1, 1, At, B1); PG8_BAR; PG8_SCHED;
        }
        if (wr == 0) PG8_BAR;
        E(acc, cur, wr, wc, fr, fq);
        if (!has_next) break;
#pragma unroll
        for (int a = 0; a < 2; ++a)
#pragma unroll
            for (int b = 0; b < 2; ++b)
#pragma unroll
                for (int m = 0; m < 4; ++m)
#pragma unroll
                    for (int n = 0; n < 2; ++n) acc[a][b][m][n] = (f32x4){0.f, 0.f, 0.f, 0.f};
        cur = nxt; cA = nA; cB = nB; ++ui;
        if (wr == 1) PG8_BAR;
    }
    PG8_WAIT_V(0);
    PG8_BAR;
#undef PG8_SA
#undef PG8_SB
#undef PG8_STAGE
#undef PG8_LDA
#undef PG8_LDB
#undef PG8_MMA
#undef PG8_WAIT_V
#undef PG8_WAIT_L
#undef PG8_BAR
#undef PG8_SCHED
}
}


#define XB_TMO      128
#define XB_XCNT(j)  (256  + 64 * (j))
#define XB_XSUB(j)  (1280 + 64 * (j))
#define XB_XGEN(j)  (2304 + 64 * (j))
#define XB_TOP      3328
#define XB_TOPGEN   3392
#define XCD_BAR_WORDS 3456
#define XB_SPIN_CAP (1u << 22)
__device__ __forceinline__ unsigned xb_ld(unsigned* p)              { return __hip_atomic_load(p, __ATOMIC_RELAXED, __HIP_MEMORY_SCOPE_AGENT); }
__device__ __forceinline__ unsigned xb_add(unsigned* p, unsigned v) { return __hip_atomic_fetch_add(p, v, __ATOMIC_RELAXED, __HIP_MEMORY_SCOPE_AGENT); }
__device__ __forceinline__ unsigned xb_xcc_id() { return (unsigned)__builtin_amdgcn_s_getreg((3 << 11) | 20) & 0xFu; }
#define XB_SPIN(cond, bar) do { unsigned _sp = 0; while (cond) { __builtin_amdgcn_s_sleep(1); \
    if ((++_sp & 255u) == 0u) { if (xb_ld(&(bar)[XB_TMO])) break; if (_sp > XB_SPIN_CAP) { atomicAdd(&(bar)[XB_TMO], 1u); break; } } } } while (0)
struct XcdBarrier { unsigned* bar; unsigned x; volatile LAS unsigned* st; };
__device__ __forceinline__ XcdBarrier xcd_barrier_post(unsigned* bar, volatile LAS unsigned* st) {
    XcdBarrier b; b.bar = bar; b.x = xb_xcc_id(); b.st = st;
    if (threadIdx.x == 0) (void)xb_add(&bar[XB_XCNT(b.x)], 1u);
    return b;
}
__device__ __forceinline__ void xcd_barrier_complete(unsigned* bar, unsigned x, unsigned& nloc, unsigned& nx) {
    const unsigned G = gridDim.x * gridDim.y * gridDim.z;
    unsigned sum, cnt, mine, sp = 0u;
    for (;;) {
        sum = 0u; cnt = 0u; mine = 0u;
#pragma unroll
        for (unsigned j = 0; j < 16; ++j) { const unsigned c = xb_ld(&bar[XB_XCNT(j)]); sum += c; cnt += (c > 0u) ? 1u : 0u; mine = (j == x) ? c : mine; }
        if (sum == G) break;
        __builtin_amdgcn_s_sleep(1);
        if ((++sp & 255u) == 0u) { if (xb_ld(&bar[XB_TMO])) break; if (sp > XB_SPIN_CAP) { atomicAdd(&bar[XB_TMO], 1u); break; } }
    }
    nloc = mine > 0u ? mine : 1u; nx = cnt > 0u ? cnt : 1u;
}
__device__ __forceinline__ void xcd_barrier(const XcdBarrier& b) {
    asm volatile("s_waitcnt vmcnt(0)" ::: "memory");
    __syncthreads();
    if (threadIdx.x == 0) {
        unsigned* bar = b.bar;
        __builtin_amdgcn_s_waitcnt(0);
        unsigned nloc = b.st[0], nx = b.st[1];
        if (nloc == 0u) { xcd_barrier_complete(bar, b.x, nloc, nx); b.st[0] = nloc; b.st[1] = nx; }
        const unsigned old = xb_add(&bar[XB_XSUB(b.x)], 1u);
        const unsigned gen = old / nloc;
        if (old + 1u == (gen + 1u) * nloc) {
            __builtin_amdgcn_fence(__ATOMIC_RELEASE, "agent");
            asm volatile("s_waitcnt vmcnt(0)" ::: "memory");
            const unsigned og = xb_add(&bar[XB_TOP], 1u);
            const unsigned tg = og / nx;
            if (og + 1u == (tg + 1u) * nx) xb_add(&bar[XB_TOPGEN], 1u);
            else XB_SPIN(xb_ld(&bar[XB_TOPGEN]) == tg, bar);
            __builtin_amdgcn_fence(__ATOMIC_ACQUIRE, "agent");
            xb_add(&bar[XB_XGEN(b.x)], 1u);
            asm volatile("s_waitcnt vmcnt(0)" ::: "memory");
        } else {
            XB_SPIN(xb_ld(&bar[XB_XGEN(b.x)]) == gen, bar);
            __builtin_amdgcn_fence(__ATOMIC_ACQUIRE, "agent");
            asm volatile("s_waitcnt vmcnt(0)" ::: "memory");
        }
    }
    __syncthreads();
}

struct Frame { LAS unsigned char* lds; int G, bid; };
#define OPAQUE_TID() int tid_ = threadIdx.x; asm volatile("" : "+v"(tid_)); const int tid = tid_, lane = tid & 63, wave = __builtin_amdgcn_readfirstlane(tid >> 6); (void)lane; (void)wave
__device__ __forceinline__ float wave_sum(float v) {
#pragma unroll
    for (int o = 1; o < 64; o <<= 1) v += __shfl_xor(v, o);
    return v;
}
#define LDS_WAIT() asm volatile("s_waitcnt lgkmcnt(0)" ::: "memory")

__device__ __forceinline__ void transpose_item(const float* W, int K, int N, bf16_t* WT, int ldt, const float* kscale, const float* nscale, bool glu, LAS float* scr, int item, int lane) {
    const int nblk = N / 32, kb = item / nblk, nb = item % nblk, k0 = 64 * kb, n0 = 32 * nb;
    const float ns = nscale ? nscale[n0 + (lane & 31)] : 1.0f;
#pragma unroll 8
    for (int i = 0; i < 32; ++i) { const int kk = 2 * i + (lane >> 5); const float ks = kscale ? kscale[k0 + kk] : 1.0f; scr[kk * 33 + (lane & 31)] = W[(size_t)(k0 + kk) * N + n0 + (lane & 31)] * ks * ns; }
    LDS_WAIT(); asm volatile("" ::: "memory");
    int r0 = n0; if (glu) { const int c = n0 & 1023, gate = n0 >> 10; r0 = (c >> 7) * 256 + gate * 128 + (c & 127); }
    const int c = lane & 7;
#pragma unroll
    for (int j = 0; j < 4; ++j) { const int n = (lane >> 3) + 8 * j; const LAS float* s = scr + (8 * c) * 33 + n;
        u32x4 o; o.x = cvt_pk_bf16(s[0 * 33], s[1 * 33]); o.y = cvt_pk_bf16(s[2 * 33], s[3 * 33]); o.z = cvt_pk_bf16(s[4 * 33], s[5 * 33]); o.w = cvt_pk_bf16(s[6 * 33], s[7 * 33]);
        *(u32x4*)(WT + (size_t)(r0 + n) * ldt + k0 + 8 * c) = o; }
    LDS_WAIT(); asm volatile("" ::: "memory");
}

struct Args { const float* in[34]; float* out; unsigned char* ws; };

__device__ __forceinline__ void prep_phase(const Frame& F, const Args& a) {
    OPAQUE_TID();
    unsigned char* ws = a.ws;
    LAS float* scr = (LAS float*)(F.lds + wave * 16384);
    const int gw = F.bid * 8 + wave, NGW = F.G * 8;
    constexpr int I_SQ = (D / 64) * (D / 32), I_UP = (D / 64) * (FF / 32), I_DN = (FF / 64) * (D / 32), I_GRP = 4 * (256 / 64) * (256 / 32), I_CIN = (D / 64) * (2 * D / 32);
    constexpr int I_MLP = I_UP + I_DN;
    constexpr int I_POOL = I_SQ + I_GRP + I_MLP, I_CONV = I_CIN + I_SQ + I_MLP, I_FOUR = 2 * I_SQ + I_MLP;
    constexpr int NITEMS = 2 * I_POOL + I_CONV + I_FOUR;
#define JOB(W, K_, N_, DST, LDT, KS, NS, GLU) if (r < ((K_) / 64) * ((N_) / 32)) { transpose_item((W), (K_), (N_), (bf16_t*)(DST), (LDT), (KS), (NS), (GLU), scr, r, lane); continue; } r -= ((K_) / 64) * ((N_) / 32);
#define JOB_MLP(L, i0) JOB(a.in[(i0) + 1], D, FF, ws + WS_WUP + (L) * 16 * MiB, D, a.in[(i0)], nullptr, false) \
                       JOB(a.in[(i0) + 2], FF, D, ws + WS_WDN + (L) * 16 * MiB, FF, nullptr, nullptr, false)
#define JOB_POOL(L, i0) if (r < I_GRP) { const int g = r / (I_GRP / 4); transpose_item(a.in[(i0) + 2] + g * 65536, 256, 256, (bf16_t*)(ws + WS_MIXB + (L) * 3 * MiB) + g * 65536, 256, nullptr, a.in[(i0) + 3] + g * 256, false, scr, r % (I_GRP / 4), lane); continue; } r -= I_GRP; \
                        JOB(a.in[(i0) + 4], D, D, ws + WS_MIXB + (L) * 3 * MiB + MiB, D, nullptr, nullptr, false) \
                        JOB_MLP(L, (i0) + 5)
    for (int it = gw; it < NITEMS; it += NGW) {
        int r = it;
        JOB_POOL(0, 1)
        JOB(a.in[10], D, 2 * D, ws + WS_MIX + 1 * 5 * MiB, D, a.in[9], nullptr, true)
        JOB(a.in[15], D, D, ws + WS_MIXB + 1 * 3 * MiB + MiB, D, nullptr, nullptr, false)
        JOB_MLP(1, 16)
        JOB(a.in[20], D, D, ws + WS_MIX + 2 * 5 * MiB, D, a.in[19], nullptr, false)
        JOB(a.in[21], D, D, ws + WS_MIXB + 2 * 3 * MiB + MiB, D, nullptr, nullptr, false)
        JOB_MLP(2, 22)
        JOB_POOL(3, 25)
    }
#undef JOB
#undef JOB_MLP
#undef JOB_POOL
    {
        const float* x = a.in[0]; bf16_t* XB = (bf16_t*)(ws + WS_XB); float* rowsq = (float*)(ws + WS_ROWSQ);
        for (int m = gw; m < M; m += NGW) {
            const f32x4* xr = (const f32x4*)(x + (size_t)m * D) + lane; f32x4 v[4]; float s = 0.f;
#pragma unroll
            for (int j = 0; j < 4; ++j) { v[j] = xr[64 * j]; s += (v[j][0] * v[j][0] + v[j][1] * v[j][1]) + (v[j][2] * v[j][2] + v[j][3] * v[j][3]); }
            s = wave_sum(s);
            u32x2* o8 = (u32x2*)(XB + (size_t)m * D) + lane;
#pragma unroll
            for (int j = 0; j < 4; ++j) { u32x2 w; w.x = cvt_pk_bf16(v[j][0], v[j][1]); w.y = cvt_pk_bf16(v[j][2], v[j][3]); o8[64 * j] = w; }
            if (lane < 16) rowsq[(size_t)m * 16 + lane] = (lane == 0) ? s : 0.f;
        }
    }
    {
        const int gt = F.bid * 512 + tid, GT = F.G * 512;
        for (int it = gt; it < 2 * D * D / 8; it += GT) {
            const int l3 = it >> 17, e0 = (it & 131071) * 8, k = e0 >> 10;
            const float* W = l3 ? a.in[26] : a.in[2]; const float gk = (l3 ? a.in[25] : a.in[1])[k];
            const f32x4 v0 = *(const f32x4*)(W + e0), v1 = *(const f32x4*)(W + e0 + 4);
            u32x4 w; w.x = cvt_pk_bf16(v0[0] * gk, v0[1] * gk); w.y = cvt_pk_bf16(v0[2] * gk, v0[3] * gk); w.z = cvt_pk_bf16(v1[0] * gk, v1[1] * gk); w.w = cvt_pk_bf16(v1[2] * gk, v1[3] * gk);
            *(u32x4*)((bf16_t*)(ws + WS_MIX + (l3 ? 15 : 0) * MiB + 2 * MiB) + e0) = w;
        }
        bf16_t* Dcs = (bf16_t*)(ws + WS_DCS); bf16_t* T = (bf16_t*)(ws + WS_T);
        for (int it = gt; it < 2 * 256 * 256 / 8; it += GT) {
            const int e0 = it * 8, cs = e0 >> 16, j = (e0 >> 8) & 255, c0 = e0 & 255; float v[8];
#pragma unroll
            for (int k = 0; k < 8; ++k) { const float xx = (float)((j * (c0 + k)) & 255) * (1.0f / 128.0f); v[k] = (cs ? sinpif(xx) : cospif(xx)) * 0.0625f; }
            u32x4 w; w.x = cvt_pk_bf16(v[0], v[1]); w.y = cvt_pk_bf16(v[2], v[3]); w.z = cvt_pk_bf16(v[4], v[5]); w.w = cvt_pk_bf16(v[6], v[7]);
            *(u32x4*)(Dcs + e0) = w;
        }
        for (int it = gt; it < 2048 * 4096 / 8; it += GT) {
            const int e0 = it * 8, p = e0 >> 12, q = e0 & 4095, cs = q >> 11, s0 = q & 2047; float v[8];
#pragma unroll
            for (int k = 0; k < 8; ++k) { const float xx = (float)((p * (s0 + k)) & 2047) * (1.0f / 1024.0f); v[k] = (cs ? -sinpif(xx) : cospif(xx)) * 0.03125f; }
            u32x4 w; w.x = cvt_pk_bf16(v[0], v[1]); w.y = cvt_pk_bf16(v[2], v[3]); w.z = cvt_pk_bf16(v[4], v[5]); w.w = cvt_pk_bf16(v[6], v[7]);
            *(u32x4*)(T + e0) = w;
        }
    }
}

template <int HW>
__device__ __forceinline__ void pool_item(const bf16_t* U, bf16_t* P, int b, int seg, int g, int lane) {
    const int s0 = seg * 16;
    const bf16_t* base = U + (size_t)b * S * D + g * 256 + lane * 4;
    u32x2 r[16 + 2 * HW];
#pragma unroll
    for (int i = 0; i < 16 + 2 * HW; ++i) { const int t = s0 - HW + i; r[i] = (u32x2){0u, 0u}; if (t >= 0 && t < S) r[i] = *(const u32x2*)(base + (size_t)t * D); }
    float sum[4] = {0.f, 0.f, 0.f, 0.f};
#pragma unroll
    for (int i = 0; i < 2 * HW; ++i) { sum[0] += bflo(r[i][0]); sum[1] += bfhi(r[i][0]); sum[2] += bflo(r[i][1]); sum[3] += bfhi(r[i][1]); }
    bf16_t* ob = P + (size_t)(b * S + s0) * D + g * 256 + lane * 4;
#pragma unroll
    for (int o = 0; o < 16; ++o) {
        const int s = s0 + o, lo = (s - HW) > 0 ? (s - HW) : 0, hi = (s + HW) < S ? (s + HW) : S;
        const float inv = 1.0f / (float)(hi - lo);
        const u32x2 c = r[o + HW];
        u32x2 w; w.x = cvt_pk_bf16(sum[0] * inv - bflo(c[0]), sum[1] * inv - bfhi(c[0])); w.y = cvt_pk_bf16(sum[2] * inv - bflo(c[1]), sum[3] * inv - bfhi(c[1]));
        *(u32x2*)(ob + (size_t)o * D) = w;
        if (o < 15) { const u32x2 a = r[o + 2 * HW], d = r[o];
            sum[0] += bflo(a[0]) - bflo(d[0]); sum[1] += bfhi(a[0]) - bfhi(d[0]); sum[2] += bflo(a[1]) - bflo(d[1]); sum[3] += bfhi(a[1]) - bfhi(d[1]); }
    }
}
__device__ __forceinline__ void pool_phase(const Frame& F, const bf16_t* U, bf16_t* P) {
    OPAQUE_TID();
    const int gw = F.bid * 8 + wave, NGW = F.G * 8;
    for (int it = gw; it < NB * (S / 16) * 4; it += NGW) {
        const int g = it & 3, seg = (it >> 2) & (S / 16 - 1), b = it >> 9;
        if (g == 0) pool_item<1>(U, P, b, seg, 0, lane);
        else if (g == 1) pool_item<2>(U, P, b, seg, 1, lane);
        else if (g == 2) pool_item<4>(U, P, b, seg, 2, lane);
        else pool_item<8>(U, P, b, seg, 3, lane);
    }
}

__device__ __forceinline__ void conv_dma_rows(LAS unsigned char* tl, const bf16_t* V, int p0, int sbase, int ra, int nrows, int wave, int lane) {
    for (int c = wave; c < 2 * nrows; c += 8) {
        const int r = ra + (c >> 1), t = sbase - 15 + r;
        LAS unsigned char* dst = tl + (r & 63) * (D * 2) + (c & 1) * 1024;
        if (t >= 0 && t < S) __builtin_amdgcn_global_load_lds((const unsigned*)((const char*)V + ((long)(p0 - 15 + r)) * (D * 2) + (c & 1) * 1024 + lane * 16), (LAS unsigned*)dst, 16, 0, 0);
        else *(LAS u32x4*)(dst + lane * 16) = (u32x4){0u, 0u, 0u, 0u};
    }
}
__device__ __forceinline__ void conv_phase(const Frame& F, const bf16_t* V, bf16_t* Aout, const float* dw, const float* dwb, const float* lng, const float* lnb) {
    OPAQUE_TID();
    f32x2 wv[31];
    { const float* p = dw + 2 * tid;
#pragma unroll
      for (int j = 0; j < 31; ++j) { wv[j] = *(const f32x2*)p; p += D; if ((j & 3) == 3) asm volatile("" ::: "memory"); } }
    const f32x2 bb = *(const f32x2*)(dwb + 2 * tid), gg = *(const f32x2*)(lng + 2 * tid), lb = *(const f32x2*)(lnb + 2 * tid);
    LAS unsigned char* tl = F.lds;
    LAS float* part = (LAS float*)(F.lds + 131072 + 1024);
    LAS float* stat = (LAS float*)(F.lds + 131072 + 2048);
    for (int strip = F.bid; strip < M / 128; strip += F.G) {
        const int p0 = strip * 128, sbase = p0 & (S - 1);
        conv_dma_rows(tl, V, p0, sbase, 0, 46, wave, lane);
#pragma unroll 1
        for (int k = 0; k < 8; ++k) {
            asm volatile("s_waitcnt vmcnt(0) lgkmcnt(0)" ::: "memory");
            __syncthreads();
            if (k < 7) conv_dma_rows(tl, V, p0, sbase, 46 + 16 * k, 16, wave, lane);
#pragma unroll 1
            for (int h = 0; h < 2; ++h) {
                const int rb = 16 * k + 8 * h;
                const LAS unsigned char* tlt = tl + tid * 4;
                f32x2 av[8];
#pragma unroll
                for (int o = 0; o < 8; ++o) av[o] = bb;
#pragma unroll
                for (int tt = 0; tt < 38; ++tt) {
                    const unsigned w = *(const LAS unsigned*)(tlt + ((rb + tt) & 63) * (D * 2));
                    const f32x2 xv = (f32x2){bflo(w), bfhi(w)};
#pragma unroll
                    for (int o = 0; o < 8; ++o) { const int j = tt - o; if (j >= 0 && j <= 30) av[o] = __builtin_elementwise_fma(xv, wv[j], av[o]); }
                    if ((tt & 7) == 7) asm volatile("" ::: "memory");
                }
                float vals[16];
#pragma unroll
                for (int o = 0; o < 8; ++o) { vals[o] = av[o][0] + av[o][1]; vals[8 + o] = av[o][0] * av[o][0] + av[o][1] * av[o][1]; }
#pragma unroll
                for (int step = 0; step < 4; ++step) {
                    const int half = 8 >> step; const bool up = (lane >> step) & 1;
#pragma unroll
                    for (int i = 0; i < half; ++i) { const float keep = up ? vals[i + half] : vals[i], send = up ? vals[i] : vals[i + half]; vals[i] = keep + __shfl_xor(send, 1 << step); }
                }
                vals[0] += __shfl_xor(vals[0], 16); vals[0] += __shfl_xor(vals[0], 32);
                if (lane < 16) { const int l = lane; const int idx = ((l & 1) << 3) | ((l & 2) << 1) | ((l & 4) >> 1) | ((l & 8) >> 3); part[wave * 16 + idx] = vals[0]; }
                __syncthreads();
                if (tid < 8) { float s1 = 0.f, s2 = 0.f;
#pragma unroll
                    for (int w = 0; w < 8; ++w) { s1 += part[w * 16 + tid]; s2 += part[w * 16 + 8 + tid]; }
                    const float mean = s1 * (1.0f / D), var = s2 * (1.0f / D) - mean * mean;
                    stat[2 * tid] = mean; stat[2 * tid + 1] = __builtin_amdgcn_rsqf(fmaxf(var, 0.f) + LN_EPS); }
                __syncthreads();
                unsigned* op = (unsigned*)(Aout + (size_t)(p0 + rb) * D) + tid;
#pragma unroll
                for (int o = 0; o < 8; ++o) {
                    const float mean = stat[2 * o], rstd = stat[2 * o + 1];
                    const float y0 = (av[o][0] - mean) * rstd * gg[0] + lb[0], y1 = (av[o][1] - mean) * rstd * gg[1] + lb[1];
                    const float z0 = y0 * __builtin_amdgcn_rcpf(1.0f + __builtin_amdgcn_exp2f(-1.44269504089f * y0)), z1 = y1 * __builtin_amdgcn_rcpf(1.0f + __builtin_amdgcn_exp2f(-1.44269504089f * y1));
                    *op = cvt_pk_bf16(z0, z1); op += D / 2;
                    if ((o & 3) == 3) asm volatile("" ::: "memory");
                }
            }
        }
        __syncthreads();
    }
}

__device__ __forceinline__ void final_phase(const Frame& F, float* out, const float* rowsq, const float* g) {
    OPAQUE_TID();
    const int gw = F.bid * 8 + wave, NGW = F.G * 8;
    f32x4 gv[4];
#pragma unroll
    for (int j = 0; j < 4; ++j) gv[j] = ((const f32x4*)g)[lane + 64 * j];
    for (int m = gw; m < M; m += NGW) {
        const float q = lane < 16 ? rowsq[(size_t)m * 16 + lane] : 0.f;
        const float rstd = __builtin_amdgcn_rsqf(wave_sum(q) * (1.0f / D) + NORM_EPS);
        f32x4* xr = (f32x4*)(out + (size_t)m * D) + lane;
#pragma unroll
        for (int j = 0; j < 4; ++j) { const f32x4 v = xr[64 * j]; xr[64 * j] = v * rstd * gv[j]; }
    }
}

__global__ void __launch_bounds__(512, 2) fwd_megakernel(Args args) {
    extern __shared__ __attribute__((aligned(16))) unsigned char lds_raw[];
    cg::grid_group grid = cg::this_grid();
    Frame F; F.lds = (LAS unsigned char*)lds_raw; F.G = gridDim.x; F.bid = blockIdx.x;
    unsigned char* ws = args.ws;
    float* X = args.out;
    bf16_t* XB = (bf16_t*)(ws + WS_XB); float* ROWSQ = (float*)(ws + WS_ROWSQ);
    bf16_t* ACT1 = (bf16_t*)(ws + WS_ACT1); bf16_t* ACT2 = (bf16_t*)(ws + WS_ACT2); bf16_t* YT = (bf16_t*)(ws + WS_YT); bf16_t* HB = (bf16_t*)(ws + WS_H);
    volatile LAS unsigned* bst = (volatile LAS unsigned*)(F.lds + 131072 + 512);
    if (threadIdx.x < 2) bst[threadIdx.x] = 0u;
    __syncthreads();
    const XcdBarrier xbar = xcd_barrier_post((unsigned*)ws, bst);
#define GSYNC() xcd_barrier(xbar)
#define RUN_GEMM(EPI, A_, B_, LDA, LDB, K_, MODE, MR, NC, APN, ...) do { pg8::Gemm g_{(A_), (B_), (LDA), (LDB), (K_)}; pg8::Order S_; S_.init((MODE), (MR), (NC), F.G, F.bid, (LDA), (LDB), (APN)); \
        EPI E_{__VA_ARGS__}; pg8::gemm_phase<EPI>(F.lds, g_, S_, E_); } while (0)

    if (args.ws == nullptr) grid.sync();
    prep_phase(F, args);
    GSYNC();
    RUN_GEMM(pg8::EpiBf16<0>, (const bf16_t*)(ws + WS_MIXB), (const bf16_t*)(ws + WS_MIX + 2 * MiB), 256, D, 256, 3, 32 * 256, 256, 0, (bf16_t*)(ws + WS_MIX), D, nullptr, 1.0f);
    GSYNC();
#pragma unroll 1
    for (int l = 0; l < 4; ++l) {
        const bf16_t* Win = (const bf16_t*)(ws + WS_MIX + (size_t)l * 5 * MiB);
        const bf16_t* Wout = (const bf16_t*)(ws + WS_MIXB + (size_t)l * 3 * MiB + MiB);
        const float* resbase = (l == 0) ? args.in[0] : X;
        if (l == 0 || l == 3) {
            RUN_GEMM(pg8::EpiBf16<0>, XB, Win, D, D, D, 0, M, D, 0, ACT1, D, ROWSQ, 1.0f);
            GSYNC();
            pool_phase(F, ACT1, ACT2);
            GSYNC();
            RUN_GEMM(pg8::EpiRes, ACT2, Wout, D, D, D, 0, M, D, 0, resbase, X, XB, ROWSQ);
            GSYNC();
        } else if (l == 1) {
            RUN_GEMM(pg8::EpiBf16<2>, XB, Win, D, D, D, 0, M, 2 * D, 0, ACT1, D, ROWSQ, 1.0f);
            GSYNC();
            conv_phase(F, ACT1, ACT2, args.in[11], args.in[12], args.in[13], args.in[14]);
            GSYNC();
            RUN_GEMM(pg8::EpiRes, ACT2, Wout, D, D, D, 0, M, D, 0, resbase, X, XB, ROWSQ);
            GSYNC();
        } else {
            RUN_GEMM(pg8::EpiBf16<0>, XB, Win, D, D, D, 0, M, D, 0, ACT1, D, ROWSQ, 1.0f);
            GSYNC();
            RUN_GEMM(pg8::EpiBf16<0>, (const bf16_t*)(ws + WS_DCS), ACT1, 256, D, 256, 1, 256 * 1024, 256, 0, YT, 4096, nullptr, 1.0f);
            GSYNC();
            RUN_GEMM(pg8::EpiBf16<0>, (const bf16_t*)(ws + WS_T), YT, 4096, 4096, 4096, 2, 256 * 512, 256, 0, ACT2, D, nullptr, 0.70710678118f);
            GSYNC();
            RUN_GEMM(pg8::EpiRes, ACT2, Wout, D, D, D, 0, M, D, 0, resbase, X, XB, ROWSQ);
            GSYNC();
        }
        RUN_GEMM(pg8::EpiBf16<1>, XB, (const bf16_t*)(ws + WS_WUP + (size_t)l * 16 * MiB), D, D, D, 0, M, FF, 0, HB, FF, ROWSQ, 1.0f);
        GSYNC();
        RUN_GEMM(pg8::EpiRes, HB, (const bf16_t*)(ws + WS_WDN + (size_t)l * 16 * MiB), FF, FF, FF, 0, M, D, 0, X, X, XB, ROWSQ);
        GSYNC();
    }
    final_phase(F, X, ROWSQ, args.in[33]);
}

extern "C" void kernel_launch(void* const* d_in, const int* in_sizes, int n_in, void* d_out, int out_size, void* d_ws, size_t ws_size, hipStream_t stream) {
    static int grid = 0;
    if (grid == 0) {
        if (n_in != 34 || out_size != M * D || ws_size < WS_END) { fprintf(stderr, "kernel_launch: unexpected problem (n_in %d, out %d, ws %zu < %zu)\n", n_in, out_size, ws_size, (size_t)WS_END); grid = -1; return; }
        int dev = 0, cus = 0, per_cu = 0;
        if (hipGetDevice(&dev) != hipSuccess || hipDeviceGetAttribute(&cus, hipDeviceAttributeMultiprocessorCount, dev) != hipSuccess) { grid = -1; return; }
        if (hipFuncSetAttribute((const void*)fwd_megakernel, hipFuncAttributeMaxDynamicSharedMemorySize, LDS_BYTES) != hipSuccess) { fprintf(stderr, "hipFuncSetAttribute failed\n"); grid = -1; return; }
        if (hipOccupancyMaxActiveBlocksPerMultiprocessor(&per_cu, (const void*)fwd_megakernel, 512, LDS_BYTES) != hipSuccess || per_cu < 1) { fprintf(stderr, "occupancy query: %d\n", per_cu); }
        (void)hipGetLastError();
        grid = cus;
    }
    if (grid < 0) return;
    if (hipMemsetAsync(d_ws, 0, 16384, stream) != hipSuccess) { fprintf(stderr, "kernel_launch: memset failed\n"); return; }
    Args a{};
    for (int i = 0; i < 34; ++i) a.in[i] = (const float*)d_in[i];
    a.out = (float*)d_out; a.ws = (unsigned char*)d_ws;
    void* kargs[] = {&a};
    hipError_t e = hipLaunchCooperativeKernel((const void*)fwd_megakernel, dim3(grid), dim3(512), kargs, LDS_BYTES, stream);
    if (e != hipSuccess) fprintf(stderr, "cooperative launch failed: %s (grid %d)\n", hipGetErrorString(e), grid);
}
```

```cpp
#include <hip/hip_runtime.h>
#include <hip/hip_cooperative_groups.h>
#include <cstdio>
#include <cstdint>
namespace cg = cooperative_groups;

#define LAS __attribute__((address_space(3)))
typedef unsigned short bf16_t;
typedef short bf16x8 __attribute__((ext_vector_type(8)));
typedef float f32x4 __attribute__((ext_vector_type(4)));
typedef float f32x2 __attribute__((ext_vector_type(2)));
typedef unsigned u32x4 __attribute__((ext_vector_type(4)));
typedef unsigned u32x2 __attribute__((ext_vector_type(2)));

constexpr int NB = 16, S = 2048, D = 1024, M = NB * S, FF = 4096;
constexpr float NORM_EPS = 1e-6f, LN_EPS = 1e-5f;
constexpr size_t MiB = 1u << 20;
constexpr size_t WS_ROWSQ = 1 * MiB;
constexpr size_t WS_DCS = 3 * MiB;
constexpr size_t WS_T = 4 * MiB;
constexpr size_t WS_WUP = 20 * MiB;
constexpr size_t WS_WDN = 28 * MiB;
constexpr size_t WS_MIX = 84 * MiB;
constexpr size_t WS_MIXB = 104 * MiB;
constexpr size_t WS_XB = 116 * MiB;
constexpr size_t WS_H = 180 * MiB;
constexpr size_t WS_ACT1 = WS_H, WS_ACT2 = WS_H + 64 * MiB, WS_YT = WS_H + 128 * MiB, WS_ACT3 = WS_H + 128 * MiB;
constexpr size_t WS_END = WS_H + 256 * MiB;
constexpr int LDS_BYTES = 147456;

__device__ __forceinline__ unsigned cvt_pk_bf16(float lo, float hi) { unsigned r; asm volatile("v_cvt_pk_bf16_f32 %0, %1, %2" : "=v"(r) : "v"(lo), "v"(hi)); return r; }
__device__ __forceinline__ float bflo(unsigned w) { return __uint_as_float(w << 16); }
__device__ __forceinline__ float bfhi(unsigned w) { return __uint_as_float(w & 0xffff0000u); }

namespace pg8 {
constexpr int BM = 256, BK = 64, HALF = 128, HTB = HALF * BK * 2, STAGE_BYTES = 8 * HTB, NXCD = 8, WGM = 8;
__host__ __device__ __forceinline__ int lds_byte(int r, int c) { const int st = (r >> 4) * 2 + (c >> 5), rr = r & 15, cc = c & 31, ob = rr * 64 + cc * 2; return st * 1024 + (ob ^ (((ob >> 9) & 1) << 5)); }
__host__ __device__ __forceinline__ void stage_rc(int b, int& R, int& C) { const int st = b / 1024, sb = b % 1024, swz = sb ^ (((sb >> 9) & 1) << 5); R = (st >> 1) * 16 + swz / 64; C = (st & 1) * 32 + (swz % 64) / 2; }
__host__ __device__ __forceinline__ int perm32(int rho) { const int n = rho >> 4, i = rho & 15; return 8 * (i >> 2) + 4 * n + (i & 3); }

struct Unit { long aoff, boff; int row0, col0; };
struct Gemm { const bf16_t* A; const bf16_t* Bt; int lda, ldb, K; };

struct Order {
    int mode, nM, nN, nwg, G, c, lda, ldb; long a_pn_bytes;
    __device__ __forceinline__ void init(int mode_, int Mr, int Nc, int G_, int c_, int lda_, int ldb_, long apn) { mode = mode_; nM = Mr / BM; nN = Nc / BM; nwg = nM * nN; G = G_; c = c_; lda = lda_; ldb = ldb_; a_pn_bytes = apn; }
    __device__ __forceinline__ bool next(int i, Unit& u) const {
        const long L = (long)i * G + c; if (L >= nwg) return false;
        if (mode == 0) {
            int wgid = (int)L; { const int q = nwg / NXCD, r = nwg % NXCD, xcd = wgid % NXCD, off = wgid / NXCD; wgid = (xcd < r ? xcd * (q + 1) : r * (q + 1) + (xcd - r) * q) + off; }
            const int nig = WGM * nN, gid = wgid / nig, fm = gid * WGM, gsz = (nM - fm) < WGM ? (nM - fm) : WGM;
            const int pm = fm + ((wgid % nig) % gsz), pn = (wgid % nig) / gsz;
            u.aoff = (long)pm * BM * lda * 2 + (long)pn * a_pn_bytes; u.boff = (long)pn * BM * ldb * 2; u.row0 = pm * BM; u.col0 = pn * BM;
        } else if (mode == 1) {
            const int w = (int)L, cs = w & 1, pt = (w >> 1) & 7, g = (w >> 4) & 3, b = w >> 6;
            u.aoff = (long)cs * 256 * 256 * 2; u.boff = ((long)(b * S + pt * 256) * D + g * 256) * 2; u.row0 = b * 1024 + g * 256; u.col0 = cs * 2048 + pt * 256;
        } else if (mode == 3) {
            const int w = (int)L, layer = w >> 4, pm = (w >> 2) & 3, pn = w & 3;
            u.aoff = (long)layer * 9 * 1048576 + (long)pm * 256 * 256 * 2; u.boff = (long)layer * 15 * 1048576 + (long)pn * 256 * 1024 * 2 + pm * 512; u.row0 = layer * 7680 + pm * 256; u.col0 = pn * 256;
        } else {
            int b, pm, pn;
            if (G == 256) { const int xcd = c & 7, loc = c >> 3; b = i * 8 + xcd; pm = loc & 7; pn = loc >> 3; }
            else { const int w = (int)L; b = w >> 5; pm = w & 7; pn = (w >> 3) & 3; }
            u.aoff = (long)pm * 256 * 4096 * 2; u.boff = ((long)b * 1024 + pn * 256) * 4096 * 2; u.row0 = b * S + pm * 256; u.col0 = pn * 256;
        }
        return true;
    }
};

__device__ __forceinline__ float row_rstd(const float* rowsq, int row) {
    const f32x4 s = *(const f32x4*)(rowsq + (size_t)row * 4);
    const float t = (s[0] + s[1]) + (s[2] + s[3]);
    return __builtin_amdgcn_rsqf(t * (1.0f / D) + NORM_EPS);
}
template <int ACT> struct EpiBf16 {
    static constexpr bool PERM = true;
    bf16_t* O; int ldc; const float* rowsq; float post;
    __device__ __forceinline__ void operator()(const f32x4 (&acc)[2][2][4][2], const Unit& u, int wr, int wc, int fr, int fq, LAS unsigned char*, int) const {
        const int row0 = u.row0 + wr * 64 + fr;
        const int col0 = (ACT == 2 ? (u.col0 >> 1) : u.col0) + wc * 32 + 8 * fq;
        float rs[2][4];
#pragma unroll
        for (int ai = 0; ai < 2; ++ai)
#pragma unroll
            for (int m = 0; m < 4; ++m) rs[ai][m] = rowsq ? post * row_rstd(rowsq, row0 + ai * HALF + m * 16) : post;
#pragma unroll
        for (int ai = 0; ai < 2; ++ai)
#pragma unroll
            for (int m = 0; m < 4; ++m) {
                const int row = row0 + ai * HALF + m * 16;
                const float sc = rs[ai][m];
                bf16_t* rowp = O + (size_t)row * ldc + col0;
                if (ACT == 2) {
                    f32x4 v0 = acc[ai][0][m][0] * sc, v1 = acc[ai][0][m][1] * sc, g0 = acc[ai][1][m][0] * sc, g1 = acc[ai][1][m][1] * sc;
#pragma unroll
                    for (int i = 0; i < 4; ++i) {
                        v0[i] = v0[i] * __builtin_amdgcn_rcpf(1.0f + __builtin_amdgcn_exp2f(-1.44269504089f * g0[i]));
                        v1[i] = v1[i] * __builtin_amdgcn_rcpf(1.0f + __builtin_amdgcn_exp2f(-1.44269504089f * g1[i])); }
                    u32x4 w; w.x = cvt_pk_bf16(v0[0], v0[1]); w.y = cvt_pk_bf16(v0[2], v0[3]); w.z = cvt_pk_bf16(v1[0], v1[1]); w.w = cvt_pk_bf16(v1[2], v1[3]);
                    *(u32x4*)rowp = w;
                } else {
#pragma unroll
                    for (int bj = 0; bj < 2; ++bj) {
                        f32x4 v0 = acc[ai][bj][m][0] * sc, v1 = acc[ai][bj][m][1] * sc;
                        if (ACT == 1) {
#pragma unroll
                            for (int i = 0; i < 4; ++i) { const float a = fmaxf(v0[i], 0.f), b = fmaxf(v1[i], 0.f); v0[i] = a * a; v1[i] = b * b; } }
                        u32x4 w; w.x = cvt_pk_bf16(v0[0], v0[1]); w.y = cvt_pk_bf16(v0[2], v0[3]); w.z = cvt_pk_bf16(v1[0], v1[1]); w.w = cvt_pk_bf16(v1[2], v1[3]);
                        *(u32x4*)(rowp + bj * HALF) = w; }
                }
                asm volatile("" ::: "memory");
            }
    }
};
struct EpiRes {
    static constexpr bool PERM = true;
    int mode; const float* xin; bf16_t* xb; float* xout; float* rowsq;
    __device__ __forceinline__ void operator()(const f32x4 (&acc)[2][2][4][2], const Unit& u, int wr, int wc, int fr, int fq, LAS unsigned char* lds, int tid) const {
        const int colb = u.col0 + wc * 32 + 8 * fq, pn = u.col0 >> 8;
        LAS float* xch = (LAS float*)(lds + 135168);
        const size_t off0 = (size_t)(u.row0 + wr * 64 + fr) * D + colb;
        f32x4 cur[2][2], nxt[2][2];
#define EPIRES_LOAD(dst, off_) do { _Pragma("unroll") for (int bj = 0; bj < 2; ++bj) { \
            if (mode == 0) { dst[bj][0] = *(const f32x4*)(xin + (off_) + bj * HALF); dst[bj][1] = *(const f32x4*)(xin + (off_) + bj * HALF + 4); } \
            else { const u32x4 w_ = *(const u32x4*)(xb + (off_) + bj * HALF); dst[bj][0] = (f32x4){bflo(w_[0]), bfhi(w_[0]), bflo(w_[1]), bfhi(w_[1])}; dst[bj][1] = (f32x4){bflo(w_[2]), bfhi(w_[2]), bflo(w_[3]), bfhi(w_[3])}; } } } while (0)
        EPIRES_LOAD(cur, off0);
#pragma unroll
        for (int it = 0; it < 8; ++it) {
            const int ai = it >> 2, m = it & 3;
            const size_t off = off0 + (size_t)(ai * HALF + m * 16) * D;
            if (it < 7) { const size_t offn = off0 + (size_t)(((it + 1) >> 2) * HALF + ((it + 1) & 3) * 16) * D; EPIRES_LOAD(nxt, offn); }
            float ss = 0.f;
#pragma unroll
            for (int bj = 0; bj < 2; ++bj) {
                const f32x4 o0 = cur[bj][0] + acc[ai][bj][m][0], o1 = cur[bj][1] + acc[ai][bj][m][1];
                ss += ((o0[0] * o0[0] + o0[1] * o0[1]) + (o0[2] * o0[2] + o0[3] * o0[3])) + ((o1[0] * o1[0] + o1[1] * o1[1]) + (o1[2] * o1[2] + o1[3] * o1[3]));
                if (mode == 2) { *(f32x4*)(xout + off + bj * HALF) = o0; *(f32x4*)(xout + off + bj * HALF + 4) = o1; }
                else { u32x4 w; w.x = cvt_pk_bf16(o0[0], o0[1]); w.y = cvt_pk_bf16(o0[2], o0[3]); w.z = cvt_pk_bf16(o1[0], o1[1]); w.w = cvt_pk_bf16(o1[2], o1[3]); *(u32x4*)(xb + off + bj * HALF) = w; }
            }
            ss += __shfl_xor(ss, 16); ss += __shfl_xor(ss, 32);
            if (fq == 0) xch[(ai * HALF + wr * 64 + m * 16 + fr) * 4 + wc] = ss;
#pragma unroll
            for (int bj = 0; bj < 2; ++bj) { cur[bj][0] = nxt[bj][0]; cur[bj][1] = nxt[bj][1]; }
            asm volatile("" ::: "memory");
        }
#undef EPIRES_LOAD
        asm volatile("s_waitcnt lgkmcnt(0)" ::: "memory"); __builtin_amdgcn_s_barrier(); asm volatile("" ::: "memory");
        if (tid < 256) { const f32x4 v = *(const LAS f32x4*)(xch + tid * 4); rowsq[(size_t)(u.row0 + tid) * 4 + pn] = (v[0] + v[1]) + (v[2] + v[3]); }
    }
};

template <class Epi>
__device__ __forceinline__ void gemm_phase(LAS unsigned char* lds, const Gemm g, const Order& S, const Epi& E) {
    int tid_ = threadIdx.x; asm volatile("" : "+v"(tid_));
    const int tid = tid_, wid = __builtin_amdgcn_readfirstlane(tid >> 6), lane = tid & 63, wr = wid >> 2, wc = wid & 3, fr = lane & 15, fq = lane >> 4;
    const int K = g.K, nt = K / BK;
    unsigned voffA[2], voffB[2];
#pragma unroll
    for (int i = 0; i < 2; ++i) { int R, C; stage_rc(tid * 16 + i * 8192, R, C); const int Rb = Epi::PERM ? ((R & ~31) + perm32(R & 31)) : R;
        voffA[i] = (unsigned)(R * g.lda + C) * 2u; voffB[i] = (unsigned)(Rb * g.ldb + C) * 2u; }
    const size_t kstep = (size_t)(BK * 2);
    const size_t hstepA = (size_t)HALF * g.lda * 2, hstepB = (size_t)HALF * g.ldb * 2;
    const unsigned ldsw = (unsigned)wid * 1024u;
    const int aoff = lds_byte(wr * 64 + fr, fq * 8), boff = lds_byte(wc * 32 + fr, fq * 8);
#define PG8_SA(b, h) (((b) * 2 + (h)) * HTB)
#define PG8_SB(b, h) ((4 + (b) * 2 + (h)) * HTB)
#define PG8_STAGE(bufoff, gbase, voff) do { _Pragma("unroll") for (int _i = 0; _i < 2; ++_i) \
        __builtin_amdgcn_global_load_lds((const unsigned*)((const char*)(gbase) + (voff)[_i]), (LAS unsigned*)(lds + (bufoff) + ldsw + _i * 8192), 16, 0, 0); } while (0)
#define PG8_LDA(dst, b, h) do { _Pragma("unroll") for (int m = 0; m < 4; ++m) _Pragma("unroll") for (int k = 0; k < 2; ++k) dst[m][k] = *(const LAS bf16x8*)(lds + PG8_SA(b, h) + aoff + m * 2048 + k * 1024); } while (0)
#define PG8_LDB(dst, b, h) do { _Pragma("unroll") for (int n = 0; n < 2; ++n) _Pragma("unroll") for (int k = 0; k < 2; ++k) dst[n][k] = *(const LAS bf16x8*)(lds + PG8_SB(b, h) + boff + n * 2048 + k * 1024); } while (0)
#define PG8_MMA(ai, bj, At, Bt) do { __builtin_amdgcn_s_setprio(1); _Pragma("unroll") for (int m = 0; m < 4; ++m) _Pragma("unroll") for (int n = 0; n < 2; ++n) _Pragma("unroll") for (int k = 0; k < 2; ++k) \
        acc[ai][bj][m][n] = __builtin_amdgcn_mfma_f32_16x16x32_bf16(Bt[n][k], At[m][k], acc[ai][bj][m][n], 0, 0, 0); __builtin_amdgcn_s_setprio(0); } while (0)
#define PG8_WAIT_V(n) asm volatile("s_waitcnt vmcnt(" #n ")" ::: "memory")
#define PG8_WAIT_L(n) asm volatile("s_waitcnt lgkmcnt(" #n ")" ::: "memory")
#define PG8_BAR __builtin_amdgcn_s_barrier()
#define PG8_SCHED __builtin_amdgcn_sched_barrier(0)
    Unit cur, nxt; int ui = 0;
    if (!S.next(0, cur)) return;
    f32x4 acc[2][2][4][2];
#pragma unroll
    for (int a = 0; a < 2; ++a)
#pragma unroll
        for (int b = 0; b < 2; ++b)
#pragma unroll
            for (int m = 0; m < 4; ++m)
#pragma unroll
                for (int n = 0; n < 2; ++n) acc[a][b][m][n] = (f32x4){0.f, 0.f, 0.f, 0.f};
    bf16x8 At[4][2], B0[2][2], B1[2][2];
    const char* cA = (const char*)g.A + cur.aoff; const char* cB = (const char*)g.Bt + cur.boff;
    PG8_STAGE(PG8_SB(0, 0), cB, voffB); PG8_STAGE(PG8_SB(0, 1), cB + hstepB, voffB); PG8_STAGE(PG8_SA(0, 0), cA, voffA); PG8_STAGE(PG8_SA(0, 1), cA + hstepA, voffA);
    if (wr == 1) PG8_BAR;
    PG8_WAIT_V(2); PG8_BAR;
    PG8_STAGE(PG8_SB(1, 0), cB + kstep, voffB); PG8_STAGE(PG8_SA(1, 0), cA + kstep, voffA); PG8_STAGE(PG8_SB(1, 1), cB + hstepB + kstep, voffB);
    PG8_WAIT_V(6); PG8_BAR;
    for (;;) {
        const bool has_next = S.next(ui + 1, nxt);
        const char* nA = has_next ? (const char*)g.A + nxt.aoff : cA; const char* nB = has_next ? (const char*)g.Bt + nxt.boff : cB;
        for (int t = 0; t < nt; t += 2) {
            const bool last = (t == nt - 2);
            const char* a1 = cA + (size_t)(t + 1) * kstep;
            const char* a2 = last ? nA : cA + (size_t)(t + 2) * kstep; const char* b2 = last ? nB : cB + (size_t)(t + 2) * kstep;
            const char* a3 = a2 + kstep; const char* b3 = b2 + kstep;
            PG8_LDB(B0, 0, 0); PG8_LDB(B1, 0, 1); PG8_SCHED; PG8_LDA(At, 0, 0); PG8_STAGE(PG8_SA(1, 1), a1 + hstepA, voffA);
            PG8_WAIT_V(8); PG8_WAIT_L(0); PG8_BAR; PG8_MMA(0, 0, At, B0); PG8_MMA(0, 1, At, B1); PG8_BAR; PG8_SCHED;
            PG8_LDA(At, 0, 1); PG8_STAGE(PG8_SB(0, 0), b2, voffB); PG8_STAGE(PG8_SB(0, 1), b2 + hstepB, voffB); PG8_STAGE(PG8_SA(0, 0), a2, voffA);
            PG8_WAIT_V(8); PG8_WAIT_L(0); PG8_BAR; PG8_MMA(1, 0, At, B0); PG8_MMA(1, 1, At, B1); PG8_BAR; PG8_SCHED;
            PG8_LDB(B0, 1, 0); PG8_LDB(B1, 1, 1); PG8_SCHED; PG8_LDA(At, 1, 0); PG8_STAGE(PG8_SA(0, 1), a2 + hstepA, voffA);
            PG8_WAIT_V(8); PG8_WAIT_L(0); PG8_BAR; PG8_MMA(0, 0, At, B0); PG8_MMA(0, 1, At, B1); PG8_BAR; PG8_SCHED;
            PG8_LDA(At, 1, 1); PG8_STAGE(PG8_SB(1, 0), b3, voffB); PG8_STAGE(PG8_SB(1, 1), b3 + hstepB, voffB); PG8_STAGE(PG8_SA(1, 0), a3, voffA);
            PG8_WAIT_V(8); PG8_WAIT_L(0); PG8_BAR; PG8_MMA(1, 0, At, B0); PG8_MMA(1, 1, At, B1); PG8_BAR; PG8_SCHED;
        }
        if (wr == 0) PG8_BAR;
        E(acc, cur, wr, wc, fr, fq, lds, tid);
        if (!has_next) break;
#pragma unroll
        for (int a = 0; a < 2; ++a)
#pragma unroll
            for (int b = 0; b < 2; ++b)
#pragma unroll
                for (int m = 0; m < 4; ++m)
#pragma unroll
                    for (int n = 0; n < 2; ++n) acc[a][b][m][n] = (f32x4){0.f, 0.f, 0.f, 0.f};
        cur = nxt; cA = nA; cB = nB; ++ui;
        if (wr == 1) PG8_BAR;
    }
    PG8_WAIT_V(0);
    PG8_BAR;
#undef PG8_SA
#undef PG8_SB
#undef PG8_STAGE
#undef PG8_LDA
#undef PG8_LDB
#undef PG8_MMA
#undef PG8_WAIT_V
#undef PG8_WAIT_L
#undef PG8_BAR
#undef PG8_SCHED
}
}


#define XB_TMO      128
#define XB_XCNT(j)  (256  + 64 * (j))
#define XB_XSUB(j)  (1280 + 64 * (j))
#define XB_XGEN(j)  (2304 + 64 * (j))
#define XB_TOP      3328
#define XB_TOPGEN   3392
#define XCD_BAR_WORDS 3456
#define XB_SPIN_CAP (1u << 22)
__device__ __forceinline__ unsigned xb_ld(unsigned* p)              { return __hip_atomic_load(p, __ATOMIC_RELAXED, __HIP_MEMORY_SCOPE_AGENT); }
__device__ __forceinline__ unsigned xb_add(unsigned* p, unsigned v) { return __hip_atomic_fetch_add(p, v, __ATOMIC_RELAXED, __HIP_MEMORY_SCOPE_AGENT); }
__device__ __forceinline__ unsigned xb_xcc_id() { return (unsigned)__builtin_amdgcn_s_getreg((3 << 11) | 20) & 0xFu; }
#define XB_SPIN(cond, bar) do { unsigned _sp = 0; while (cond) { __builtin_amdgcn_s_sleep(1); \
    if ((++_sp & 255u) == 0u) { if (xb_ld(&(bar)[XB_TMO])) break; if (_sp > XB_SPIN_CAP) { atomicAdd(&(bar)[XB_TMO], 1u); break; } } } } while (0)
struct XcdBarrier { unsigned* bar; unsigned x; volatile LAS unsigned* st; };
__device__ __forceinline__ XcdBarrier xcd_barrier_post(unsigned* bar, volatile LAS unsigned* st) {
    XcdBarrier b; b.bar = bar; b.x = xb_xcc_id(); b.st = st;
    if (threadIdx.x == 0) (void)xb_add(&bar[XB_XCNT(b.x)], 1u);
    return b;
}
__device__ __forceinline__ void xcd_barrier_complete(unsigned* bar, unsigned x, unsigned& nloc, unsigned& nx) {
    const unsigned G = gridDim.x * gridDim.y * gridDim.z;
    unsigned sum, cnt, mine, sp = 0u;
    for (;;) {
        sum = 0u; cnt = 0u; mine = 0u;
#pragma unroll
        for (unsigned j = 0; j < 16; ++j) { const unsigned c = xb_ld(&bar[XB_XCNT(j)]); sum += c; cnt += (c > 0u) ? 1u : 0u; mine = (j == x) ? c : mine; }
        if (sum == G) break;
        __builtin_amdgcn_s_sleep(1);
        if ((++sp & 255u) == 0u) { if (xb_ld(&bar[XB_TMO])) break; if (sp > XB_SPIN_CAP) { atomicAdd(&bar[XB_TMO], 1u); break; } }
    }
    nloc = mine > 0u ? mine : 1u; nx = cnt > 0u ? cnt : 1u;
}
__device__ __forceinline__ void xcd_barrier(const XcdBarrier& b) {
    asm volatile("s_waitcnt vmcnt(0)" ::: "memory");
    __syncthreads();
    if (threadIdx.x == 0) {
        unsigned* bar = b.bar;
        __builtin_amdgcn_s_waitcnt(0);
        unsigned nloc = b.st[0], nx = b.st[1];
        if (nloc == 0u) { xcd_barrier_complete(bar, b.x, nloc, nx); b.st[0] = nloc; b.st[1] = nx; }
        const unsigned old = xb_add(&bar[XB_XSUB(b.x)], 1u);
        const unsigned gen = old / nloc;
        if (old + 1u == (gen + 1u) * nloc) {
            __builtin_amdgcn_fence(__ATOMIC_RELEASE, "agent");
            asm volatile("s_waitcnt vmcnt(0)" ::: "memory");
            const unsigned og = xb_add(&bar[XB_TOP], 1u);
            const unsigned tg = og / nx;
            if (og + 1u == (tg + 1u) * nx) xb_add(&bar[XB_TOPGEN], 1u);
            else XB_SPIN(xb_ld(&bar[XB_TOPGEN]) == tg, bar);
            __builtin_amdgcn_fence(__ATOMIC_ACQUIRE, "agent");
            xb_add(&bar[XB_XGEN(b.x)], 1u);
            asm volatile("s_waitcnt vmcnt(0)" ::: "memory");
        } else {
            XB_SPIN(xb_ld(&bar[XB_XGEN(b.x)]) == gen, bar);
            __builtin_amdgcn_fence(__ATOMIC_ACQUIRE, "agent");
            asm volatile("s_waitcnt vmcnt(0)" ::: "memory");
        }
    }
    __syncthreads();
}

struct Frame { LAS unsigned char* lds; int G, bid; };
#define OPAQUE_TID() int tid_ = threadIdx.x; asm volatile("" : "+v"(tid_)); const int tid = tid_, lane = tid & 63, wave = __builtin_amdgcn_readfirstlane(tid >> 6); (void)lane; (void)wave
__device__ __forceinline__ float wave_sum(float v) {
#pragma unroll
    for (int o = 1; o < 64; o <<= 1) v += __shfl_xor(v, o);
    return v;
}
#define LDS_WAIT() asm volatile("s_waitcnt lgkmcnt(0)" ::: "memory")

__device__ __forceinline__ void transpose_item(const float* W, int K, int N, bf16_t* WT, int ldt, const float* kscale, const float* nscale, bool glu, LAS float* scr, int item, int lane) {
    const int nblk = N / 32, kb = item / nblk, nb = item % nblk, k0 = 64 * kb, n0 = 32 * nb;
    const float ns = nscale ? nscale[n0 + (lane & 31)] : 1.0f;
#pragma unroll 8
    for (int i = 0; i < 32; ++i) { const int kk = 2 * i + (lane >> 5); const float ks = kscale ? kscale[k0 + kk] : 1.0f; scr[kk * 33 + (lane & 31)] = W[(size_t)(k0 + kk) * N + n0 + (lane & 31)] * ks * ns; }
    LDS_WAIT(); asm volatile("" ::: "memory");
    int r0 = n0; if (glu) { const int c = n0 & 1023, gate = n0 >> 10; r0 = (c >> 7) * 256 + gate * 128 + (c & 127); }
    const int c = lane & 7;
#pragma unroll
    for (int j = 0; j < 4; ++j) { const int n = (lane >> 3) + 8 * j; const LAS float* s = scr + (8 * c) * 33 + n;
        u32x4 o; o.x = cvt_pk_bf16(s[0 * 33], s[1 * 33]); o.y = cvt_pk_bf16(s[2 * 33], s[3 * 33]); o.z = cvt_pk_bf16(s[4 * 33], s[5 * 33]); o.w = cvt_pk_bf16(s[6 * 33], s[7 * 33]);
        *(u32x4*)(WT + (size_t)(r0 + n) * ldt + k0 + 8 * c) = o; }
    LDS_WAIT(); asm volatile("" ::: "memory");
}

struct Args { const float* in[34]; float* out; unsigned char* ws; };

__device__ __forceinline__ void prep_phase(const Frame& F, const Args& a) {
    OPAQUE_TID();
    unsigned char* ws = a.ws;
    LAS float* scr = (LAS float*)(F.lds + wave * 16384);
    const int gw = F.bid * 8 + wave, NGW = F.G * 8;
    constexpr int I_SQ = (D / 64) * (D / 32), I_UP = (D / 64) * (FF / 32), I_DN = (FF / 64) * (D / 32), I_GRP = 4 * (256 / 64) * (256 / 32), I_CIN = (D / 64) * (2 * D / 32);
    constexpr int I_MLP = I_UP + I_DN;
    constexpr int I_POOL = I_SQ + I_GRP + I_MLP, I_CONV = I_CIN + I_SQ + I_MLP, I_FOUR = 2 * I_SQ + I_MLP;
    constexpr int NITEMS = 2 * I_POOL + I_CONV + I_FOUR;
#define JOB(W, K_, N_, DST, LDT, KS, NS, GLU) if (r < ((K_) / 64) * ((N_) / 32)) { transpose_item((W), (K_), (N_), (bf16_t*)(DST), (LDT), (KS), (NS), (GLU), scr, r, lane); continue; } r -= ((K_) / 64) * ((N_) / 32);
#define JOB_MLP(L, i0) JOB(a.in[(i0) + 1], D, FF, ws + WS_WUP + (L) * 16 * MiB, D, a.in[(i0)], nullptr, false) \
                       JOB(a.in[(i0) + 2], FF, D, ws + WS_WDN + (L) * 16 * MiB, FF, nullptr, nullptr, false)
#define JOB_POOL(L, i0) if (r < I_GRP) { const int g = r / (I_GRP / 4); transpose_item(a.in[(i0) + 2] + g * 65536, 256, 256, (bf16_t*)(ws + WS_MIXB + (L) * 3 * MiB) + g * 65536, 256, nullptr, a.in[(i0) + 3] + g * 256, false, scr, r % (I_GRP / 4), lane); continue; } r -= I_GRP; \
                        JOB(a.in[(i0) + 4], D, D, ws + WS_MIXB + (L) * 3 * MiB + MiB, D, nullptr, nullptr, false) \
                        JOB_MLP(L, (i0) + 5)
    for (int it = gw; it < NITEMS; it += NGW) {
        int r = it;
        JOB_POOL(0, 1)
        JOB(a.in[10], D, 2 * D, ws + WS_MIX + 1 * 5 * MiB, D, a.in[9], nullptr, true)
        JOB(a.in[15], D, D, ws + WS_MIXB + 1 * 3 * MiB + MiB, D, nullptr, nullptr, false)
        JOB_MLP(1, 16)
        JOB(a.in[20], D, D, ws + WS_MIX + 2 * 5 * MiB, D, a.in[19], nullptr, false)
        JOB(a.in[21], D, D, ws + WS_MIXB + 2 * 3 * MiB + MiB, D, nullptr, nullptr, false)
        JOB_MLP(2, 22)
        JOB_POOL(3, 25)
    }
#undef JOB
#undef JOB_MLP
#undef JOB_POOL
    {
        const float* x = a.in[0]; bf16_t* XB = (bf16_t*)(ws + WS_XB); float* rowsq = (float*)(ws + WS_ROWSQ);
        for (int m = gw; m < M; m += NGW) {
            const f32x4* xr = (const f32x4*)(x + (size_t)m * D) + lane; f32x4 v[4]; float s = 0.f;
#pragma unroll
            for (int j = 0; j < 4; ++j) { v[j] = xr[64 * j]; s += (v[j][0] * v[j][0] + v[j][1] * v[j][1]) + (v[j][2] * v[j][2] + v[j][3] * v[j][3]); }
            s = wave_sum(s);
            u32x2* o8 = (u32x2*)(XB + (size_t)m * D) + lane;
#pragma unroll
            for (int j = 0; j < 4; ++j) { u32x2 w; w.x = cvt_pk_bf16(v[j][0], v[j][1]); w.y = cvt_pk_bf16(v[j][2], v[j][3]); o8[64 * j] = w; }
            if (lane < 4) rowsq[(size_t)m * 4 + lane] = (lane == 0) ? s : 0.f;
        }
    }
    {
        const int gt = F.bid * 512 + tid, GT = F.G * 512;
        for (int it = gt; it < 2 * D * D / 8; it += GT) {
            const int l3 = it >> 17, e0 = (it & 131071) * 8, k = e0 >> 10;
            const float* W = l3 ? a.in[26] : a.in[2]; const float gk = (l3 ? a.in[25] : a.in[1])[k];
            const f32x4 v0 = *(const f32x4*)(W + e0), v1 = *(const f32x4*)(W + e0 + 4);
            u32x4 w; w.x = cvt_pk_bf16(v0[0] * gk, v0[1] * gk); w.y = cvt_pk_bf16(v0[2] * gk, v0[3] * gk); w.z = cvt_pk_bf16(v1[0] * gk, v1[1] * gk); w.w = cvt_pk_bf16(v1[2] * gk, v1[3] * gk);
            *(u32x4*)((bf16_t*)(ws + WS_MIX + (l3 ? 15 : 0) * MiB + 2 * MiB) + e0) = w;
        }
        bf16_t* Dcs = (bf16_t*)(ws + WS_DCS); bf16_t* T = (bf16_t*)(ws + WS_T);
        for (int it = gt; it < 2 * 256 * 256 / 8; it += GT) {
            const int e0 = it * 8, cs = e0 >> 16, j = (e0 >> 8) & 255, c0 = e0 & 255; float v[8];
#pragma unroll
            for (int k = 0; k < 8; ++k) { const float xx = (float)((j * (c0 + k)) & 255) * (1.0f / 128.0f); v[k] = (cs ? sinpif(xx) : cospif(xx)) * 0.0625f; }
            u32x4 w; w.x = cvt_pk_bf16(v[0], v[1]); w.y = cvt_pk_bf16(v[2], v[3]); w.z = cvt_pk_bf16(v[4], v[5]); w.w = cvt_pk_bf16(v[6], v[7]);
            *(u32x4*)(Dcs + e0) = w;
        }
        for (int it = gt; it < 2048 * 4096 / 8; it += GT) {
            const int e0 = it * 8, p = e0 >> 12, q = e0 & 4095, cs = q >> 11, s0 = q & 2047; float v[8];
#pragma unroll
            for (int k = 0; k < 8; ++k) { const float xx = (float)((p * (s0 + k)) & 2047) * (1.0f / 1024.0f); v[k] = (cs ? -sinpif(xx) : cospif(xx)) * 0.03125f; }
            u32x4 w; w.x = cvt_pk_bf16(v[0], v[1]); w.y = cvt_pk_bf16(v[2], v[3]); w.z = cvt_pk_bf16(v[4], v[5]); w.w = cvt_pk_bf16(v[6], v[7]);
            *(u32x4*)(T + e0) = w;
        }
    }
}

template <int HW>
__device__ __forceinline__ void pool_item(const bf16_t* U, bf16_t* P, int b, int seg, int g, int lane) {
    const int s0 = seg * 16;
    const bf16_t* base = U + (size_t)b * S * D + g * 256 + lane * 4;
    u32x2 r[16 + 2 * HW];
#pragma unroll
    for (int i = 0; i < 16 + 2 * HW; ++i) { const int t = s0 - HW + i; r[i] = (u32x2){0u, 0u}; if (t >= 0 && t < S) r[i] = *(const u32x2*)(base + (size_t)t * D); }
    float sum[4] = {0.f, 0.f, 0.f, 0.f};
#pragma unroll
    for (int i = 0; i < 2 * HW; ++i) { sum[0] += bflo(r[i][0]); sum[1] += bfhi(r[i][0]); sum[2] += bflo(r[i][1]); sum[3] += bfhi(r[i][1]); }
    bf16_t* ob = P + (size_t)(b * S + s0) * D + g * 256 + lane * 4;
#pragma unroll
    for (int o = 0; o < 16; ++o) {
        const int s = s0 + o, lo = (s - HW) > 0 ? (s - HW) : 0, hi = (s + HW) < S ? (s + HW) : S;
        const float inv = 1.0f / (float)(hi - lo);
        const u32x2 c = r[o + HW];
        u32x2 w; w.x = cvt_pk_bf16(sum[0] * inv - bflo(c[0]), sum[1] * inv - bfhi(c[0])); w.y = cvt_pk_bf16(sum[2] * inv - bflo(c[1]), sum[3] * inv - bfhi(c[1]));
        *(u32x2*)(ob + (size_t)o * D) = w;
        if (o < 15) { const u32x2 a = r[o + 2 * HW], d = r[o];
            sum[0] += bflo(a[0]) - bflo(d[0]); sum[1] += bfhi(a[0]) - bfhi(d[0]); sum[2] += bflo(a[1]) - bflo(d[1]); sum[3] += bfhi(a[1]) - bfhi(d[1]); }
    }
}
__device__ __forceinline__ void pool_phase(const Frame& F, const bf16_t* U, bf16_t* P) {
    OPAQUE_TID();
    const int gw = F.bid * 8 + wave, NGW = F.G * 8;
    for (int it = gw; it < NB * (S / 16) * 4; it += NGW) {
        const int g = it & 3, seg = (it >> 2) & (S / 16 - 1), b = it >> 9;
        if (g == 0) pool_item<1>(U, P, b, seg, 0, lane);
        else if (g == 1) pool_item<2>(U, P, b, seg, 1, lane);
        else if (g == 2) pool_item<4>(U, P, b, seg, 2, lane);
        else pool_item<8>(U, P, b, seg, 3, lane);
    }
}

__device__ __forceinline__ void conv_dma_rows(LAS unsigned char* tl, const bf16_t* V, int p0, int sbase, int ra, int nrows, int wave, int lane) {
    for (int c = wave; c < 2 * nrows; c += 8) {
        const int r = ra + (c >> 1), t = sbase - 15 + r;
        LAS unsigned char* dst = tl + (r & 63) * (D * 2) + (c & 1) * 1024;
        if (t >= 0 && t < S) __builtin_amdgcn_global_load_lds((const unsigned*)((const char*)V + ((long)(p0 - 15 + r)) * (D * 2) + (c & 1) * 1024 + lane * 16), (LAS unsigned*)dst, 16, 0, 0);
        else *(LAS u32x4*)(dst + lane * 16) = (u32x4){0u, 0u, 0u, 0u};
    }
}
__device__ __forceinline__ void conv_phase(const Frame& F, const bf16_t* V, bf16_t* Aout, const float* dw, const float* dwb, const float* lng, const float* lnb) {
    OPAQUE_TID();
    f32x2 wv[31];
    { const float* p = dw + 2 * tid;
#pragma unroll
      for (int j = 0; j < 31; ++j) { wv[j] = *(const f32x2*)p; p += D; if ((j & 3) == 3) asm volatile("" ::: "memory"); } }
    const f32x2 bb = *(const f32x2*)(dwb + 2 * tid), gg = *(const f32x2*)(lng + 2 * tid), lb = *(const f32x2*)(lnb + 2 * tid);
    LAS unsigned char* tl = F.lds;
    LAS float* part = (LAS float*)(F.lds + 131072 + 1024);
    LAS float* stat = (LAS float*)(F.lds + 131072 + 2048);
    for (int strip = F.bid; strip < M / 128; strip += F.G) {
        const int p0 = strip * 128, sbase = p0 & (S - 1);
        conv_dma_rows(tl, V, p0, sbase, 0, 46, wave, lane);
#pragma unroll 1
        for (int k = 0; k < 8; ++k) {
            asm volatile("s_waitcnt vmcnt(0) lgkmcnt(0)" ::: "memory");
            __syncthreads();
            if (k < 7) conv_dma_rows(tl, V, p0, sbase, 46 + 16 * k, 16, wave, lane);
#pragma unroll 1
            for (int h = 0; h < 2; ++h) {
                const int rb = 16 * k + 8 * h;
                const LAS unsigned char* tlt = tl + tid * 4;
                f32x2 av[8];
#pragma unroll
                for (int o = 0; o < 8; ++o) av[o] = bb;
#pragma unroll
                for (int tt = 0; tt < 38; ++tt) {
                    const unsigned w = *(const LAS unsigned*)(tlt + ((rb + tt) & 63) * (D * 2));
                    const f32x2 xv = (f32x2){bflo(w), bfhi(w)};
#pragma unroll
                    for (int o = 0; o < 8; ++o) { const int j = tt - o; if (j >= 0 && j <= 30) av[o] = __builtin_elementwise_fma(xv, wv[j], av[o]); }
                    if ((tt & 7) == 7) asm volatile("" ::: "memory");
                }
                float vals[16];
#pragma unroll
                for (int o = 0; o < 8; ++o) { vals[o] = av[o][0] + av[o][1]; vals[8 + o] = av[o][0] * av[o][0] + av[o][1] * av[o][1]; }
#pragma unroll
                for (int step = 0; step < 4; ++step) {
                    const int half = 8 >> step; const bool up = (lane >> step) & 1;
#pragma unroll
                    for (int i = 0; i < half; ++i) { const float keep = up ? vals[i + half] : vals[i], send = up ? vals[i] : vals[i + half]; vals[i] = keep + __shfl_xor(send, 1 << step); }
                }
                vals[0] += __shfl_xor(vals[0], 16); vals[0] += __shfl_xor(vals[0], 32);
                if (lane < 16) { const int l = lane; const int idx = ((l & 1) << 3) | ((l & 2) << 1) | ((l & 4) >> 1) | ((l & 8) >> 3); part[wave * 16 + idx] = vals[0]; }
                __syncthreads();
                if (tid < 8) { float s1 = 0.f, s2 = 0.f;
#pragma unroll
                    for (int w = 0; w < 8; ++w) { s1 += part[w * 16 + tid]; s2 += part[w * 16 + 8 + tid]; }
                    const float mean = s1 * (1.0f / D), var = s2 * (1.0f / D) - mean * mean;
                    stat[2 * tid] = mean; stat[2 * tid + 1] = __builtin_amdgcn_rsqf(fmaxf(var, 0.f) + LN_EPS); }
                __syncthreads();
                unsigned* op = (unsigned*)(Aout + (size_t)(p0 + rb) * D) + tid;
#pragma unroll
                for (int o = 0; o < 8; ++o) {
                    const float mean = stat[2 * o], rstd = stat[2 * o + 1];
                    const float y0 = (av[o][0] - mean) * rstd * gg[0] + lb[0], y1 = (av[o][1] - mean) * rstd * gg[1] + lb[1];
                    const float z0 = y0 * __builtin_amdgcn_rcpf(1.0f + __builtin_amdgcn_exp2f(-1.44269504089f * y0)), z1 = y1 * __builtin_amdgcn_rcpf(1.0f + __builtin_amdgcn_exp2f(-1.44269504089f * y1));
                    *op = cvt_pk_bf16(z0, z1); op += D / 2;
                    if ((o & 3) == 3) asm volatile("" ::: "memory");
                }
            }
        }
        __syncthreads();
    }
}

__device__ __forceinline__ void final_phase(const Frame& F, float* out, const float* rowsq, const float* g) {
    OPAQUE_TID();
    const int gw = F.bid * 8 + wave, NGW = F.G * 8;
    f32x4 gv[4];
#pragma unroll
    for (int j = 0; j < 4; ++j) gv[j] = ((const f32x4*)g)[lane + 64 * j];
    for (int m = gw; m < M; m += NGW) {
        const float q = lane < 4 ? rowsq[(size_t)m * 4 + lane] : 0.f;
        const float rstd = __builtin_amdgcn_rsqf(wave_sum(q) * (1.0f / D) + NORM_EPS);
        f32x4* xr = (f32x4*)(out + (size_t)m * D) + lane;
#pragma unroll
        for (int j = 0; j < 4; ++j) { const f32x4 v = xr[64 * j]; xr[64 * j] = v * rstd * gv[j]; }
    }
}

__global__ void __launch_bounds__(512, 2) fwd_megakernel(Args args) {
    extern __shared__ __attribute__((aligned(16))) unsigned char lds_raw[];
    cg::grid_group grid = cg::this_grid();
    Frame F; F.lds = (LAS unsigned char*)lds_raw; F.G = gridDim.x; F.bid = blockIdx.x;
    unsigned char* ws = args.ws;
    float* X = args.out;
    bf16_t* XB = (bf16_t*)(ws + WS_XB); float* ROWSQ = (float*)(ws + WS_ROWSQ);
    bf16_t* ACT1 = (bf16_t*)(ws + WS_ACT1); bf16_t* ACT2 = (bf16_t*)(ws + WS_ACT2); bf16_t* YT = (bf16_t*)(ws + WS_YT); bf16_t* HB = (bf16_t*)(ws + WS_H);
    volatile LAS unsigned* bst = (volatile LAS unsigned*)(F.lds + 131072 + 512);
    if (threadIdx.x < 2) bst[threadIdx.x] = 0u;
    __syncthreads();
    const XcdBarrier xbar = xcd_barrier_post((unsigned*)ws, bst);
#define GSYNC() xcd_barrier(xbar)
#define RUN_GEMM(EPI, A_, B_, LDA, LDB, K_, MODE, MR, NC, APN, ...) do { pg8::Gemm g_{(A_), (B_), (LDA), (LDB), (K_)}; pg8::Order S_; S_.init((MODE), (MR), (NC), F.G, F.bid, (LDA), (LDB), (APN)); \
        EPI E_{__VA_ARGS__}; pg8::gemm_phase<EPI>(F.lds, g_, S_, E_); } while (0)

    if (args.ws == nullptr) grid.sync();
    prep_phase(F, args);
    GSYNC();
    RUN_GEMM(pg8::EpiBf16<0>, (const bf16_t*)(ws + WS_MIXB), (const bf16_t*)(ws + WS_MIX + 2 * MiB), 256, D, 256, 3, 32 * 256, 256, 0, (bf16_t*)(ws + WS_MIX), D, nullptr, 1.0f);
    GSYNC();
#pragma unroll 1
    for (int l = 0; l < 4; ++l) {
        const bf16_t* Win = (const bf16_t*)(ws + WS_MIX + (size_t)l * 5 * MiB);
        const bf16_t* Wout = (const bf16_t*)(ws + WS_MIXB + (size_t)l * 3 * MiB + MiB);
        if (l == 0 || l == 3) {
            RUN_GEMM(pg8::EpiBf16<0>, XB, Win, D, D, D, 0, M, D, 0, ACT1, D, ROWSQ, 1.0f);
            GSYNC();
            pool_phase(F, ACT1, ACT2);
            GSYNC();
            RUN_GEMM(pg8::EpiRes, ACT2, Wout, D, D, D, 0, M, D, 0, (l == 0) ? 0 : 1, args.in[0], XB, X, ROWSQ);
            GSYNC();
        } else if (l == 1) {
            RUN_GEMM(pg8::EpiBf16<2>, XB, Win, D, D, D, 0, M, 2 * D, 0, ACT1, D, ROWSQ, 1.0f);
            GSYNC();
            conv_phase(F, ACT1, ACT2, args.in[11], args.in[12], args.in[13], args.in[14]);
            GSYNC();
            RUN_GEMM(pg8::EpiRes, ACT2, Wout, D, D, D, 0, M, D, 0, (l == 0) ? 0 : 1, args.in[0], XB, X, ROWSQ);
            GSYNC();
        } else {
            RUN_GEMM(pg8::EpiBf16<0>, XB, Win, D, D, D, 0, M, D, 0, ACT1, D, ROWSQ, 1.0f);
            GSYNC();
            RUN_GEMM(pg8::EpiBf16<0>, (const bf16_t*)(ws + WS_DCS), ACT1, 256, D, 256, 1, 256 * 1024, 256, 0, YT, 4096, nullptr, 1.0f);
            GSYNC();
            RUN_GEMM(pg8::EpiBf16<0>, (const bf16_t*)(ws + WS_T), YT, 4096, 4096, 4096, 2, 256 * 512, 256, 0, ACT2, D, nullptr, 0.70710678118f);
            GSYNC();
            RUN_GEMM(pg8::EpiRes, ACT2, Wout, D, D, D, 0, M, D, 0, (l == 0) ? 0 : 1, args.in[0], XB, X, ROWSQ);
            GSYNC();
        }
        RUN_GEMM(pg8::EpiBf16<1>, XB, (const bf16_t*)(ws + WS_WUP + (size_t)l * 16 * MiB), D, D, D, 0, M, FF, 0, HB, FF, ROWSQ, 1.0f);
        GSYNC();
        RUN_GEMM(pg8::EpiRes, HB, (const bf16_t*)(ws + WS_WDN + (size_t)l * 16 * MiB), FF, FF, FF, 0, M, D, 0, (l == 3) ? 2 : 1, args.in[0], XB, X, ROWSQ);
        GSYNC();
    }
    final_phase(F, X, ROWSQ, args.in[33]);
}

extern "C" void kernel_launch(void* const* d_in, const int* in_sizes, int n_in, void* d_out, int out_size, void* d_ws, size_t ws_size, hipStream_t stream) {
    static int grid = 0;
    if (grid == 0) {
        if (n_in != 34 || out_size != M * D || ws_size < WS_END) { fprintf(stderr, "kernel_launch: unexpected problem (n_in %d, out %d, ws %zu < %zu)\n", n_in, out_size, ws_size, (size_t)WS_END); grid = -1; return; }
        int dev = 0, cus = 0, per_cu = 0;
        if (hipGetDevice(&dev) != hipSuccess || hipDeviceGetAttribute(&cus, hipDeviceAttributeMultiprocessorCount, dev) != hipSuccess) { grid = -1; return; }
        if (hipFuncSetAttribute((const void*)fwd_megakernel, hipFuncAttributeMaxDynamicSharedMemorySize, LDS_BYTES) != hipSuccess) { fprintf(stderr, "hipFuncSetAttribute failed\n"); grid = -1; return; }
        if (hipOccupancyMaxActiveBlocksPerMultiprocessor(&per_cu, (const void*)fwd_megakernel, 512, LDS_BYTES) != hipSuccess || per_cu < 1) { fprintf(stderr, "occupancy query: %d\n", per_cu); }
        (void)hipGetLastError();
        grid = cus;
    }
    if (grid < 0) return;
    if (hipMemsetAsync(d_ws, 0, 16384, stream) != hipSuccess) { fprintf(stderr, "kernel_launch: memset failed\n"); return; }
    Args a{};
    for (int i = 0; i < 34; ++i) a.in[i] = (const float*)d_in[i];
    a.out = (float*)d_out; a.ws = (unsigned char*)d_ws;
    void* kargs[] = {&a};
    hipError_t e = hipLaunchCooperativeKernel((const void*)fwd_megakernel, dim3(grid), dim3(512), kargs, LDS_BYTES, stream);
    if (e != hipSuccess) fprintf(stderr, "cooperative launch failed: %s (grid %d)\n", hipGetErrorString(e), grid);
}
```

```cpp
#include <hip/hip_runtime.h>
#include <hip/hip_cooperative_groups.h>
#include <cstdio>
#include <cstdint>
namespace cg = cooperative_groups;

#define LAS __attribute__((address_space(3)))
typedef unsigned short bf16_t;
typedef short bf16x8 __attribute__((ext_vector_type(8)));
typedef float f32x4 __attribute__((ext_vector_type(4)));
typedef float f32x2 __attribute__((ext_vector_type(2)));
typedef unsigned u32x4 __attribute__((ext_vector_type(4)));
typedef unsigned u32x2 __attribute__((ext_vector_type(2)));

constexpr int NB = 16, S = 2048, D = 1024, M = NB * S, FF = 4096;
constexpr float NORM_EPS = 1e-6f, LN_EPS = 1e-5f;
constexpr size_t MiB = 1u << 20;
constexpr size_t WS_ROWSQ = 1 * MiB;
constexpr size_t WS_DCS = 3 * MiB;
constexpr size_t WS_T = 4 * MiB;
constexpr size_t WS_WUP = 20 * MiB;
constexpr size_t WS_WDN = 28 * MiB;
constexpr size_t WS_MIX = 84 * MiB;
constexpr size_t WS_MIXB = 104 * MiB;
constexpr size_t WS_XB = 116 * MiB;
constexpr size_t WS_H = 180 * MiB;
constexpr size_t WS_ACT1 = WS_H, WS_ACT2 = WS_H + 64 * MiB, WS_FF = WS_H + 64 * MiB, WS_YT = WS_H + 144 * MiB, WS_ACT3 = WS_H + 128 * MiB;
constexpr size_t WS_END = WS_H + 256 * MiB;
constexpr int LDS_BYTES = 147456;
constexpr int KFE = 1280, KF = KFE + 1024;

__device__ __forceinline__ unsigned cvt_pk_bf16(float lo, float hi) { unsigned r; asm volatile("v_cvt_pk_bf16_f32 %0, %1, %2" : "=v"(r) : "v"(lo), "v"(hi)); return r; }
__device__ __forceinline__ float bflo(unsigned w) { return __uint_as_float(w << 16); }
__device__ __forceinline__ float bfhi(unsigned w) { return __uint_as_float(w & 0xffff0000u); }

namespace pg8 {
constexpr int BM = 256, BK = 64, HALF = 128, HTB = HALF * BK * 2, STAGE_BYTES = 8 * HTB, NXCD = 8, WGM = 2;
__host__ __device__ __forceinline__ int lds_byte(int r, int c) { const int st = (r >> 4) * 2 + (c >> 5), rr = r & 15, cc = c & 31, ob = rr * 64 + cc * 2; return st * 1024 + (ob ^ (((ob >> 9) & 1) << 5)); }
__host__ __device__ __forceinline__ void stage_rc(int b, int& R, int& C) { const int st = b / 1024, sb = b % 1024, swz = sb ^ (((sb >> 9) & 1) << 5); R = (st >> 1) * 16 + swz / 64; C = (st & 1) * 32 + (swz % 64) / 2; }
__host__ __device__ __forceinline__ int perm32(int rho) { const int n = rho >> 4, i = rho & 15; return 8 * (i >> 2) + 4 * n + (i & 3); }

struct Unit { long aoff, boff; int row0, col0; };
struct Gemm { const bf16_t* A; const bf16_t* Bt; int lda, ldb, K; };

struct Order {
    int mode, nM, nN, nwg, G, c, lda, ldb; long a_pn_bytes;
    __device__ __forceinline__ void init(int mode_, int Mr, int Nc, int G_, int c_, int lda_, int ldb_, long apn) { mode = mode_; nM = Mr / BM; nN = Nc / BM; nwg = nM * nN; G = G_; c = c_; lda = lda_; ldb = ldb_; a_pn_bytes = apn; }
    __device__ __forceinline__ bool next(int i, Unit& u) const {
        const long L = (long)i * G + c; if (L >= nwg) return false;
        if (mode == 0) {
            int wgid = (int)L; { const int q = nwg / NXCD, r = nwg % NXCD, xcd = wgid % NXCD, off = wgid / NXCD; wgid = (xcd < r ? xcd * (q + 1) : r * (q + 1) + (xcd - r) * q) + off; }
            const int nig = WGM * nN, gid = wgid / nig, fm = gid * WGM, gsz = (nM - fm) < WGM ? (nM - fm) : WGM;
            const int pm = fm + ((wgid % nig) % gsz), pn = (wgid % nig) / gsz;
            u.aoff = (long)pm * BM * lda * 2 + (long)pn * a_pn_bytes; u.boff = (long)pn * BM * ldb * 2; u.row0 = pm * BM; u.col0 = pn * BM;
        } else if (mode == 1) {
            const int w = (int)L, t = w % 9, g = (w / 9) & 3, b = w / 36, cs = (t >= 5) ? 1 : 0;
            u.aoff = (long)cs * 256 * 256 * 2; u.boff = ((long)(b * KF + t * 256) * D + g * 256) * 2; u.row0 = b * 1024 + g * 256; u.col0 = t * 256;
        } else if (mode == 3) {
            const int w = (int)L, layer = w >> 4, pm = (w >> 2) & 3, pn = w & 3;
            u.aoff = (long)layer * 9 * 1048576 + (long)pm * 256 * 256 * 2; u.boff = (long)layer * 15 * 1048576 + (long)pn * 256 * 1024 * 2 + pm * 512; u.row0 = layer * 7680 + pm * 256; u.col0 = pn * 256;
        } else {
            int b, pm, pn;
            if (G == 256) { const int xcd = c & 7, loc = c >> 3; b = i * 8 + xcd; pm = loc & 7; pn = loc >> 3; }
            else { const int w = (int)L; b = w >> 5; pm = w & 7; pn = (w >> 3) & 3; }
            u.aoff = (long)pm * 256 * KF * 2; u.boff = ((long)b * 1024 + pn * 256) * KF * 2; u.row0 = b * S + pm * 256; u.col0 = pn * 256;
        }
        return true;
    }
};

__device__ __forceinline__ float row_rstd(const float* rowsq, int row) {
    const f32x4 s = *(const f32x4*)(rowsq + (size_t)row * 4);
    const float t = (s[0] + s[1]) + (s[2] + s[3]);
    return __builtin_amdgcn_rsqf(t * (1.0f / D) + NORM_EPS);
}
template <int ACT> struct EpiBf16 {
    static constexpr bool PERM = true;
    bf16_t* O; int ldc; const float* rowsq; float post;
    __device__ __forceinline__ void operator()(const f32x4 (&acc)[2][2][4][2], const Unit& u, int wr, int wc, int fr, int fq, LAS unsigned char*, int) const {
        const int row0 = u.row0 + wr * 64 + fr;
        const int col0 = (ACT == 2 ? (u.col0 >> 1) : u.col0) + wc * 32 + 8 * fq;
        float rs[2][4];
#pragma unroll
        for (int ai = 0; ai < 2; ++ai)
#pragma unroll
            for (int m = 0; m < 4; ++m) rs[ai][m] = rowsq ? post * row_rstd(rowsq, row0 + ai * HALF + m * 16) : post;
#pragma unroll
        for (int ai = 0; ai < 2; ++ai)
#pragma unroll
            for (int m = 0; m < 4; ++m) {
                const int row = row0 + ai * HALF + m * 16;
                const float sc = rs[ai][m];
                bf16_t* rowp = O + (size_t)row * ldc + col0;
                if (ACT == 2) {
                    f32x4 v0 = acc[ai][0][m][0] * sc, v1 = acc[ai][0][m][1] * sc, g0 = acc[ai][1][m][0] * sc, g1 = acc[ai][1][m][1] * sc;
#pragma unroll
                    for (int i = 0; i < 4; ++i) {
                        v0[i] = v0[i] * __builtin_amdgcn_rcpf(1.0f + __builtin_amdgcn_exp2f(-1.44269504089f * g0[i]));
                        v1[i] = v1[i] * __builtin_amdgcn_rcpf(1.0f + __builtin_amdgcn_exp2f(-1.44269504089f * g1[i])); }
                    u32x4 w; w.x = cvt_pk_bf16(v0[0], v0[1]); w.y = cvt_pk_bf16(v0[2], v0[3]); w.z = cvt_pk_bf16(v1[0], v1[1]); w.w = cvt_pk_bf16(v1[2], v1[3]);
                    *(u32x4*)rowp = w;
                } else {
#pragma unroll
                    for (int bj = 0; bj < 2; ++bj) {
                        f32x4 v0 = acc[ai][bj][m][0] * sc, v1 = acc[ai][bj][m][1] * sc;
                        if (ACT == 1) {
#pragma unroll
                            for (int i = 0; i < 4; ++i) { const float a = fmaxf(v0[i], 0.f), b = fmaxf(v1[i], 0.f); v0[i] = a * a; v1[i] = b * b; } }
                        u32x4 w; w.x = cvt_pk_bf16(v0[0], v0[1]); w.y = cvt_pk_bf16(v0[2], v0[3]); w.z = cvt_pk_bf16(v1[0], v1[1]); w.w = cvt_pk_bf16(v1[2], v1[3]);
                        *(u32x4*)(rowp + bj * HALF) = w; }
                }
                asm volatile("" ::: "memory");
            }
    }
};
struct EpiRes {
    static constexpr bool PERM = true;
    int mode; const float* xin; bf16_t* xb; float* xout; float* rowsq;
    __device__ __forceinline__ void operator()(const f32x4 (&acc)[2][2][4][2], const Unit& u, int wr, int wc, int fr, int fq, LAS unsigned char* lds, int tid) const {
        const int colb = u.col0 + wc * 32 + 8 * fq, pn = u.col0 >> 8;
        LAS float* xch = (LAS float*)(lds + 135168);
        const size_t off0 = (size_t)(u.row0 + wr * 64 + fr) * D + colb;
        f32x4 cur[2][2], nxt[2][2];
#define EPIRES_LOAD(dst, off_) do { _Pragma("unroll") for (int bj = 0; bj < 2; ++bj) { \
            if (mode == 0) { dst[bj][0] = *(const f32x4*)(xin + (off_) + bj * HALF); dst[bj][1] = *(const f32x4*)(xin + (off_) + bj * HALF + 4); } \
            else { const u32x4 w_ = *(const u32x4*)(xb + (off_) + bj * HALF); dst[bj][0] = (f32x4){bflo(w_[0]), bfhi(w_[0]), bflo(w_[1]), bfhi(w_[1])}; dst[bj][1] = (f32x4){bflo(w_[2]), bfhi(w_[2]), bflo(w_[3]), bfhi(w_[3])}; } } } while (0)
        EPIRES_LOAD(cur, off0);
#pragma unroll
        for (int it = 0; it < 8; ++it) {
            const int ai = it >> 2, m = it & 3;
            const size_t off = off0 + (size_t)(ai * HALF + m * 16) * D;
            if (it < 7) { const size_t offn = off0 + (size_t)(((it + 1) >> 2) * HALF + ((it + 1) & 3) * 16) * D; EPIRES_LOAD(nxt, offn); }
            float ss = 0.f;
#pragma unroll
            for (int bj = 0; bj < 2; ++bj) {
                const f32x4 o0 = cur[bj][0] + acc[ai][bj][m][0], o1 = cur[bj][1] + acc[ai][bj][m][1];
                ss += ((o0[0] * o0[0] + o0[1] * o0[1]) + (o0[2] * o0[2] + o0[3] * o0[3])) + ((o1[0] * o1[0] + o1[1] * o1[1]) + (o1[2] * o1[2] + o1[3] * o1[3]));
                if (mode == 2) { *(f32x4*)(xout + off + bj * HALF) = o0; *(f32x4*)(xout + off + bj * HALF + 4) = o1; }
                else { u32x4 w; w.x = cvt_pk_bf16(o0[0], o0[1]); w.y = cvt_pk_bf16(o0[2], o0[3]); w.z = cvt_pk_bf16(o1[0], o1[1]); w.w = cvt_pk_bf16(o1[2], o1[3]); *(u32x4*)(xb + off + bj * HALF) = w; }
            }
            ss += __shfl_xor(ss, 16); ss += __shfl_xor(ss, 32);
            if (fq == 0) xch[(ai * HALF + wr * 64 + m * 16 + fr) * 4 + wc] = ss;
#pragma unroll
            for (int bj = 0; bj < 2; ++bj) { cur[bj][0] = nxt[bj][0]; cur[bj][1] = nxt[bj][1]; }
            asm volatile("" ::: "memory");
        }
#undef EPIRES_LOAD
        asm volatile("s_waitcnt lgkmcnt(0)" ::: "memory"); __builtin_amdgcn_s_barrier(); asm volatile("" ::: "memory");
        if (tid < 256) { const f32x4 v = *(const LAS f32x4*)(xch + tid * 4); rowsq[(size_t)(u.row0 + tid) * 4 + pn] = (v[0] + v[1]) + (v[2] + v[3]); }
    }
};

template <class Epi>
__device__ __forceinline__ void gemm_phase(LAS unsigned char* lds, const Gemm g, const Order& S, const Epi& E, const unsigned stag = 0u) {
    int tid_ = threadIdx.x; asm volatile("" : "+v"(tid_));
    const int tid = tid_, wid = __builtin_amdgcn_readfirstlane(tid >> 6), lane = tid & 63, wr = wid >> 2, wc = wid & 3, fr = lane & 15, fq = lane >> 4;
    const int K = g.K, nt = K / BK;
    unsigned voffA[2], voffB[2];
#pragma unroll
    for (int i = 0; i < 2; ++i) { int R, C; stage_rc(tid * 16 + i * 8192, R, C); const int Rb = Epi::PERM ? ((R & ~31) + perm32(R & 31)) : R;
        voffA[i] = (unsigned)(R * g.lda + C) * 2u; voffB[i] = (unsigned)(Rb * g.ldb + C) * 2u; }
    const size_t kstep = (size_t)(BK * 2);
    const size_t hstepA = (size_t)HALF * g.lda * 2, hstepB = (size_t)HALF * g.ldb * 2;
    const unsigned ldsw = (unsigned)wid * 1024u;
    const int aoff = lds_byte(wr * 64 + fr, fq * 8), boff = lds_byte(wc * 32 + fr, fq * 8);
#define PG8_SA(b, h) (((b) * 2 + (h)) * HTB)
#define PG8_SB(b, h) ((4 + (b) * 2 + (h)) * HTB)
#define PG8_STAGE(bufoff, gbase, voff) do { _Pragma("unroll") for (int _i = 0; _i < 2; ++_i) \
        __builtin_amdgcn_global_load_lds((const unsigned*)((const char*)(gbase) + (voff)[_i]), (LAS unsigned*)(lds + (bufoff) + ldsw + _i * 8192), 16, 0, 0); } while (0)
#define PG8_LDA(dst, b, h) do { _Pragma("unroll") for (int m = 0; m < 4; ++m) _Pragma("unroll") for (int k = 0; k < 2; ++k) dst[m][k] = *(const LAS bf16x8*)(lds + PG8_SA(b, h) + aoff + m * 2048 + k * 1024); } while (0)
#define PG8_LDB(dst, b, h) do { _Pragma("unroll") for (int n = 0; n < 2; ++n) _Pragma("unroll") for (int k = 0; k < 2; ++k) dst[n][k] = *(const LAS bf16x8*)(lds + PG8_SB(b, h) + boff + n * 2048 + k * 1024); } while (0)
#define PG8_MMA(ai, bj, At, Bt) do { __builtin_amdgcn_s_setprio(1); _Pragma("unroll") for (int m = 0; m < 4; ++m) _Pragma("unroll") for (int n = 0; n < 2; ++n) _Pragma("unroll") for (int k = 0; k < 2; ++k) \
        acc[ai][bj][m][n] = __builtin_amdgcn_mfma_f32_16x16x32_bf16(Bt[n][k], At[m][k], acc[ai][bj][m][n], 0, 0, 0); __builtin_amdgcn_s_setprio(0); } while (0)
#define PG8_WAIT_V(n) asm volatile("s_waitcnt vmcnt(" #n ")" ::: "memory")
#define PG8_WAIT_L(n) asm volatile("s_waitcnt lgkmcnt(" #n ")" ::: "memory")
#define PG8_BAR __builtin_amdgcn_s_barrier()
#define PG8_SCHED __builtin_amdgcn_sched_barrier(0)
    Unit cur, nxt; int ui = 0;
    if (!S.next(0, cur)) return;
    if (stag) {
        const unsigned long long t0 = __builtin_amdgcn_s_memrealtime(), dl = (unsigned long long)(((unsigned)cur.col0 >> 8) & 3u) * stag;
        while (__builtin_amdgcn_s_memrealtime() - t0 < dl) __builtin_amdgcn_s_sleep(8);
    }
    f32x4 acc[2][2][4][2];
#pragma unroll
    for (int a = 0; a < 2; ++a)
#pragma unroll
        for (int b = 0; b < 2; ++b)
#pragma unroll
            for (int m = 0; m < 4; ++m)
#pragma unroll
                for (int n = 0; n < 2; ++n) acc[a][b][m][n] = (f32x4){0.f, 0.f, 0.f, 0.f};
    bf16x8 At[4][2], B0[2][2], B1[2][2];
    const char* cA = (const char*)g.A + cur.aoff; const char* cB = (const char*)g.Bt + cur.boff;
    PG8_STAGE(PG8_SB(0, 0), cB, voffB); PG8_STAGE(PG8_SB(0, 1), cB + hstepB, voffB); PG8_STAGE(PG8_SA(0, 0), cA, voffA); PG8_STAGE(PG8_SA(0, 1), cA + hstepA, voffA);
    if (wr == 1) PG8_BAR;
    PG8_WAIT_V(2); PG8_BAR;
    PG8_STAGE(PG8_SB(1, 0), cB + kstep, voffB); PG8_STAGE(PG8_SA(1, 0), cA + kstep, voffA); PG8_STAGE(PG8_SB(1, 1), cB + hstepB + kstep, voffB);
    PG8_WAIT_V(6); PG8_BAR;
    for (;;) {
        const bool has_next = S.next(ui + 1, nxt);
        const char* nA = has_next ? (const char*)g.A + nxt.aoff : cA; const char* nB = has_next ? (const char*)g.Bt + nxt.boff : cB;
        for (int t = 0; t < nt; t += 2) {
            const bool last = (t == nt - 2);
            const char* a1 = cA + (size_t)(t + 1) * kstep;
            const char* a2 = last ? nA : cA + (size_t)(t + 2) * kstep; const char* b2 = last ? nB : cB + (size_t)(t + 2) * kstep;
            const char* a3 = a2 + kstep; const char* b3 = b2 + kstep;
            PG8_LDB(B0, 0, 0); PG8_LDB(B1, 0, 1); PG8_SCHED; PG8_LDA(At, 0, 0); PG8_STAGE(PG8_SA(1, 1), a1 + hstepA, voffA);
            PG8_WAIT_V(8); PG8_WAIT_L(0); PG8_BAR; PG8_MMA(0, 0, At, B0); PG8_MMA(0, 1, At, B1); PG8_BAR; PG8_SCHED;
            PG8_LDA(At, 0, 1); PG8_STAGE(PG8_SB(0, 0), b2, voffB); PG8_STAGE(PG8_SB(0, 1), b2 + hstepB, voffB); PG8_STAGE(PG8_SA(0, 0), a2, voffA);
            PG8_WAIT_V(8); PG8_WAIT_L(0); PG8_BAR; PG8_MMA(1, 0, At, B0); PG8_MMA(1, 1, At, B1); PG8_BAR; PG8_SCHED;
            PG8_LDB(B0, 1, 0); PG8_LDB(B1, 1, 1); PG8_SCHED; PG8_LDA(At, 1, 0); PG8_STAGE(PG8_SA(0, 1), a2 + hstepA, voffA);
            PG8_WAIT_V(8); PG8_WAIT_L(0); PG8_BAR; PG8_MMA(0, 0, At, B0); PG8_MMA(0, 1, At, B1); PG8_BAR; PG8_SCHED;
            PG8_LDA(At, 1, 1); PG8_STAGE(PG8_SB(1, 0), b3, voffB); PG8_STAGE(PG8_SB(1, 1), b3 + hstepB, voffB); PG8_STAGE(PG8_SA(1, 0), a3, voffA);
            PG8_WAIT_V(8); PG8_WAIT_L(0); PG8_BAR; PG8_MMA(1, 0, At, B0); PG8_MMA(1, 1, At, B1); PG8_BAR; PG8_SCHED;
        }
        if (wr == 0) PG8_BAR;
        E(acc, cur, wr, wc, fr, fq, lds, tid);
        if (!has_next) break;
#pragma unroll
        for (int a = 0; a < 2; ++a)
#pragma unroll
            for (int b = 0; b < 2; ++b)
#pragma unroll
                for (int m = 0; m < 4; ++m)
#pragma unroll
                    for (int n = 0; n < 2; ++n) acc[a][b][m][n] = (f32x4){0.f, 0.f, 0.f, 0.f};
        cur = nxt; cA = nA; cB = nB; ++ui;
        if (wr == 1) PG8_BAR;
    }
    PG8_WAIT_V(0);
    PG8_BAR;
#undef PG8_SA
#undef PG8_SB
#undef PG8_STAGE
#undef PG8_LDA
#undef PG8_LDB
#undef PG8_MMA
#undef PG8_WAIT_V
#undef PG8_WAIT_L
#undef PG8_BAR
#undef PG8_SCHED
}
}


#define XB_TMO      128
#define XB_XCNT(j)  (256  + 64 * (j))
#define XB_XSUB(j)  (1280 + 64 * (j))
#define XB_XGEN(j)  (2304 + 64 * (j))
#define XB_TOP      3328
#define XB_TOPGEN   3392
#define XCD_BAR_WORDS 3456
#define XB_SPIN_CAP (1u << 22)
__device__ __forceinline__ unsigned xb_ld(unsigned* p)              { return __hip_atomic_load(p, __ATOMIC_RELAXED, __HIP_MEMORY_SCOPE_AGENT); }
__device__ __forceinline__ unsigned xb_add(unsigned* p, unsigned v) { return __hip_atomic_fetch_add(p, v, __ATOMIC_RELAXED, __HIP_MEMORY_SCOPE_AGENT); }
__device__ __forceinline__ unsigned xb_xcc_id() { return (unsigned)__builtin_amdgcn_s_getreg((3 << 11) | 20) & 0xFu; }
#define XB_SPIN(cond, bar) do { unsigned _sp = 0; while (cond) { __builtin_amdgcn_s_sleep(1); \
    if ((++_sp & 255u) == 0u) { if (xb_ld(&(bar)[XB_TMO])) break; if (_sp > XB_SPIN_CAP) { atomicAdd(&(bar)[XB_TMO], 1u); break; } } } } while (0)
struct XcdBarrier { unsigned* bar; unsigned x; volatile LAS unsigned* st; };
__device__ __forceinline__ XcdBarrier xcd_barrier_post(unsigned* bar, volatile LAS unsigned* st) {
    XcdBarrier b; b.bar = bar; b.x = xb_xcc_id(); b.st = st;
    if (threadIdx.x == 0) (void)xb_add(&bar[XB_XCNT(b.x)], 1u);
    return b;
}
__device__ __forceinline__ void xcd_barrier_complete(unsigned* bar, unsigned x, unsigned& nloc, unsigned& nx) {
    const unsigned G = gridDim.x * gridDim.y * gridDim.z;
    unsigned sum, cnt, mine, sp = 0u;
    for (;;) {
        sum = 0u; cnt = 0u; mine = 0u;
#pragma unroll
        for (unsigned j = 0; j < 16; ++j) { const unsigned c = xb_ld(&bar[XB_XCNT(j)]); sum += c; cnt += (c > 0u) ? 1u : 0u; mine = (j == x) ? c : mine; }
        if (sum == G) break;
        __builtin_amdgcn_s_sleep(1);
        if ((++sp & 255u) == 0u) { if (xb_ld(&bar[XB_TMO])) break; if (sp > XB_SPIN_CAP) { atomicAdd(&bar[XB_TMO], 1u); break; } }
    }
    nloc = mine > 0u ? mine : 1u; nx = cnt > 0u ? cnt : 1u;
}
__device__ __forceinline__ void xcd_barrier(const XcdBarrier& b) {
    asm volatile("s_waitcnt vmcnt(0)" ::: "memory");
    __syncthreads();
    if (threadIdx.x == 0) {
        unsigned* bar = b.bar;
        __builtin_amdgcn_s_waitcnt(0);
        unsigned nloc = b.st[0], nx = b.st[1];
        if (nloc == 0u) { xcd_barrier_complete(bar, b.x, nloc, nx); b.st[0] = nloc; b.st[1] = nx; }
        const unsigned old = xb_add(&bar[XB_XSUB(b.x)], 1u);
        const unsigned gen = old / nloc;
        if (old + 1u == (gen + 1u) * nloc) {
            __builtin_amdgcn_fence(__ATOMIC_RELEASE, "agent");
            asm volatile("s_waitcnt vmcnt(0)" ::: "memory");
            const unsigned og = xb_add(&bar[XB_TOP], 1u);
            const unsigned tg = og / nx;
            if (og + 1u == (tg + 1u) * nx) xb_add(&bar[XB_TOPGEN], 1u);
            else XB_SPIN(xb_ld(&bar[XB_TOPGEN]) == tg, bar);
            __builtin_amdgcn_fence(__ATOMIC_ACQUIRE, "agent");
            xb_add(&bar[XB_XGEN(b.x)], 1u);
            asm volatile("s_waitcnt vmcnt(0)" ::: "memory");
        } else {
            XB_SPIN(xb_ld(&bar[XB_XGEN(b.x)]) == gen, bar);
            __builtin_amdgcn_fence(__ATOMIC_ACQUIRE, "agent");
            asm volatile("s_waitcnt vmcnt(0)" ::: "memory");
        }
    }
    __syncthreads();
}

struct Frame { LAS unsigned char* lds; int G, bid; };
#define OPAQUE_TID() int tid_ = threadIdx.x; asm volatile("" : "+v"(tid_)); const int tid = tid_, lane = tid & 63, wave = __builtin_amdgcn_readfirstlane(tid >> 6); (void)lane; (void)wave
__device__ __forceinline__ float wave_sum(float v) {
#pragma unroll
    for (int o = 1; o < 64; o <<= 1) v += __shfl_xor(v, o);
    return v;
}
#define LDS_WAIT() asm volatile("s_waitcnt lgkmcnt(0)" ::: "memory")

struct TrDesc { const float* W; int K, N; bf16_t* WT; int ldt; const float* kscale; const float* nscale; int glu, item; };
__device__ __forceinline__ void tr_load(const TrDesc& d, f32x4 (&v)[8], int lane) {
    const int nblk = d.N / 32, kb = d.item / nblk, nb = d.item % nblk, k0 = 64 * kb, n0 = 32 * nb, n4 = (lane & 7) * 4, kr = lane >> 3;
#pragma unroll
    for (int i = 0; i < 8; ++i) v[i] = *(const f32x4*)(d.W + (size_t)(k0 + kr + 8 * i) * d.N + n0 + n4);
}
__device__ __forceinline__ void tr_finish(const TrDesc& d, const f32x4 (&v)[8], LAS float* scr, int lane) {
    const int nblk = d.N / 32, kb = d.item / nblk, nb = d.item % nblk, k0 = 64 * kb, n0 = 32 * nb, n4 = (lane & 7) * 4, kr = lane >> 3;
    const f32x4 ns = d.nscale ? *(const f32x4*)(d.nscale + n0 + n4) : (f32x4){1.f, 1.f, 1.f, 1.f};
#pragma unroll
    for (int i = 0; i < 8; ++i) { const int kk = kr + 8 * i; const float ks = d.kscale ? d.kscale[k0 + kk] : 1.0f; const f32x4 t = v[i] * ns * ks;
        LAS float* p = scr + kk * 33 + n4; p[0] = t[0]; p[1] = t[1]; p[2] = t[2]; p[3] = t[3]; }
    LDS_WAIT(); asm volatile("" ::: "memory");
    int r0 = n0; if (d.glu) { const int c = n0 & 1023, gate = n0 >> 10; r0 = (c >> 7) * 256 + gate * 128 + (c & 127); }
    const int c = lane & 7;
#pragma unroll
    for (int j = 0; j < 4; ++j) { const int n = (lane >> 3) + 8 * j; const LAS float* q = scr + (8 * c) * 33 + n;
        u32x4 o; o.x = cvt_pk_bf16(q[0 * 33], q[1 * 33]); o.y = cvt_pk_bf16(q[2 * 33], q[3 * 33]); o.z = cvt_pk_bf16(q[4 * 33], q[5 * 33]); o.w = cvt_pk_bf16(q[6 * 33], q[7 * 33]);
        *(u32x4*)(d.WT + (size_t)(r0 + n) * d.ldt + k0 + 8 * c) = o; }
    LDS_WAIT(); asm volatile("" ::: "memory");
}

struct Args { const float* in[34]; float* out; unsigned char* ws; };

__device__ __forceinline__ void prep_phase(const Frame& F, const Args& a) {
    OPAQUE_TID();
    unsigned char* ws = a.ws;
    LAS float* scr = (LAS float*)(F.lds + wave * 16384);
    const int gw = F.bid * 8 + wave, NGW = F.G * 8;
    constexpr int I_SQ = (D / 64) * (D / 32), I_UP = (D / 64) * (FF / 32), I_DN = (FF / 64) * (D / 32), I_GRP = 4 * (256 / 64) * (256 / 32), I_CIN = (D / 64) * (2 * D / 32);
    constexpr int I_MLP = I_UP + I_DN;
    constexpr int I_POOL = I_SQ + I_GRP + I_MLP, I_CONV = I_CIN + I_SQ + I_MLP, I_FOUR = 2 * I_SQ + I_MLP;
    constexpr int NITEMS = 2 * I_POOL + I_CONV + I_FOUR;
#define JOB(W, K_, N_, DST, LDT, KS, NS, GLU) if (r < ((K_) / 64) * ((N_) / 32)) { d = TrDesc{(W), (K_), (N_), (bf16_t*)(DST), (LDT), (KS), (NS), (GLU) ? 1 : 0, r}; break; } r -= ((K_) / 64) * ((N_) / 32);
#define JOB_MLP(L, i0) JOB(a.in[(i0) + 1], D, FF, ws + WS_WUP + (L) * 16 * MiB, D, a.in[(i0)], nullptr, false) \
                       JOB(a.in[(i0) + 2], FF, D, ws + WS_WDN + (L) * 16 * MiB, FF, nullptr, nullptr, false)
#define JOB_POOL(L, i0) if (r < I_GRP) { const int g = r / (I_GRP / 4); d = TrDesc{a.in[(i0) + 2] + g * 65536, 256, 256, (bf16_t*)(ws + WS_MIXB + (L) * 3 * MiB) + g * 65536, 256, nullptr, a.in[(i0) + 3] + g * 256, 0, r % (I_GRP / 4)}; break; } r -= I_GRP; \
                        JOB(a.in[(i0) + 4], D, D, ws + WS_MIXB + (L) * 3 * MiB + MiB, D, nullptr, nullptr, false) \
                        JOB_MLP(L, (i0) + 5)
#define TR_DECODE(IT, DESC) do { TrDesc d{}; int r = (IT); do { \
        JOB_POOL(0, 1) \
        JOB(a.in[10], D, 2 * D, ws + WS_MIX + 1 * 5 * MiB, D, a.in[9], nullptr, true) \
        JOB(a.in[15], D, D, ws + WS_MIXB + 1 * 3 * MiB + MiB, D, nullptr, nullptr, false) \
        JOB_MLP(1, 16) \
        JOB(a.in[20], D, D, ws + WS_MIX + 2 * 5 * MiB, D, a.in[19], nullptr, false) \
        JOB(a.in[21], D, D, ws + WS_MIXB + 2 * 3 * MiB + MiB, D, nullptr, nullptr, false) \
        JOB_MLP(2, 22) \
        JOB_POOL(3, 25) } while (0); (DESC) = d; } while (0)
    if (gw < NITEMS) {
        TrDesc cur; f32x4 v[8];
        TR_DECODE(gw, cur); tr_load(cur, v, lane);
        for (int it = gw; it < NITEMS; it += NGW) {
            const bool hn = it + NGW < NITEMS;
            TrDesc nxt = cur; f32x4 vn[8];
            if (hn) TR_DECODE(it + NGW, nxt);
            tr_load(nxt, vn, lane);
            tr_finish(cur, v, scr, lane);
            cur = nxt;
#pragma unroll
            for (int i = 0; i < 8; ++i) v[i] = vn[i];
        }
    }
#undef JOB
#undef JOB_MLP
#undef JOB_POOL
#undef TR_DECODE
    {
        const float* x = a.in[0]; bf16_t* XB = (bf16_t*)(ws + WS_XB); float* rowsq = (float*)(ws + WS_ROWSQ);
        for (int m = gw; m < M; m += 2 * NGW) {
            const int m2 = (m + NGW < M) ? m + NGW : m;
            const f32x4* xr = (const f32x4*)(x + (size_t)m * D) + lane; const f32x4* xr2 = (const f32x4*)(x + (size_t)m2 * D) + lane; f32x4 v[4], v2[4]; float s = 0.f, s2 = 0.f;
#pragma unroll
            for (int j = 0; j < 4; ++j) { v[j] = xr[64 * j]; v2[j] = xr2[64 * j]; }
#pragma unroll
            for (int j = 0; j < 4; ++j) { s += (v[j][0] * v[j][0] + v[j][1] * v[j][1]) + (v[j][2] * v[j][2] + v[j][3] * v[j][3]); s2 += (v2[j][0] * v2[j][0] + v2[j][1] * v2[j][1]) + (v2[j][2] * v2[j][2] + v2[j][3] * v2[j][3]); }
            s = wave_sum(s); s2 = wave_sum(s2);
            u32x2* o8 = (u32x2*)(XB + (size_t)m * D) + lane; u32x2* o82 = (u32x2*)(XB + (size_t)m2 * D) + lane;
#pragma unroll
            for (int j = 0; j < 4; ++j) { u32x2 w; w.x = cvt_pk_bf16(v[j][0], v[j][1]); w.y = cvt_pk_bf16(v[j][2], v[j][3]); o8[64 * j] = w;
                                          u32x2 w2; w2.x = cvt_pk_bf16(v2[j][0], v2[j][1]); w2.y = cvt_pk_bf16(v2[j][2], v2[j][3]); o82[64 * j] = w2; }
            if (lane < 4) { rowsq[(size_t)m * 4 + lane] = (lane == 0) ? s : 0.f; rowsq[(size_t)m2 * 4 + lane] = (lane == 0) ? s2 : 0.f; }
        }
    }
    {
        const int gt = F.bid * 512 + tid, GT = F.G * 512;
        for (int it = gt; it < 2 * D * D / 8; it += GT) {
            const int l3 = it >> 17, e0 = (it & 131071) * 8, k = e0 >> 10;
            const float* W = l3 ? a.in[26] : a.in[2]; const float gk = (l3 ? a.in[25] : a.in[1])[k];
            const f32x4 v0 = *(const f32x4*)(W + e0), v1 = *(const f32x4*)(W + e0 + 4);
            u32x4 w; w.x = cvt_pk_bf16(v0[0] * gk, v0[1] * gk); w.y = cvt_pk_bf16(v0[2] * gk, v0[3] * gk); w.z = cvt_pk_bf16(v1[0] * gk, v1[1] * gk); w.w = cvt_pk_bf16(v1[2] * gk, v1[3] * gk);
            *(u32x4*)((bf16_t*)(ws + WS_MIX + (l3 ? 15 : 0) * MiB + 2 * MiB) + e0) = w;
        }
        bf16_t* Dcs = (bf16_t*)(ws + WS_DCS); bf16_t* T = (bf16_t*)(ws + WS_T);
        for (int it = gt; it < 2 * 256 * 256 / 8; it += GT) {
            const int e0 = it * 8, cs = e0 >> 16, j = (e0 >> 8) & 255, c0 = e0 & 255; float v[8];
#pragma unroll
            for (int k = 0; k < 8; ++k) { const float xx = (float)((j * (c0 + k)) & 255) * (1.0f / 128.0f); v[k] = (cs ? sinpif(xx) : cospif(xx)) * 0.0625f; }
            u32x4 w; w.x = cvt_pk_bf16(v[0], v[1]); w.y = cvt_pk_bf16(v[2], v[3]); w.z = cvt_pk_bf16(v[4], v[5]); w.w = cvt_pk_bf16(v[6], v[7]);
            *(u32x4*)(Dcs + e0) = w;
        }
        for (int it = gt; it < 2048 * KF / 8; it += GT) {
            const int e0 = it * 8, p = e0 / KF, q = e0 % KF; float v[8];
#pragma unroll
            for (int k = 0; k < 8; ++k) { const int kk = q + k, cs = kk >= KFE, sidx = cs ? kk - KFE : kk; const float xx = (float)((p * sidx) & 2047) * (1.0f / 1024.0f);
                v[k] = (cs ? -sinpif(xx) : (kk <= 1024 ? cospif(xx) : 0.0f)) * 0.03125f; }
            u32x4 w; w.x = cvt_pk_bf16(v[0], v[1]); w.y = cvt_pk_bf16(v[2], v[3]); w.z = cvt_pk_bf16(v[4], v[5]); w.w = cvt_pk_bf16(v[6], v[7]);
            *(u32x4*)(T + e0) = w;
        }
    }
}

__device__ __forceinline__ void fourier_fold_phase(const Frame& F, const bf16_t* __restrict__ U, bf16_t* __restrict__ FFo) {
    OPAQUE_TID();
    const int gt = F.bid * 512 + tid, GT = F.G * 512;
#pragma unroll 4
    for (int it = gt; it < NB * KF * 128; it += GT) {
        const int ch = it & 127, r = (it >> 7) % KF, b = (it >> 7) / KF;
        const bool sinp = r >= KFE; const int s = sinp ? r - KFE : r;
        const bf16_t* ub = U + (size_t)b * S * D + ch * 8;
        u32x4 o = (u32x4){0u, 0u, 0u, 0u};
        if (s <= 1024 && !(sinp && s == 0) && !(sinp && s == 1024)) {
            const u32x4 a = *(const u32x4*)(ub + (size_t)s * D);
            if (s == 0 || s == 1024) o = a;
            else { const u32x4 c = *(const u32x4*)(ub + (size_t)(S - s) * D); const float sg = sinp ? -1.0f : 1.0f;
#pragma unroll
                for (int k = 0; k < 4; ++k) o[k] = cvt_pk_bf16(bflo(a[k]) + sg * bflo(c[k]), bfhi(a[k]) + sg * bfhi(c[k])); }
        }
        *(u32x4*)(FFo + ((size_t)b * KF + r) * D + ch * 8) = o;
    }
}

template <int HW>
__device__ __forceinline__ void pool_item(const bf16_t* U, bf16_t* P, int b, int seg, int g, int lane) {
    const int s0 = seg * 16;
    const bf16_t* base = U + (size_t)b * S * D + g * 256 + lane * 4;
    u32x2 r[16 + 2 * HW];
#pragma unroll
    for (int i = 0; i < 16 + 2 * HW; ++i) { const int t = s0 - HW + i; r[i] = (u32x2){0u, 0u}; if (t >= 0 && t < S) r[i] = *(const u32x2*)(base + (size_t)t * D); }
    float sum[4] = {0.f, 0.f, 0.f, 0.f};
#pragma unroll
    for (int i = 0; i < 2 * HW; ++i) { sum[0] += bflo(r[i][0]); sum[1] += bfhi(r[i][0]); sum[2] += bflo(r[i][1]); sum[3] += bfhi(r[i][1]); }
    bf16_t* ob = P + (size_t)(b * S + s0) * D + g * 256 + lane * 4;
#pragma unroll
    for (int o = 0; o < 16; ++o) {
        const int s = s0 + o, lo = (s - HW) > 0 ? (s - HW) : 0, hi = (s + HW) < S ? (s + HW) : S;
        const float inv = 1.0f / (float)(hi - lo);
        const u32x2 c = r[o + HW];
        u32x2 w; w.x = cvt_pk_bf16(sum[0] * inv - bflo(c[0]), sum[1] * inv - bfhi(c[0])); w.y = cvt_pk_bf16(sum[2] * inv - bflo(c[1]), sum[3] * inv - bfhi(c[1]));
        *(u32x2*)(ob + (size_t)o * D) = w;
        if (o < 15) { const u32x2 a = r[o + 2 * HW], d = r[o];
            sum[0] += bflo(a[0]) - bflo(d[0]); sum[1] += bfhi(a[0]) - bfhi(d[0]); sum[2] += bflo(a[1]) - bflo(d[1]); sum[3] += bfhi(a[1]) - bfhi(d[1]); }
    }
}
__device__ __forceinline__ void pool_phase(const Frame& F, const bf16_t* U, bf16_t* P) {
    OPAQUE_TID();
    const int gw = F.bid * 8 + wave, NGW = F.G * 8;
    for (int it = gw; it < NB * (S / 16) * 4; it += NGW) {
        const int g = it & 3, seg = (it >> 2) & (S / 16 - 1), b = it >> 9;
        if (g == 0) pool_item<1>(U, P, b, seg, 0, lane);
        else if (g == 1) pool_item<2>(U, P, b, seg, 1, lane);
        else if (g == 2) pool_item<4>(U, P, b, seg, 2, lane);
        else pool_item<8>(U, P, b, seg, 3, lane);
    }
}

__device__ __forceinline__ void conv_dma_rows(LAS unsigned char* tl, const bf16_t* V, int p0, int sbase, int ra, int nrows, int wave, int lane) {
    for (int c = wave; c < 2 * nrows; c += 8) {
        const int r = ra + (c >> 1), t = sbase - 15 + r;
        LAS unsigned char* dst = tl + (r & 63) * (D * 2) + (c & 1) * 1024;
        if (t >= 0 && t < S) __builtin_amdgcn_global_load_lds((const unsigned*)((const char*)V + ((long)(p0 - 15 + r)) * (D * 2) + (c & 1) * 1024 + lane * 16), (LAS unsigned*)dst, 16, 0, 0);
        else *(LAS u32x4*)(dst + lane * 16) = (u32x4){0u, 0u, 0u, 0u};
    }
}
__device__ __forceinline__ void conv_phase(const Frame& F, const bf16_t* V, bf16_t* Aout, const float* dw, const float* dwb, const float* lng, const float* lnb) {
    OPAQUE_TID();
    f32x2 wv[31];
    { const float* p = dw + 2 * tid;
#pragma unroll
      for (int j = 0; j < 31; ++j) { wv[j] = *(const f32x2*)p; p += D; if ((j & 3) == 3) asm volatile("" ::: "memory"); } }
    const f32x2 bb = *(const f32x2*)(dwb + 2 * tid), gg = *(const f32x2*)(lng + 2 * tid), lb = *(const f32x2*)(lnb + 2 * tid);
    LAS unsigned char* tl = F.lds;
    LAS float* part = (LAS float*)(F.lds + 131072 + 1024);
    LAS float* stat = (LAS float*)(F.lds + 131072 + 2048);
    for (int strip = F.bid; strip < M / 128; strip += F.G) {
        const int p0 = strip * 128, sbase = p0 & (S - 1);
        conv_dma_rows(tl, V, p0, sbase, 0, 46, wave, lane);
#pragma unroll 1
        for (int k = 0; k < 8; ++k) {
            asm volatile("s_waitcnt vmcnt(0) lgkmcnt(0)" ::: "memory");
            __syncthreads();
            if (k < 7) conv_dma_rows(tl, V, p0, sbase, 46 + 16 * k, 16, wave, lane);
#pragma unroll 1
            for (int h = 0; h < 2; ++h) {
                const int rb = 16 * k + 8 * h;
                const LAS unsigned char* tlt = tl + tid * 4;
                f32x2 av[8];
#pragma unroll
                for (int o = 0; o < 8; ++o) av[o] = bb;
#pragma unroll
                for (int tt = 0; tt < 38; ++tt) {
                    const unsigned w = *(const LAS unsigned*)(tlt + ((rb + tt) & 63) * (D * 2));
                    const f32x2 xv = (f32x2){bflo(w), bfhi(w)};
#pragma unroll
                    for (int o = 0; o < 8; ++o) { const int j = tt - o; if (j >= 0 && j <= 30) av[o] = __builtin_elementwise_fma(xv, wv[j], av[o]); }
                    if ((tt & 7) == 7) asm volatile("" ::: "memory");
                }
                float vals[16];
#pragma unroll
                for (int o = 0; o < 8; ++o) { vals[o] = av[o][0] + av[o][1]; vals[8 + o] = av[o][0] * av[o][0] + av[o][1] * av[o][1]; }
#pragma unroll
                for (int step = 0; step < 4; ++step) {
                    const int half = 8 >> step; const bool up = (lane >> step) & 1;
#pragma unroll
                    for (int i = 0; i < half; ++i) { const float keep = up ? vals[i + half] : vals[i], send = up ? vals[i] : vals[i + half]; vals[i] = keep + __shfl_xor(send, 1 << step); }
                }
                vals[0] += __shfl_xor(vals[0], 16); vals[0] += __shfl_xor(vals[0], 32);
                if (lane < 16) { const int l = lane; const int idx = ((l & 1) << 3) | ((l & 2) << 1) | ((l & 4) >> 1) | ((l & 8) >> 3); part[wave * 16 + idx] = vals[0]; }
                __syncthreads();
                if (tid < 8) { float s1 = 0.f, s2 = 0.f;
#pragma unroll
                    for (int w = 0; w < 8; ++w) { s1 += part[w * 16 + tid]; s2 += part[w * 16 + 8 + tid]; }
                    const float mean = s1 * (1.0f / D), var = s2 * (1.0f / D) - mean * mean;
                    stat[2 * tid] = mean; stat[2 * tid + 1] = __builtin_amdgcn_rsqf(fmaxf(var, 0.f) + LN_EPS); }
                __syncthreads();
                unsigned* op = (unsigned*)(Aout + (size_t)(p0 + rb) * D) + tid;
#pragma unroll
                for (int o = 0; o < 8; ++o) {
                    const float mean = stat[2 * o], rstd = stat[2 * o + 1];
                    const float y0 = (av[o][0] - mean) * rstd * gg[0] + lb[0], y1 = (av[o][1] - mean) * rstd * gg[1] + lb[1];
                    const float z0 = y0 * __builtin_amdgcn_rcpf(1.0f + __builtin_amdgcn_exp2f(-1.44269504089f * y0)), z1 = y1 * __builtin_amdgcn_rcpf(1.0f + __builtin_amdgcn_exp2f(-1.44269504089f * y1));
                    *op = cvt_pk_bf16(z0, z1); op += D / 2;
                    if ((o & 3) == 3) asm volatile("" ::: "memory");
                }
            }
        }
        __syncthreads();
    }
}

__device__ __forceinline__ void final_phase(const Frame& F, float* out, const bf16_t* xb, const float* rowsq, const float* g) {
    OPAQUE_TID();
    const int gw = F.bid * 8 + wave, NGW = F.G * 8;
    f32x4 gv[4];
#pragma unroll
    for (int j = 0; j < 4; ++j) gv[j] = ((const f32x4*)g)[lane + 64 * j];
    for (int m = gw; m < M; m += 2 * NGW) {
        const int m2 = m + NGW;
        const float q0 = lane < 4 ? rowsq[(size_t)m * 4 + lane] : 0.f, q1 = (m2 < M && lane < 4) ? rowsq[(size_t)m2 * 4 + lane] : 0.f;
        u32x2 a[4], b[4];
#pragma unroll
        for (int j = 0; j < 4; ++j) { a[j] = ((const u32x2*)(xb + (size_t)m * D))[lane + 64 * j]; b[j] = (m2 < M) ? ((const u32x2*)(xb + (size_t)m2 * D))[lane + 64 * j] : (u32x2){0u, 0u}; }
        const float r0 = __builtin_amdgcn_rsqf(wave_sum(q0) * (1.0f / D) + NORM_EPS), r1 = __builtin_amdgcn_rsqf(wave_sum(q1) * (1.0f / D) + NORM_EPS);
        f32x4* o0 = (f32x4*)(out + (size_t)m * D) + lane; f32x4* o1 = (f32x4*)(out + (size_t)m2 * D) + lane;
#pragma unroll
        for (int j = 0; j < 4; ++j) { const f32x4 v = (f32x4){bflo(a[j][0]), bfhi(a[j][0]), bflo(a[j][1]), bfhi(a[j][1])}; o0[64 * j] = v * r0 * gv[j]; }
        if (m2 < M) {
#pragma unroll
            for (int j = 0; j < 4; ++j) { const f32x4 v = (f32x4){bflo(b[j][0]), bfhi(b[j][0]), bflo(b[j][1]), bfhi(b[j][1])}; o1[64 * j] = v * r1 * gv[j]; } }
    }
}

__global__ void __launch_bounds__(512, 2) fwd_megakernel(Args args) {
    extern __shared__ __attribute__((aligned(16))) unsigned char lds_raw[];
    cg::grid_group grid = cg::this_grid();
    Frame F; F.lds = (LAS unsigned char*)lds_raw; F.G = gridDim.x; F.bid = blockIdx.x;
    unsigned char* ws = args.ws;
    float* X = args.out;
    bf16_t* XB = (bf16_t*)(ws + WS_XB); float* ROWSQ = (float*)(ws + WS_ROWSQ);
    bf16_t* ACT1 = (bf16_t*)(ws + WS_ACT1); bf16_t* ACT2 = (bf16_t*)(ws + WS_ACT2); bf16_t* YT = (bf16_t*)(ws + WS_YT); bf16_t* HB = (bf16_t*)(ws + WS_H);
    volatile LAS unsigned* bst = (volatile LAS unsigned*)(F.lds + 131072 + 512);
    if (threadIdx.x < 2) bst[threadIdx.x] = 0u;
    __syncthreads();
    const XcdBarrier xbar = xcd_barrier_post((unsigned*)ws, bst);
#define GSYNC() xcd_barrier(xbar)
#define RUN_GEMM(EPI, A_, B_, LDA, LDB, K_, MODE, MR, NC, APN, ...) RUN_GEMM_S(0u, EPI, A_, B_, LDA, LDB, K_, MODE, MR, NC, APN, __VA_ARGS__)
#define RUN_GEMM_S(STAG, EPI, A_, B_, LDA, LDB, K_, MODE, MR, NC, APN, ...) do { pg8::Gemm g_{(A_), (B_), (LDA), (LDB), (K_)}; pg8::Order S_; S_.init((MODE), (MR), (NC), F.G, F.bid, (LDA), (LDB), (APN)); \
        EPI E_{__VA_ARGS__}; pg8::gemm_phase<EPI>(F.lds, g_, S_, E_, STAG); } while (0)

    if (args.ws == nullptr) grid.sync();
    prep_phase(F, args);
    GSYNC();
    RUN_GEMM(pg8::EpiBf16<0>, (const bf16_t*)(ws + WS_MIXB), (const bf16_t*)(ws + WS_MIX + 2 * MiB), 256, D, 256, 3, 32 * 256, 256, 0, (bf16_t*)(ws + WS_MIX), D, nullptr, 1.0f);
    GSYNC();
#pragma unroll 1
    for (int l = 0; l < 4; ++l) {
        const bf16_t* Win = (const bf16_t*)(ws + WS_MIX + (size_t)l * 5 * MiB);
        const bf16_t* Wout = (const bf16_t*)(ws + WS_MIXB + (size_t)l * 3 * MiB + MiB);
        if (l == 0 || l == 3) {
            RUN_GEMM(pg8::EpiBf16<0>, XB, Win, D, D, D, 0, M, D, 0, ACT1, D, ROWSQ, 1.0f);
            GSYNC();
            pool_phase(F, ACT1, ACT2);
            GSYNC();
            RUN_GEMM(pg8::EpiRes, ACT2, Wout, D, D, D, 0, M, D, 0, (l == 0) ? 0 : 1, args.in[0], XB, X, ROWSQ);
            GSYNC();
        } else if (l == 1) {
            RUN_GEMM(pg8::EpiBf16<2>, XB, Win, D, D, D, 0, M, 2 * D, 0, ACT1, D, ROWSQ, 1.0f);
            GSYNC();
            conv_phase(F, ACT1, ACT2, args.in[11], args.in[12], args.in[13], args.in[14]);
            GSYNC();
            RUN_GEMM(pg8::EpiRes, ACT2, Wout, D, D, D, 0, M, D, 0, (l == 0) ? 0 : 1, args.in[0], XB, X, ROWSQ);
            GSYNC();
        } else {
            RUN_GEMM(pg8::EpiBf16<0>, XB, Win, D, D, D, 0, M, D, 0, ACT1, D, ROWSQ, 1.0f);
            GSYNC();
            fourier_fold_phase(F, ACT1, (bf16_t*)(ws + WS_FF));
            GSYNC();
            RUN_GEMM(pg8::EpiBf16<0>, (const bf16_t*)(ws + WS_DCS), (const bf16_t*)(ws + WS_FF), 256, D, 256, 1, 256 * 576, 256, 0, YT, KF, nullptr, 1.0f);
            GSYNC();
            RUN_GEMM(pg8::EpiBf16<0>, (const bf16_t*)(ws + WS_T), YT, KF, KF, KF, 2, 256 * 512, 256, 0, ACT2, D, nullptr, 0.70710678118f);
            GSYNC();
            RUN_GEMM(pg8::EpiRes, ACT2, Wout, D, D, D, 0, M, D, 0, (l == 0) ? 0 : 1, args.in[0], XB, X, ROWSQ);
            GSYNC();
        }
#pragma unroll 1
        for (int c_ = 0; c_ < 2; ++c_) {
            int c = c_; asm volatile("" : "+s"(c));
            const size_t r0 = (size_t)c * (M / 2);
            RUN_GEMM_S(0u, pg8::EpiBf16<1>, XB + r0 * D, (const bf16_t*)(ws + WS_WUP + (size_t)l * 16 * MiB), D, D, D, 0, M / 2, FF, 0, HB, FF, ROWSQ + r0 * 4, 1.0f);
            GSYNC();
            RUN_GEMM(pg8::EpiRes, HB, (const bf16_t*)(ws + WS_WDN + (size_t)l * 16 * MiB), FF, FF, FF, 0, M / 2, D, 0, 1, args.in[0], XB + r0 * D, X, ROWSQ + r0 * 4);
            GSYNC();
        }
    }
    final_phase(F, X, XB, ROWSQ, args.in[33]);
}

extern "C" void kernel_launch(void* const* d_in, const int* in_sizes, int n_in, void* d_out, int out_size, void* d_ws, size_t ws_size, hipStream_t stream) {
    static int grid = 0;
    if (grid == 0) {
        if (n_in != 34 || out_size != M * D || ws_size < WS_END) { fprintf(stderr, "kernel_launch: unexpected problem (n_in %d, out %d, ws %zu < %zu)\n", n_in, out_size, ws_size, (size_t)WS_END); grid = -1; return; }
        int dev = 0, cus = 0, per_cu = 0;
        if (hipGetDevice(&dev) != hipSuccess || hipDeviceGetAttribute(&cus, hipDeviceAttributeMultiprocessorCount, dev) != hipSuccess) { grid = -1; return; }
        if (hipFuncSetAttribute((const void*)fwd_megakernel, hipFuncAttributeMaxDynamicSharedMemorySize, LDS_BYTES) != hipSuccess) { fprintf(stderr, "hipFuncSetAttribute failed\n"); grid = -1; return; }
        if (hipOccupancyMaxActiveBlocksPerMultiprocessor(&per_cu, (const void*)fwd_megakernel, 512, LDS_BYTES) != hipSuccess || per_cu < 1) { fprintf(stderr, "occupancy query: %d\n", per_cu); }
        (void)hipGetLastError();
        grid = cus;
    }
    if (grid < 0) return;
    if (hipMemsetAsync(d_ws, 0, 16384, stream) != hipSuccess) { fprintf(stderr, "kernel_launch: memset failed\n"); return; }
    Args a{};
    for (int i = 0; i < 34; ++i) a.in[i] = (const float*)d_in[i];
    a.out = (float*)d_out; a.ws = (unsigned char*)d_ws;
    void* kargs[] = {&a};
    hipError_t e = hipLaunchCooperativeKernel((const void*)fwd_megakernel, dim3(grid), dim3(512), kargs, LDS_BYTES, stream);
    if (e != hipSuccess) fprintf(stderr, "cooperative launch failed: %s (grid %d)\n", hipGetErrorString(e), grid);
}
```

```cpp
#include <hip/hip_runtime.h>
#include <hip/hip_cooperative_groups.h>
#include <cstdio>
#include <cstdint>
namespace cg = cooperative_groups;

#define LAS __attribute__((address_space(3)))
typedef unsigned short bf16_t;
typedef short bf16x8 __attribute__((ext_vector_type(8)));
typedef float f32x4 __attribute__((ext_vector_type(4)));
typedef float f32x2 __attribute__((ext_vector_type(2)));
typedef unsigned u32x4 __attribute__((ext_vector_type(4)));
typedef unsigned u32x2 __attribute__((ext_vector_type(2)));

constexpr int NB = 16, S = 2048, D = 1024, M = NB * S, FF = 4096;
constexpr float NORM_EPS = 1e-6f, LN_EPS = 1e-5f;
constexpr size_t MiB = 1u << 20;
constexpr size_t WS_ROWSQ = 1 * MiB;
constexpr size_t WS_DCS = 3 * MiB;
constexpr size_t WS_T = 4 * MiB;
constexpr size_t WS_WUP = 20 * MiB;
constexpr size_t WS_WDN = 28 * MiB;
constexpr size_t WS_MIX = 84 * MiB;
constexpr size_t WS_MIXB = 104 * MiB;
constexpr size_t WS_XB = 116 * MiB;
constexpr size_t WS_H = 180 * MiB;
constexpr size_t WS_ACT1 = WS_H, WS_ACT2 = WS_H + 64 * MiB, WS_FF = WS_H + 64 * MiB, WS_YT = WS_H + 144 * MiB, WS_ACT3 = WS_H + 128 * MiB;
constexpr size_t WS_END = WS_H + 256 * MiB;
constexpr int LDS_BYTES = 147456;
constexpr int KFE = 1280, KF = KFE + 1024;

__device__ __forceinline__ unsigned cvt_pk_bf16(float lo, float hi) { unsigned r; asm volatile("v_cvt_pk_bf16_f32 %0, %1, %2" : "=v"(r) : "v"(lo), "v"(hi)); return r; }
__device__ __forceinline__ float bflo(unsigned w) { return __uint_as_float(w << 16); }
__device__ __forceinline__ float bfhi(unsigned w) { return __uint_as_float(w & 0xffff0000u); }

namespace pg8 {
constexpr int BM = 256, BK = 64, HALF = 128, HTB = HALF * BK * 2, STAGE_BYTES = 8 * HTB, NXCD = 8, WGM = 2;
__host__ __device__ __forceinline__ int lds_byte(int r, int c) { const int st = (r >> 4) * 2 + (c >> 5), rr = r & 15, cc = c & 31, ob = rr * 64 + cc * 2; return st * 1024 + (ob ^ (((ob >> 9) & 1) << 5)); }
__host__ __device__ __forceinline__ void stage_rc(int b, int& R, int& C) { const int st = b / 1024, sb = b % 1024, swz = sb ^ (((sb >> 9) & 1) << 5); R = (st >> 1) * 16 + swz / 64; C = (st & 1) * 32 + (swz % 64) / 2; }
__host__ __device__ __forceinline__ int perm32(int rho) { const int n = rho >> 4, i = rho & 15; return 8 * (i >> 2) + 4 * n + (i & 3); }

struct Unit { long aoff, boff; int row0, col0; };
struct Gemm { const bf16_t* A; const bf16_t* Bt; int lda, ldb, K; };

struct Order {
    int mode, nM, nN, nwg, G, c, lda, ldb; long a_pn_bytes;
    __device__ __forceinline__ void init(int mode_, int Mr, int Nc, int G_, int c_, int lda_, int ldb_, long apn) { mode = mode_; nM = Mr / BM; nN = Nc / BM; nwg = nM * nN; G = G_; c = c_; lda = lda_; ldb = ldb_; a_pn_bytes = apn; }
    __device__ __forceinline__ bool next(int i, Unit& u) const {
        const long L = (long)i * G + c; if (L >= nwg) return false;
        if (mode == 0) {
            int wgid = (int)L; { const int q = nwg / NXCD, r = nwg % NXCD, xcd = wgid % NXCD, off = wgid / NXCD; wgid = (xcd < r ? xcd * (q + 1) : r * (q + 1) + (xcd - r) * q) + off; }
            const int nig = WGM * nN, gid = wgid / nig, fm = gid * WGM, gsz = (nM - fm) < WGM ? (nM - fm) : WGM;
            const int pm = fm + ((wgid % nig) % gsz), pn = (wgid % nig) / gsz;
            u.aoff = (long)pm * BM * lda * 2 + (long)pn * a_pn_bytes; u.boff = (long)pn * BM * ldb * 2; u.row0 = pm * BM; u.col0 = pn * BM;
        } else if (mode == 1) {
            const int w = (int)L, t = w % 9, g = (w / 9) & 3, b = w / 36, cs = (t >= 5) ? 1 : 0;
            u.aoff = (long)cs * 256 * 256 * 2; u.boff = ((long)(b * KF + t * 256) * D + g * 256) * 2; u.row0 = b * 1024 + g * 256; u.col0 = t * 256;
        } else if (mode == 3) {
            const int w = (int)L, layer = w >> 4, pm = (w >> 2) & 3, pn = w & 3;
            u.aoff = (long)layer * 9 * 1048576 + (long)pm * 256 * 256 * 2; u.boff = (long)layer * 15 * 1048576 + (long)pn * 256 * 1024 * 2 + pm * 512; u.row0 = layer * 7680 + pm * 256; u.col0 = pn * 256;
        } else {
            int b, pm, pn;
            if (G == 256) { const int xcd = c & 7, loc = c >> 3; b = i * 8 + xcd; pm = loc & 7; pn = loc >> 3; }
            else { const int w = (int)L; b = w >> 5; pm = w & 7; pn = (w >> 3) & 3; }
            u.aoff = (long)pm * 256 * KF * 2; u.boff = ((long)b * 1024 + pn * 256) * KF * 2; u.row0 = b * S + pm * 256; u.col0 = pn * 256;
        }
        return true;
    }
};

__device__ __forceinline__ float row_rstd(const float* rowsq, int row) {
    const f32x4 s = *(const f32x4*)(rowsq + (size_t)row * 4);
    const float t = (s[0] + s[1]) + (s[2] + s[3]);
    return __builtin_amdgcn_rsqf(t * (1.0f / D) + NORM_EPS);
}
template <int ACT> struct EpiBf16 {
    static constexpr bool PERM = true;
    bf16_t* O; int ldc; const float* rowsq; float post;
    template <class Sched> __device__ __forceinline__ void prefill(LAS unsigned char* lds, const Sched& S, int tid) const {
        if (!rowsq) return;
        LAS float* rsl = (LAS float*)(lds + 139264);
        Unit u;
        for (int i = 0; i < 8 && S.next(i, u); ++i) if (tid < 256) rsl[i * 256 + tid] = post * row_rstd(rowsq, u.row0 + tid);
        asm volatile("s_waitcnt vmcnt(0) lgkmcnt(0)" ::: "memory");
    }
    __device__ __forceinline__ void operator()(const f32x4 (&acc)[2][2][4][2], const Unit& u, int wr, int wc, int fr, int fq, LAS unsigned char* lds, int, int ui) const {
        const int row0 = u.row0 + wr * 64 + fr;
        const int col0 = (ACT == 2 ? (u.col0 >> 1) : u.col0) + wc * 32 + 8 * fq;
        const LAS float* rsl = (const LAS float*)(lds + 139264) + (ui & 7) * 256 + wr * 64 + fr;
        float rs[2][4];
#pragma unroll
        for (int ai = 0; ai < 2; ++ai)
#pragma unroll
            for (int m = 0; m < 4; ++m) rs[ai][m] = rowsq ? rsl[ai * HALF + m * 16] : post;
#pragma unroll
        for (int ai = 0; ai < 2; ++ai)
#pragma unroll
            for (int m = 0; m < 4; ++m) {
                const int row = row0 + ai * HALF + m * 16;
                const float sc = rs[ai][m];
                bf16_t* rowp = O + (size_t)row * ldc + col0;
                if (ACT == 2) {
                    f32x4 v0 = acc[ai][0][m][0] * sc, v1 = acc[ai][0][m][1] * sc, g0 = acc[ai][1][m][0] * sc, g1 = acc[ai][1][m][1] * sc;
#pragma unroll
                    for (int i = 0; i < 4; ++i) {
                        v0[i] = v0[i] * __builtin_amdgcn_rcpf(1.0f + __builtin_amdgcn_exp2f(-1.44269504089f * g0[i]));
                        v1[i] = v1[i] * __builtin_amdgcn_rcpf(1.0f + __builtin_amdgcn_exp2f(-1.44269504089f * g1[i])); }
                    u32x4 w; w.x = cvt_pk_bf16(v0[0], v0[1]); w.y = cvt_pk_bf16(v0[2], v0[3]); w.z = cvt_pk_bf16(v1[0], v1[1]); w.w = cvt_pk_bf16(v1[2], v1[3]);
                    *(u32x4*)rowp = w;
                } else {
#pragma unroll
                    for (int bj = 0; bj < 2; ++bj) {
                        f32x4 v0 = acc[ai][bj][m][0] * sc, v1 = acc[ai][bj][m][1] * sc;
                        if (ACT == 1) {
#pragma unroll
                            for (int i = 0; i < 4; ++i) { const float a = fmaxf(v0[i], 0.f), b = fmaxf(v1[i], 0.f); v0[i] = a * a; v1[i] = b * b; } }
                        u32x4 w; w.x = cvt_pk_bf16(v0[0], v0[1]); w.y = cvt_pk_bf16(v0[2], v0[3]); w.z = cvt_pk_bf16(v1[0], v1[1]); w.w = cvt_pk_bf16(v1[2], v1[3]);
                        *(u32x4*)(rowp + bj * HALF) = w; }
                }
                asm volatile("" ::: "memory");
            }
    }
};
struct EpiRes {
    static constexpr bool PERM = true;
    template <class Sched> __device__ __forceinline__ void prefill(LAS unsigned char*, const Sched&, int) const {}
    int mode; const float* xin; bf16_t* xb; float* xout; float* rowsq;
    __device__ __forceinline__ void operator()(const f32x4 (&acc)[2][2][4][2], const Unit& u, int wr, int wc, int fr, int fq, LAS unsigned char* lds, int tid, int) const {
        const int colb = u.col0 + wc * 32 + 8 * fq, pn = u.col0 >> 8;
        LAS float* xch = (LAS float*)(lds + 135168);
        const size_t off0 = (size_t)(u.row0 + wr * 64 + fr) * D + colb;
        f32x4 cur[2][2], nxt[2][2];
#define EPIRES_LOAD(dst, off_) do { _Pragma("unroll") for (int bj = 0; bj < 2; ++bj) { \
            if (mode == 0) { dst[bj][0] = *(const f32x4*)(xin + (off_) + bj * HALF); dst[bj][1] = *(const f32x4*)(xin + (off_) + bj * HALF + 4); } \
            else { const u32x4 w_ = *(const u32x4*)(xb + (off_) + bj * HALF); dst[bj][0] = (f32x4){bflo(w_[0]), bfhi(w_[0]), bflo(w_[1]), bfhi(w_[1])}; dst[bj][1] = (f32x4){bflo(w_[2]), bfhi(w_[2]), bflo(w_[3]), bfhi(w_[3])}; } } } while (0)
        EPIRES_LOAD(cur, off0);
#pragma unroll
        for (int it = 0; it < 8; ++it) {
            const int ai = it >> 2, m = it & 3;
            const size_t off = off0 + (size_t)(ai * HALF + m * 16) * D;
            if (it < 7) { const size_t offn = off0 + (size_t)(((it + 1) >> 2) * HALF + ((it + 1) & 3) * 16) * D; EPIRES_LOAD(nxt, offn); }
            float ss = 0.f;
#pragma unroll
            for (int bj = 0; bj < 2; ++bj) {
                const f32x4 o0 = cur[bj][0] + acc[ai][bj][m][0], o1 = cur[bj][1] + acc[ai][bj][m][1];
                ss += ((o0[0] * o0[0] + o0[1] * o0[1]) + (o0[2] * o0[2] + o0[3] * o0[3])) + ((o1[0] * o1[0] + o1[1] * o1[1]) + (o1[2] * o1[2] + o1[3] * o1[3]));
                if (mode == 2) { *(f32x4*)(xout + off + bj * HALF) = o0; *(f32x4*)(xout + off + bj * HALF + 4) = o1; }
                else { u32x4 w; w.x = cvt_pk_bf16(o0[0], o0[1]); w.y = cvt_pk_bf16(o0[2], o0[3]); w.z = cvt_pk_bf16(o1[0], o1[1]); w.w = cvt_pk_bf16(o1[2], o1[3]); *(u32x4*)(xb + off + bj * HALF) = w; }
            }
            ss += __shfl_xor(ss, 16); ss += __shfl_xor(ss, 32);
            if (fq == 0) xch[(ai * HALF + wr * 64 + m * 16 + fr) * 4 + wc] = ss;
#pragma unroll
            for (int bj = 0; bj < 2; ++bj) { cur[bj][0] = nxt[bj][0]; cur[bj][1] = nxt[bj][1]; }
            asm volatile("" ::: "memory");
        }
#undef EPIRES_LOAD
        asm volatile("s_waitcnt lgkmcnt(0)" ::: "memory"); __builtin_amdgcn_s_barrier(); asm volatile("" ::: "memory");
        if (tid < 256) { const f32x4 v = *(const LAS f32x4*)(xch + tid * 4); rowsq[(size_t)(u.row0 + tid) * 4 + pn] = (v[0] + v[1]) + (v[2] + v[3]); }
    }
};

template <class Epi>
__device__ __forceinline__ void gemm_phase(LAS unsigned char* lds, const Gemm g, const Order& S, const Epi& E, const unsigned stag = 0u) {
    int tid_ = threadIdx.x; asm volatile("" : "+v"(tid_));
    const int tid = tid_, wid = __builtin_amdgcn_readfirstlane(tid >> 6), lane = tid & 63, wr = wid >> 2, wc = wid & 3, fr = lane & 15, fq = lane >> 4;
    const int K = g.K, nt = K / BK;
    unsigned voffA[2], voffB[2];
#pragma unroll
    for (int i = 0; i < 2; ++i) { int R, C; stage_rc(tid * 16 + i * 8192, R, C); const int Rb = Epi::PERM ? ((R & ~31) + perm32(R & 31)) : R;
        voffA[i] = (unsigned)(R * g.lda + C) * 2u; voffB[i] = (unsigned)(Rb * g.ldb + C) * 2u; }
    const size_t kstep = (size_t)(BK * 2);
    const size_t hstepA = (size_t)HALF * g.lda * 2, hstepB = (size_t)HALF * g.ldb * 2;
    const unsigned ldsw = (unsigned)wid * 1024u;
    const int aoff = lds_byte(wr * 64 + fr, fq * 8), boff = lds_byte(wc * 32 + fr, fq * 8);
#define PG8_SA(b, h) (((b) * 2 + (h)) * HTB)
#define PG8_SB(b, h) ((4 + (b) * 2 + (h)) * HTB)
#define PG8_STAGE(bufoff, gbase, voff) do { _Pragma("unroll") for (int _i = 0; _i < 2; ++_i) \
        __builtin_amdgcn_global_load_lds((const unsigned*)((const char*)(gbase) + (voff)[_i]), (LAS unsigned*)(lds + (bufoff) + ldsw + _i * 8192), 16, 0, 0); } while (0)
#define PG8_LDA(dst, b, h) do { _Pragma("unroll") for (int m = 0; m < 4; ++m) _Pragma("unroll") for (int k = 0; k < 2; ++k) dst[m][k] = *(const LAS bf16x8*)(lds + PG8_SA(b, h) + aoff + m * 2048 + k * 1024); } while (0)
#define PG8_LDB(dst, b, h) do { _Pragma("unroll") for (int n = 0; n < 2; ++n) _Pragma("unroll") for (int k = 0; k < 2; ++k) dst[n][k] = *(const LAS bf16x8*)(lds + PG8_SB(b, h) + boff + n * 2048 + k * 1024); } while (0)
#define PG8_MMA(ai, bj, At, Bt) do { __builtin_amdgcn_s_setprio(1); _Pragma("unroll") for (int m = 0; m < 4; ++m) _Pragma("unroll") for (int n = 0; n < 2; ++n) _Pragma("unroll") for (int k = 0; k < 2; ++k) \
        acc[ai][bj][m][n] = __builtin_amdgcn_mfma_f32_16x16x32_bf16(Bt[n][k], At[m][k], acc[ai][bj][m][n], 0, 0, 0); __builtin_amdgcn_s_setprio(0); } while (0)
#define PG8_WAIT_V(n) asm volatile("s_waitcnt vmcnt(" #n ")" ::: "memory")
#define PG8_WAIT_L(n) asm volatile("s_waitcnt lgkmcnt(" #n ")" ::: "memory")
#define PG8_BAR __builtin_amdgcn_s_barrier()
#define PG8_SCHED __builtin_amdgcn_sched_barrier(0)
    Unit cur, nxt; int ui = 0;
    if (!S.next(0, cur)) return;
    if (stag) {
        const unsigned long long t0 = __builtin_amdgcn_s_memrealtime(), dl = (unsigned long long)(((unsigned)cur.col0 >> 8) & 3u) * stag;
        while (__builtin_amdgcn_s_memrealtime() - t0 < dl) __builtin_amdgcn_s_sleep(8);
    }
    f32x4 acc[2][2][4][2];
#pragma unroll
    for (int a = 0; a < 2; ++a)
#pragma unroll
        for (int b = 0; b < 2; ++b)
#pragma unroll
            for (int m = 0; m < 4; ++m)
#pragma unroll
                for (int n = 0; n < 2; ++n) acc[a][b][m][n] = (f32x4){0.f, 0.f, 0.f, 0.f};
    E.prefill(lds, S, tid);
    bf16x8 At[4][2], B0[2][2], B1[2][2];
    const char* cA = (const char*)g.A + cur.aoff; const char* cB = (const char*)g.Bt + cur.boff;
    PG8_STAGE(PG8_SB(0, 0), cB, voffB); PG8_STAGE(PG8_SB(0, 1), cB + hstepB, voffB); PG8_STAGE(PG8_SA(0, 0), cA, voffA); PG8_STAGE(PG8_SA(0, 1), cA + hstepA, voffA);
    if (wr == 1) PG8_BAR;
    PG8_WAIT_V(2); PG8_BAR;
    PG8_STAGE(PG8_SB(1, 0), cB + kstep, voffB); PG8_STAGE(PG8_SA(1, 0), cA + kstep, voffA); PG8_STAGE(PG8_SB(1, 1), cB + hstepB + kstep, voffB);
    PG8_WAIT_V(6); PG8_BAR;
    for (;;) {
        const bool has_next = S.next(ui + 1, nxt);
        const char* nA = has_next ? (const char*)g.A + nxt.aoff : cA; const char* nB = has_next ? (const char*)g.Bt + nxt.boff : cB;
        for (int t = 0; t < nt; t += 2) {
            const bool last = (t == nt - 2);
            const char* a1 = cA + (size_t)(t + 1) * kstep;
            const char* a2 = last ? nA : cA + (size_t)(t + 2) * kstep; const char* b2 = last ? nB : cB + (size_t)(t + 2) * kstep;
            const char* a3 = a2 + kstep; const char* b3 = b2 + kstep;
            PG8_LDB(B0, 0, 0); PG8_LDB(B1, 0, 1); PG8_SCHED; PG8_LDA(At, 0, 0); PG8_STAGE(PG8_SA(1, 1), a1 + hstepA, voffA);
            PG8_WAIT_V(8); PG8_WAIT_L(0); PG8_BAR; PG8_MMA(0, 0, At, B0); PG8_MMA(0, 1, At, B1); PG8_BAR; PG8_SCHED;
            PG8_LDA(At, 0, 1); PG8_STAGE(PG8_SB(0, 0), b2, voffB); PG8_STAGE(PG8_SB(0, 1), b2 + hstepB, voffB); PG8_STAGE(PG8_SA(0, 0), a2, voffA);
            PG8_WAIT_V(8); PG8_WAIT_L(0); PG8_BAR; PG8_MMA(1, 0, At, B0); PG8_MMA(1, 1, At, B1); PG8_BAR; PG8_SCHED;
            PG8_LDB(B0, 1, 0); PG8_LDB(B1, 1, 1); PG8_SCHED; PG8_LDA(At, 1, 0); PG8_STAGE(PG8_SA(0, 1), a2 + hstepA, voffA);
            PG8_WAIT_V(8); PG8_WAIT_L(0); PG8_BAR; PG8_MMA(0, 0, At, B0); PG8_MMA(0, 1, At, B1); PG8_BAR; PG8_SCHED;
            PG8_LDA(At, 1, 1); PG8_STAGE(PG8_SB(1, 0), b3, voffB); PG8_STAGE(PG8_SB(1, 1), b3 + hstepB, voffB); PG8_STAGE(PG8_SA(1, 0), a3, voffA);
            PG8_WAIT_V(8); PG8_WAIT_L(0); PG8_BAR; PG8_MMA(1, 0, At, B0); PG8_MMA(1, 1, At, B1); PG8_BAR; PG8_SCHED;
        }
        if (wr == 0) PG8_BAR;
        E(acc, cur, wr, wc, fr, fq, lds, tid, ui);
        if (!has_next) break;
#pragma unroll
        for (int a = 0; a < 2; ++a)
#pragma unroll
            for (int b = 0; b < 2; ++b)
#pragma unroll
                for (int m = 0; m < 4; ++m)
#pragma unroll
                    for (int n = 0; n < 2; ++n) acc[a][b][m][n] = (f32x4){0.f, 0.f, 0.f, 0.f};
        cur = nxt; cA = nA; cB = nB; ++ui;
        if (wr == 1) PG8_BAR;
    }
    PG8_WAIT_V(0);
    PG8_BAR;
#undef PG8_SA
#undef PG8_SB
#undef PG8_STAGE
#undef PG8_LDA
#undef PG8_LDB
#undef PG8_MMA
#undef PG8_WAIT_V
#undef PG8_WAIT_L
#undef PG8_BAR
#undef PG8_SCHED
}
}


#define XB_TMO      128
#define XB_XCNT(j)  (256  + 64 * (j))
#define XB_XSUB(j)  (1280 + 64 * (j))
#define XB_XGEN(j)  (2304 + 64 * (j))
#define XB_TOP      3328
#define XB_TOPGEN   3392
#define XCD_BAR_WORDS 3456
#define XB_SPIN_CAP (1u << 22)
__device__ __forceinline__ unsigned xb_ld(unsigned* p)              { return __hip_atomic_load(p, __ATOMIC_RELAXED, __HIP_MEMORY_SCOPE_AGENT); }
__device__ __forceinline__ unsigned xb_add(unsigned* p, unsigned v) { return __hip_atomic_fetch_add(p, v, __ATOMIC_RELAXED, __HIP_MEMORY_SCOPE_AGENT); }
__device__ __forceinline__ unsigned xb_xcc_id() { return (unsigned)__builtin_amdgcn_s_getreg((3 << 11) | 20) & 0xFu; }
#define XB_SPIN(cond, bar) do { unsigned _sp = 0; while (cond) { __builtin_amdgcn_s_sleep(1); \
    if ((++_sp & 255u) == 0u) { if (xb_ld(&(bar)[XB_TMO])) break; if (_sp > XB_SPIN_CAP) { atomicAdd(&(bar)[XB_TMO], 1u); break; } } } } while (0)
struct XcdBarrier { unsigned* bar; unsigned x; volatile LAS unsigned* st; };
__device__ __forceinline__ XcdBarrier xcd_barrier_post(unsigned* bar, volatile LAS unsigned* st) {
    XcdBarrier b; b.bar = bar; b.x = xb_xcc_id(); b.st = st;
    if (threadIdx.x == 0) (void)xb_add(&bar[XB_XCNT(b.x)], 1u);
    return b;
}
__device__ __forceinline__ void xcd_barrier_complete(unsigned* bar, unsigned x, unsigned& nloc, unsigned& nx) {
    const unsigned G = gridDim.x * gridDim.y * gridDim.z;
    unsigned sum, cnt, mine, sp = 0u;
    for (;;) {
        sum = 0u; cnt = 0u; mine = 0u;
#pragma unroll
        for (unsigned j = 0; j < 16; ++j) { const unsigned c = xb_ld(&bar[XB_XCNT(j)]); sum += c; cnt += (c > 0u) ? 1u : 0u; mine = (j == x) ? c : mine; }
        if (sum == G) break;
        __builtin_amdgcn_s_sleep(1);
        if ((++sp & 255u) == 0u) { if (xb_ld(&bar[XB_TMO])) break; if (sp > XB_SPIN_CAP) { atomicAdd(&bar[XB_TMO], 1u); break; } }
    }
    nloc = mine > 0u ? mine : 1u; nx = cnt > 0u ? cnt : 1u;
}
__device__ __forceinline__ void xcd_barrier(const XcdBarrier& b) {
    asm volatile("s_waitcnt vmcnt(0)" ::: "memory");
    __syncthreads();
    if (threadIdx.x == 0) {
        unsigned* bar = b.bar;
        __builtin_amdgcn_s_waitcnt(0);
        unsigned nloc = b.st[0], nx = b.st[1];
        if (nloc == 0u) { xcd_barrier_complete(bar, b.x, nloc, nx); b.st[0] = nloc; b.st[1] = nx; }
        const unsigned old = xb_add(&bar[XB_XSUB(b.x)], 1u);
        const unsigned gen = old / nloc;
        if (old + 1u == (gen + 1u) * nloc) {
            __builtin_amdgcn_fence(__ATOMIC_RELEASE, "agent");
            asm volatile("s_waitcnt vmcnt(0)" ::: "memory");
            const unsigned og = xb_add(&bar[XB_TOP], 1u);
            const unsigned tg = og / nx;
            if (og + 1u == (tg + 1u) * nx) xb_add(&bar[XB_TOPGEN], 1u);
            else XB_SPIN(xb_ld(&bar[XB_TOPGEN]) == tg, bar);
            __builtin_amdgcn_fence(__ATOMIC_ACQUIRE, "agent");
            xb_add(&bar[XB_XGEN(b.x)], 1u);
            asm volatile("s_waitcnt vmcnt(0)" ::: "memory");
        } else {
            XB_SPIN(xb_ld(&bar[XB_XGEN(b.x)]) == gen, bar);
            __builtin_amdgcn_fence(__ATOMIC_ACQUIRE, "agent");
            asm volatile("s_waitcnt vmcnt(0)" ::: "memory");
        }
    }
    __syncthreads();
}

struct Frame { LAS unsigned char* lds; int G, bid; };
#define OPAQUE_TID() int tid_ = threadIdx.x; asm volatile("" : "+v"(tid_)); const int tid = tid_, lane = tid & 63, wave = __builtin_amdgcn_readfirstlane(tid >> 6); (void)lane; (void)wave
__device__ __forceinline__ float wave_sum(float v) {
#pragma unroll
    for (int o = 1; o < 64; o <<= 1) v += __shfl_xor(v, o);
    return v;
}
#define LDS_WAIT() asm volatile("s_waitcnt lgkmcnt(0)" ::: "memory")

__device__ __forceinline__ void transpose_item(const float* W, int K, int N, bf16_t* WT, int ldt, const float* kscale, const float* nscale, bool glu, LAS float* scr, int item, int lane) {
    const int nblk = N / 32, kb = item / nblk, nb = item % nblk, k0 = 64 * kb, n0 = 32 * nb;
    const int n4 = (lane & 7) * 4, kr = lane >> 3;
    const f32x4 ns = nscale ? *(const f32x4*)(nscale + n0 + n4) : (f32x4){1.f, 1.f, 1.f, 1.f};
    f32x4 v[8];
#pragma unroll
    for (int i = 0; i < 8; ++i) v[i] = *(const f32x4*)(W + (size_t)(k0 + kr + 8 * i) * N + n0 + n4);
#pragma unroll
    for (int i = 0; i < 8; ++i) { const int kk = kr + 8 * i; const float ks = kscale ? kscale[k0 + kk] : 1.0f; const f32x4 t = v[i] * ns * ks;
        LAS float* d = scr + kk * 33 + n4; d[0] = t[0]; d[1] = t[1]; d[2] = t[2]; d[3] = t[3]; }
    LDS_WAIT(); asm volatile("" ::: "memory");
    int r0 = n0; if (glu) { const int c = n0 & 1023, gate = n0 >> 10; r0 = (c >> 7) * 256 + gate * 128 + (c & 127); }
    const int c = lane & 7;
#pragma unroll
    for (int j = 0; j < 4; ++j) { const int n = (lane >> 3) + 8 * j; const LAS float* s = scr + (8 * c) * 33 + n;
        u32x4 o; o.x = cvt_pk_bf16(s[0 * 33], s[1 * 33]); o.y = cvt_pk_bf16(s[2 * 33], s[3 * 33]); o.z = cvt_pk_bf16(s[4 * 33], s[5 * 33]); o.w = cvt_pk_bf16(s[6 * 33], s[7 * 33]);
        *(u32x4*)(WT + (size_t)(r0 + n) * ldt + k0 + 8 * c) = o; }
    LDS_WAIT(); asm volatile("" ::: "memory");
}

struct Args { const float* in[34]; float* out; unsigned char* ws; };

__device__ __forceinline__ void prep_phase(const Frame& F, const Args& a) {
    OPAQUE_TID();
    unsigned char* ws = a.ws;
    LAS float* scr = (LAS float*)(F.lds + wave * 16384);
    const int gw = F.bid * 8 + wave, NGW = F.G * 8;
    constexpr int I_SQ = (D / 64) * (D / 32), I_UP = (D / 64) * (FF / 32), I_DN = (FF / 64) * (D / 32), I_GRP = 4 * (256 / 64) * (256 / 32), I_CIN = (D / 64) * (2 * D / 32);
    constexpr int I_MLP = I_UP + I_DN;
    constexpr int I_POOL = I_SQ + I_GRP + I_MLP, I_CONV = I_CIN + I_SQ + I_MLP, I_FOUR = 2 * I_SQ + I_MLP;
    constexpr int NITEMS = 2 * I_POOL + I_CONV + I_FOUR;
#define JOB(W, K_, N_, DST, LDT, KS, NS, GLU) if (r < ((K_) / 64) * ((N_) / 32)) { transpose_item((W), (K_), (N_), (bf16_t*)(DST), (LDT), (KS), (NS), (GLU), scr, r, lane); continue; } r -= ((K_) / 64) * ((N_) / 32);
#define JOB_MLP(L, i0) JOB(a.in[(i0) + 1], D, FF, ws + WS_WUP + (L) * 16 * MiB, D, a.in[(i0)], nullptr, false) \
                       JOB(a.in[(i0) + 2], FF, D, ws + WS_WDN + (L) * 16 * MiB, FF, nullptr, nullptr, false)
#define JOB_POOL(L, i0) if (r < I_GRP) { const int g = r / (I_GRP / 4); transpose_item(a.in[(i0) + 2] + g * 65536, 256, 256, (bf16_t*)(ws + WS_MIXB + (L) * 3 * MiB) + g * 65536, 256, nullptr, a.in[(i0) + 3] + g * 256, false, scr, r % (I_GRP / 4), lane); continue; } r -= I_GRP; \
                        JOB(a.in[(i0) + 4], D, D, ws + WS_MIXB + (L) * 3 * MiB + MiB, D, nullptr, nullptr, false) \
                        JOB_MLP(L, (i0) + 5)
    for (int it = gw; it < NITEMS; it += NGW) {
        int r = it;
        JOB_POOL(0, 1)
        JOB(a.in[10], D, 2 * D, ws + WS_MIX + 1 * 5 * MiB, D, a.in[9], nullptr, true)
        JOB(a.in[15], D, D, ws + WS_MIXB + 1 * 3 * MiB + MiB, D, nullptr, nullptr, false)
        JOB_MLP(1, 16)
        JOB(a.in[20], D, D, ws + WS_MIX + 2 * 5 * MiB, D, a.in[19], nullptr, false)
        JOB(a.in[21], D, D, ws + WS_MIXB + 2 * 3 * MiB + MiB, D, nullptr, nullptr, false)
        JOB_MLP(2, 22)
        JOB_POOL(3, 25)
    }
#undef JOB
#undef JOB_MLP
#undef JOB_POOL
    {
        const float* x = a.in[0]; bf16_t* XB = (bf16_t*)(ws + WS_XB); float* rowsq = (float*)(ws + WS_ROWSQ);
        for (int m = gw; m < M; m += 2 * NGW) {
            const int m2 = (m + NGW < M) ? m + NGW : m;
            const f32x4* xr = (const f32x4*)(x + (size_t)m * D) + lane; const f32x4* xr2 = (const f32x4*)(x + (size_t)m2 * D) + lane; f32x4 v[4], v2[4]; float s = 0.f, s2 = 0.f;
#pragma unroll
            for (int j = 0; j < 4; ++j) { v[j] = xr[64 * j]; v2[j] = xr2[64 * j]; }
#pragma unroll
            for (int j = 0; j < 4; ++j) { s += (v[j][0] * v[j][0] + v[j][1] * v[j][1]) + (v[j][2] * v[j][2] + v[j][3] * v[j][3]); s2 += (v2[j][0] * v2[j][0] + v2[j][1] * v2[j][1]) + (v2[j][2] * v2[j][2] + v2[j][3] * v2[j][3]); }
            s = wave_sum(s); s2 = wave_sum(s2);
            u32x2* o8 = (u32x2*)(XB + (size_t)m * D) + lane; u32x2* o82 = (u32x2*)(XB + (size_t)m2 * D) + lane;
#pragma unroll
            for (int j = 0; j < 4; ++j) { u32x2 w; w.x = cvt_pk_bf16(v[j][0], v[j][1]); w.y = cvt_pk_bf16(v[j][2], v[j][3]); o8[64 * j] = w;
                                          u32x2 w2; w2.x = cvt_pk_bf16(v2[j][0], v2[j][1]); w2.y = cvt_pk_bf16(v2[j][2], v2[j][3]); o82[64 * j] = w2; }
            if (lane < 4) { rowsq[(size_t)m * 4 + lane] = (lane == 0) ? s : 0.f; rowsq[(size_t)m2 * 4 + lane] = (lane == 0) ? s2 : 0.f; }
        }
    }
    {
        const int gt = F.bid * 512 + tid, GT = F.G * 512;
        for (int it = gt; it < 2 * D * D / 8; it += GT) {
            const int l3 = it >> 17, e0 = (it & 131071) * 8, k = e0 >> 10;
            const float* W = l3 ? a.in[26] : a.in[2]; const float gk = (l3 ? a.in[25] : a.in[1])[k];
            const f32x4 v0 = *(const f32x4*)(W + e0), v1 = *(const f32x4*)(W + e0 + 4);
            u32x4 w; w.x = cvt_pk_bf16(v0[0] * gk, v0[1] * gk); w.y = cvt_pk_bf16(v0[2] * gk, v0[3] * gk); w.z = cvt_pk_bf16(v1[0] * gk, v1[1] * gk); w.w = cvt_pk_bf16(v1[2] * gk, v1[3] * gk);
            *(u32x4*)((bf16_t*)(ws + WS_MIX + (l3 ? 15 : 0) * MiB + 2 * MiB) + e0) = w;
        }
        bf16_t* Dcs = (bf16_t*)(ws + WS_DCS); bf16_t* T = (bf16_t*)(ws + WS_T);
        for (int it = gt; it < 2 * 256 * 256 / 8; it += GT) {
            const int e0 = it * 8, cs = e0 >> 16, j = (e0 >> 8) & 255, c0 = e0 & 255; float v[8];
#pragma unroll
            for (int k = 0; k < 8; ++k) { const float xx = (float)((j * (c0 + k)) & 255) * (1.0f / 128.0f); v[k] = (cs ? sinpif(xx) : cospif(xx)) * 0.0625f; }
            u32x4 w; w.x = cvt_pk_bf16(v[0], v[1]); w.y = cvt_pk_bf16(v[2], v[3]); w.z = cvt_pk_bf16(v[4], v[5]); w.w = cvt_pk_bf16(v[6], v[7]);
            *(u32x4*)(Dcs + e0) = w;
        }
        for (int it = gt; it < 2048 * KF / 8; it += GT) {
            const int e0 = it * 8, p = e0 / KF, q = e0 % KF; float v[8];
#pragma unroll
            for (int k = 0; k < 8; ++k) { const int kk = q + k, cs = kk >= KFE, sidx = cs ? kk - KFE : kk; const float xx = (float)((p * sidx) & 2047) * (1.0f / 1024.0f);
                v[k] = (cs ? -sinpif(xx) : (kk <= 1024 ? cospif(xx) : 0.0f)) * 0.03125f; }
            u32x4 w; w.x = cvt_pk_bf16(v[0], v[1]); w.y = cvt_pk_bf16(v[2], v[3]); w.z = cvt_pk_bf16(v[4], v[5]); w.w = cvt_pk_bf16(v[6], v[7]);
            *(u32x4*)(T + e0) = w;
        }
    }
}

__device__ __forceinline__ void fourier_fold_phase(const Frame& F, const bf16_t* __restrict__ U, bf16_t* __restrict__ FFo) {
    OPAQUE_TID();
    const int gt = F.bid * 512 + tid, GT = F.G * 512;
#pragma unroll 4
    for (int it = gt; it < NB * KF * 128; it += GT) {
        const int ch = it & 127, r = (it >> 7) % KF, b = (it >> 7) / KF;
        const bool sinp = r >= KFE; const int s = sinp ? r - KFE : r;
        const bf16_t* ub = U + (size_t)b * S * D + ch * 8;
        u32x4 o = (u32x4){0u, 0u, 0u, 0u};
        if (s <= 1024 && !(sinp && s == 0) && !(sinp && s == 1024)) {
            const u32x4 a = *(const u32x4*)(ub + (size_t)s * D);
            if (s == 0 || s == 1024) o = a;
            else { const u32x4 c = *(const u32x4*)(ub + (size_t)(S - s) * D); const float sg = sinp ? -1.0f : 1.0f;
#pragma unroll
                for (int k = 0; k < 4; ++k) o[k] = cvt_pk_bf16(bflo(a[k]) + sg * bflo(c[k]), bfhi(a[k]) + sg * bfhi(c[k])); }
        }
        *(u32x4*)(FFo + ((size_t)b * KF + r) * D + ch * 8) = o;
    }
}

template <int HW>
__device__ __forceinline__ void pool_item(const bf16_t* U, bf16_t* P, int b, int seg, int g, int lane) {
    const int s0 = seg * 16;
    const bf16_t* base = U + (size_t)b * S * D + g * 256 + lane * 4;
    u32x2 r[16 + 2 * HW];
#pragma unroll
    for (int i = 0; i < 16 + 2 * HW; ++i) { const int t = s0 - HW + i; r[i] = (u32x2){0u, 0u}; if (t >= 0 && t < S) r[i] = *(const u32x2*)(base + (size_t)t * D); }
    float sum[4] = {0.f, 0.f, 0.f, 0.f};
#pragma unroll
    for (int i = 0; i < 2 * HW; ++i) { sum[0] += bflo(r[i][0]); sum[1] += bfhi(r[i][0]); sum[2] += bflo(r[i][1]); sum[3] += bfhi(r[i][1]); }
    bf16_t* ob = P + (size_t)(b * S + s0) * D + g * 256 + lane * 4;
#pragma unroll
    for (int o = 0; o < 16; ++o) {
        const int s = s0 + o, lo = (s - HW) > 0 ? (s - HW) : 0, hi = (s + HW) < S ? (s + HW) : S;
        const float inv = 1.0f / (float)(hi - lo);
        const u32x2 c = r[o + HW];
        u32x2 w; w.x = cvt_pk_bf16(sum[0] * inv - bflo(c[0]), sum[1] * inv - bfhi(c[0])); w.y = cvt_pk_bf16(sum[2] * inv - bflo(c[1]), sum[3] * inv - bfhi(c[1]));
        *(u32x2*)(ob + (size_t)o * D) = w;
        if (o < 15) { const u32x2 a = r[o + 2 * HW], d = r[o];
            sum[0] += bflo(a[0]) - bflo(d[0]); sum[1] += bfhi(a[0]) - bfhi(d[0]); sum[2] += bflo(a[1]) - bflo(d[1]); sum[3] += bfhi(a[1]) - bfhi(d[1]); }
    }
}
__device__ __forceinline__ void pool_phase(const Frame& F, const bf16_t* U, bf16_t* P) {
    OPAQUE_TID();
    const int gw = F.bid * 8 + wave, NGW = F.G * 8;
    for (int it = gw; it < NB * (S / 16) * 4; it += NGW) {
        const int g = it & 3, seg = (it >> 2) & (S / 16 - 1), b = it >> 9;
        if (g == 0) pool_item<1>(U, P, b, seg, 0, lane);
        else if (g == 1) pool_item<2>(U, P, b, seg, 1, lane);
        else if (g == 2) pool_item<4>(U, P, b, seg, 2, lane);
        else pool_item<8>(U, P, b, seg, 3, lane);
    }
}

__device__ __forceinline__ void conv_dma_rows(LAS unsigned char* tl, const bf16_t* V, int p0, int sbase, int ra, int nrows, int wave, int lane) {
    for (int c = wave; c < 2 * nrows; c += 8) {
        const int r = ra + (c >> 1), t = sbase - 15 + r;
        LAS unsigned char* dst = tl + (r & 63) * (D * 2) + (c & 1) * 1024;
        if (t >= 0 && t < S) __builtin_amdgcn_global_load_lds((const unsigned*)((const char*)V + ((long)(p0 - 15 + r)) * (D * 2) + (c & 1) * 1024 + lane * 16), (LAS unsigned*)dst, 16, 0, 0);
        else *(LAS u32x4*)(dst + lane * 16) = (u32x4){0u, 0u, 0u, 0u};
    }
}
__device__ __forceinline__ void conv_phase(const Frame& F, const bf16_t* V, bf16_t* Aout, const float* dw, const float* dwb, const float* lng, const float* lnb) {
    OPAQUE_TID();
    f32x2 wv[31];
    { const float* p = dw + 2 * tid;
#pragma unroll
      for (int j = 0; j < 31; ++j) { wv[j] = *(const f32x2*)p; p += D; if ((j & 3) == 3) asm volatile("" ::: "memory"); } }
    const f32x2 bb = *(const f32x2*)(dwb + 2 * tid), gg = *(const f32x2*)(lng + 2 * tid), lb = *(const f32x2*)(lnb + 2 * tid);
    LAS unsigned char* tl = F.lds;
    LAS float* part = (LAS float*)(F.lds + 131072 + 1024);
    LAS float* stat = (LAS float*)(F.lds + 131072 + 2048);
    for (int strip = F.bid; strip < M / 128; strip += F.G) {
        const int p0 = strip * 128, sbase = p0 & (S - 1);
        conv_dma_rows(tl, V, p0, sbase, 0, 46, wave, lane);
#pragma unroll 1
        for (int k = 0; k < 8; ++k) {
            asm volatile("s_waitcnt vmcnt(0) lgkmcnt(0)" ::: "memory");
            __syncthreads();
            if (k < 7) conv_dma_rows(tl, V, p0, sbase, 46 + 16 * k, 16, wave, lane);
#pragma unroll 1
            for (int h = 0; h < 2; ++h) {
                const int rb = 16 * k + 8 * h;
                const LAS unsigned char* tlt = tl + tid * 4;
                f32x2 av[8];
#pragma unroll
                for (int o = 0; o < 8; ++o) av[o] = bb;
#pragma unroll
                for (int tt = 0; tt < 38; ++tt) {
                    const unsigned w = *(const LAS unsigned*)(tlt + ((rb + tt) & 63) * (D * 2));
                    const f32x2 xv = (f32x2){bflo(w), bfhi(w)};
#pragma unroll
                    for (int o = 0; o < 8; ++o) { const int j = tt - o; if (j >= 0 && j <= 30) av[o] = __builtin_elementwise_fma(xv, wv[j], av[o]); }
                    if ((tt & 7) == 7) asm volatile("" ::: "memory");
                }
                float vals[16];
#pragma unroll
                for (int o = 0; o < 8; ++o) { vals[o] = av[o][0] + av[o][1]; vals[8 + o] = av[o][0] * av[o][0] + av[o][1] * av[o][1]; }
#pragma unroll
                for (int step = 0; step < 4; ++step) {
                    const int half = 8 >> step; const bool up = (lane >> step) & 1;
#pragma unroll
                    for (int i = 0; i < half; ++i) { const float keep = up ? vals[i + half] : vals[i], send = up ? vals[i] : vals[i + half]; vals[i] = keep + __shfl_xor(send, 1 << step); }
                }
                vals[0] += __shfl_xor(vals[0], 16); vals[0] += __shfl_xor(vals[0], 32);
                if (lane < 16) { const int l = lane; const int idx = ((l & 1) << 3) | ((l & 2) << 1) | ((l & 4) >> 1) | ((l & 8) >> 3); part[wave * 16 + idx] = vals[0]; }
                __syncthreads();
                if (tid < 8) { float s1 = 0.f, s2 = 0.f;
#pragma unroll
                    for (int w = 0; w < 8; ++w) { s1 += part[w * 16 + tid]; s2 += part[w * 16 + 8 + tid]; }
                    const float mean = s1 * (1.0f / D), var = s2 * (1.0f / D) - mean * mean;
                    stat[2 * tid] = mean; stat[2 * tid + 1] = __builtin_amdgcn_rsqf(fmaxf(var, 0.f) + LN_EPS); }
                __syncthreads();
                unsigned* op = (unsigned*)(Aout + (size_t)(p0 + rb) * D) + tid;
#pragma unroll
                for (int o = 0; o < 8; ++o) {
                    const float mean = stat[2 * o], rstd = stat[2 * o + 1];
                    const float y0 = (av[o][0] - mean) * rstd * gg[0] + lb[0], y1 = (av[o][1] - mean) * rstd * gg[1] + lb[1];
                    const float z0 = y0 * __builtin_amdgcn_rcpf(1.0f + __builtin_amdgcn_exp2f(-1.44269504089f * y0)), z1 = y1 * __builtin_amdgcn_rcpf(1.0f + __builtin_amdgcn_exp2f(-1.44269504089f * y1));
                    *op = cvt_pk_bf16(z0, z1); op += D / 2;
                    if ((o & 3) == 3) asm volatile("" ::: "memory");
                }
            }
        }
        __syncthreads();
    }
}

__device__ __forceinline__ void final_phase(const Frame& F, float* out, const bf16_t* xb, const float* rowsq, const float* g) {
    OPAQUE_TID();
    const int gw = F.bid * 8 + wave, NGW = F.G * 8;
    f32x4 gv[4];
#pragma unroll
    for (int j = 0; j < 4; ++j) gv[j] = ((const f32x4*)g)[lane + 64 * j];
    for (int m = gw; m < M; m += 2 * NGW) {
        const int m2 = m + NGW;
        const float q0 = lane < 4 ? rowsq[(size_t)m * 4 + lane] : 0.f, q1 = (m2 < M && lane < 4) ? rowsq[(size_t)m2 * 4 + lane] : 0.f;
        u32x2 a[4], b[4];
#pragma unroll
        for (int j = 0; j < 4; ++j) { a[j] = ((const u32x2*)(xb + (size_t)m * D))[lane + 64 * j]; b[j] = (m2 < M) ? ((const u32x2*)(xb + (size_t)m2 * D))[lane + 64 * j] : (u32x2){0u, 0u}; }
        const float r0 = __builtin_amdgcn_rsqf(wave_sum(q0) * (1.0f / D) + NORM_EPS), r1 = __builtin_amdgcn_rsqf(wave_sum(q1) * (1.0f / D) + NORM_EPS);
        f32x4* o0 = (f32x4*)(out + (size_t)m * D) + lane; f32x4* o1 = (f32x4*)(out + (size_t)m2 * D) + lane;
#pragma unroll
        for (int j = 0; j < 4; ++j) { const f32x4 v = (f32x4){bflo(a[j][0]), bfhi(a[j][0]), bflo(a[j][1]), bfhi(a[j][1])}; o0[64 * j] = v * r0 * gv[j]; }
        if (m2 < M) {
#pragma unroll
            for (int j = 0; j < 4; ++j) { const f32x4 v = (f32x4){bflo(b[j][0]), bfhi(b[j][0]), bflo(b[j][1]), bfhi(b[j][1])}; o1[64 * j] = v * r1 * gv[j]; } }
    }
}

__global__ void __launch_bounds__(512, 2) fwd_megakernel(Args args) {
    extern __shared__ __attribute__((aligned(16))) unsigned char lds_raw[];
    cg::grid_group grid = cg::this_grid();
    Frame F; F.lds = (LAS unsigned char*)lds_raw; F.G = gridDim.x; F.bid = blockIdx.x;
    unsigned char* ws = args.ws;
    float* X = args.out;
    bf16_t* XB = (bf16_t*)(ws + WS_XB); float* ROWSQ = (float*)(ws + WS_ROWSQ);
    bf16_t* ACT1 = (bf16_t*)(ws + WS_ACT1); bf16_t* ACT2 = (bf16_t*)(ws + WS_ACT2); bf16_t* YT = (bf16_t*)(ws + WS_YT); bf16_t* HB = (bf16_t*)(ws + WS_H);
    volatile LAS unsigned* bst = (volatile LAS unsigned*)(F.lds + 131072 + 512);
    if (threadIdx.x < 2) bst[threadIdx.x] = 0u;
    __syncthreads();
    const XcdBarrier xbar = xcd_barrier_post((unsigned*)ws, bst);
#define GSYNC() xcd_barrier(xbar)
#define RUN_GEMM(EPI, A_, B_, LDA, LDB, K_, MODE, MR, NC, APN, ...) RUN_GEMM_S(0u, EPI, A_, B_, LDA, LDB, K_, MODE, MR, NC, APN, __VA_ARGS__)
#define RUN_GEMM_S(STAG, EPI, A_, B_, LDA, LDB, K_, MODE, MR, NC, APN, ...) do { pg8::Gemm g_{(A_), (B_), (LDA), (LDB), (K_)}; pg8::Order S_; S_.init((MODE), (MR), (NC), F.G, F.bid, (LDA), (LDB), (APN)); \
        EPI E_{__VA_ARGS__}; pg8::gemm_phase<EPI>(F.lds, g_, S_, E_, STAG); } while (0)

    if (args.ws == nullptr) grid.sync();
    prep_phase(F, args);
    GSYNC();
    RUN_GEMM(pg8::EpiBf16<0>, (const bf16_t*)(ws + WS_MIXB), (const bf16_t*)(ws + WS_MIX + 2 * MiB), 256, D, 256, 3, 32 * 256, 256, 0, (bf16_t*)(ws + WS_MIX), D, nullptr, 1.0f);
    GSYNC();
#pragma unroll 1
    for (int l = 0; l < 4; ++l) {
        const bf16_t* Win = (const bf16_t*)(ws + WS_MIX + (size_t)l * 5 * MiB);
        const bf16_t* Wout = (const bf16_t*)(ws + WS_MIXB + (size_t)l * 3 * MiB + MiB);
        if (l == 0 || l == 3) {
            RUN_GEMM(pg8::EpiBf16<0>, XB, Win, D, D, D, 0, M, D, 0, ACT1, D, ROWSQ, 1.0f);
            GSYNC();
            pool_phase(F, ACT1, ACT2);
            GSYNC();
            RUN_GEMM(pg8::EpiRes, ACT2, Wout, D, D, D, 0, M, D, 0, (l == 0) ? 0 : 1, args.in[0], XB, X, ROWSQ);
            GSYNC();
        } else if (l == 1) {
            RUN_GEMM(pg8::EpiBf16<2>, XB, Win, D, D, D, 0, M, 2 * D, 0, ACT1, D, ROWSQ, 1.0f);
            GSYNC();
            conv_phase(F, ACT1, ACT2, args.in[11], args.in[12], args.in[13], args.in[14]);
            GSYNC();
            RUN_GEMM(pg8::EpiRes, ACT2, Wout, D, D, D, 0, M, D, 0, (l == 0) ? 0 : 1, args.in[0], XB, X, ROWSQ);
            GSYNC();
        } else {
            RUN_GEMM(pg8::EpiBf16<0>, XB, Win, D, D, D, 0, M, D, 0, ACT1, D, ROWSQ, 1.0f);
            GSYNC();
            fourier_fold_phase(F, ACT1, (bf16_t*)(ws + WS_FF));
            GSYNC();
            RUN_GEMM(pg8::EpiBf16<0>, (const bf16_t*)(ws + WS_DCS), (const bf16_t*)(ws + WS_FF), 256, D, 256, 1, 256 * 576, 256, 0, YT, KF, nullptr, 1.0f);
            GSYNC();
            RUN_GEMM(pg8::EpiBf16<0>, (const bf16_t*)(ws + WS_T), YT, KF, KF, KF, 2, 256 * 512, 256, 0, ACT2, D, nullptr, 0.70710678118f);
            GSYNC();
            RUN_GEMM(pg8::EpiRes, ACT2, Wout, D, D, D, 0, M, D, 0, (l == 0) ? 0 : 1, args.in[0], XB, X, ROWSQ);
            GSYNC();
        }
#pragma unroll 1
        for (int c_ = 0; c_ < 2; ++c_) {
            int c = c_; asm volatile("" : "+s"(c));
            const size_t r0 = (size_t)c * (M / 2);
            RUN_GEMM_S(0u, pg8::EpiBf16<1>, XB + r0 * D, (const bf16_t*)(ws + WS_WUP + (size_t)l * 16 * MiB), D, D, D, 0, M / 2, FF, 0, HB, FF, ROWSQ + r0 * 4, 1.0f);
            GSYNC();
            RUN_GEMM(pg8::EpiRes, HB, (const bf16_t*)(ws + WS_WDN + (size_t)l * 16 * MiB), FF, FF, FF, 0, M / 2, D, 0, 1, args.in[0], XB + r0 * D, X, ROWSQ + r0 * 4);
            GSYNC();
        }
    }
    final_phase(F, X, XB, ROWSQ, args.in[33]);
}

extern "C" void kernel_launch(void* const* d_in, const int* in_sizes, int n_in, void* d_out, int out_size, void* d_ws, size_t ws_size, hipStream_t stream) {
    static int grid = 0;
    if (grid == 0) {
        if (n_in != 34 || out_size != M * D || ws_size < WS_END) { fprintf(stderr, "kernel_launch: unexpected problem (n_in %d, out %d, ws %zu < %zu)\n", n_in, out_size, ws_size, (size_t)WS_END); grid = -1; return; }
        int dev = 0, cus = 0, per_cu = 0;
        if (hipGetDevice(&dev) != hipSuccess || hipDeviceGetAttribute(&cus, hipDeviceAttributeMultiprocessorCount, dev) != hipSuccess) { grid = -1; return; }
        if (hipFuncSetAttribute((const void*)fwd_megakernel, hipFuncAttributeMaxDynamicSharedMemorySize, LDS_BYTES) != hipSuccess) { fprintf(stderr, "hipFuncSetAttribute failed\n"); grid = -1; return; }
        if (hipOccupancyMaxActiveBlocksPerMultiprocessor(&per_cu, (const void*)fwd_megakernel, 512, LDS_BYTES) != hipSuccess || per_cu < 1) { fprintf(stderr, "occupancy query: %d\n", per_cu); }
        (void)hipGetLastError();
        grid = cus;
    }
    if (grid < 0) return;
    if (hipMemsetAsync(d_ws, 0, 16384, stream) != hipSuccess) { fprintf(stderr, "kernel_launch: memset failed\n"); return; }
    Args a{};
    for (int i = 0; i < 34; ++i) a.in[i] = (const float*)d_in[i];
    a.out = (float*)d_out; a.ws = (unsigned char*)d_ws;
    void* kargs[] = {&a};
    hipError_t e = hipLaunchCooperativeKernel((const void*)fwd_megakernel, dim3(grid), dim3(512), kargs, LDS_BYTES, stream);
    if (e != hipSuccess) fprintf(stderr, "cooperative launch failed: %s (grid %d)\n", hipGetErrorString(e), grid);
}
```

```cpp
#include <hip/hip_runtime.h>
#include <hip/hip_cooperative_groups.h>
#include <cstdio>
#include <cstdint>
namespace cg = cooperative_groups;

#define LAS __attribute__((address_space(3)))
typedef unsigned short bf16_t;
typedef short bf16x8 __attribute__((ext_vector_type(8)));
typedef float f32x4 __attribute__((ext_vector_type(4)));
typedef float f32x2 __attribute__((ext_vector_type(2)));
typedef unsigned u32x4 __attribute__((ext_vector_type(4)));
typedef unsigned u32x2 __attribute__((ext_vector_type(2)));

constexpr int NB = 16, S = 2048, D = 1024, M = NB * S, FF = 4096;
constexpr float NORM_EPS = 1e-6f, LN_EPS = 1e-5f;
constexpr size_t MiB = 1u << 20;
constexpr size_t WS_ROWSQ = 1 * MiB;
constexpr size_t WS_DCS = 3 * MiB;
constexpr size_t WS_T = 4 * MiB;
constexpr size_t WS_WUP = 20 * MiB;
constexpr size_t WS_WDN = 28 * MiB;
constexpr size_t WS_MIX = 84 * MiB;
constexpr size_t WS_MIXB = 104 * MiB;
constexpr size_t WS_XB = 116 * MiB;
constexpr size_t WS_H = 180 * MiB;
constexpr size_t WS_ACT1 = WS_H, WS_ACT2 = WS_H + 64 * MiB, WS_FF = WS_H + 64 * MiB, WS_YT = WS_H + 144 * MiB, WS_ACT3 = WS_H + 128 * MiB;
constexpr size_t WS_END = WS_H + 256 * MiB;
constexpr int LDS_BYTES = 147456;
constexpr int KFE = 1280, KF = KFE + 1024;

__device__ __forceinline__ unsigned cvt_pk_bf16(float lo, float hi) { unsigned r; asm volatile("v_cvt_pk_bf16_f32 %0, %1, %2" : "=v"(r) : "v"(lo), "v"(hi)); return r; }
__device__ __forceinline__ float bflo(unsigned w) { return __uint_as_float(w << 16); }
__device__ __forceinline__ float bfhi(unsigned w) { return __uint_as_float(w & 0xffff0000u); }

namespace pg8 {
constexpr int BM = 256, BK = 64, HALF = 128, HTB = HALF * BK * 2, STAGE_BYTES = 8 * HTB, NXCD = 8, WGM = 2;
__host__ __device__ __forceinline__ int lds_byte(int r, int c) { const int st = (r >> 4) * 2 + (c >> 5), rr = r & 15, cc = c & 31, ob = rr * 64 + cc * 2; return st * 1024 + (ob ^ (((ob >> 9) & 1) << 5)); }
__host__ __device__ __forceinline__ void stage_rc(int b, int& R, int& C) { const int st = b / 1024, sb = b % 1024, swz = sb ^ (((sb >> 9) & 1) << 5); R = (st >> 1) * 16 + swz / 64; C = (st & 1) * 32 + (swz % 64) / 2; }
__host__ __device__ __forceinline__ int perm32(int rho) { const int n = rho >> 4, i = rho & 15; return 8 * (i >> 2) + 4 * n + (i & 3); }

struct Unit { long aoff, boff; int row0, col0; };
struct Gemm { const bf16_t* A; const bf16_t* Bt; int lda, ldb, K; };

struct Order {
    int mode, nM, nN, nwg, G, c, lda, ldb; long a_pn_bytes;
    __device__ __forceinline__ void init(int mode_, int Mr, int Nc, int G_, int c_, int lda_, int ldb_, long apn) { mode = mode_; nM = Mr / BM; nN = Nc / BM; nwg = nM * nN; G = G_; c = c_; lda = lda_; ldb = ldb_; a_pn_bytes = apn; }
    __device__ __forceinline__ bool next(int i, Unit& u) const {
        const long L = (long)i * G + c; if (L >= nwg) return false;
        if (mode == 0) {
            int wgid = (int)L; { const int q = nwg / NXCD, r = nwg % NXCD, xcd = wgid % NXCD, off = wgid / NXCD; wgid = (xcd < r ? xcd * (q + 1) : r * (q + 1) + (xcd - r) * q) + off; }
            const int nig = WGM * nN, gid = wgid / nig, fm = gid * WGM, gsz = (nM - fm) < WGM ? (nM - fm) : WGM;
            const int pm = fm + ((wgid % nig) % gsz), pn = (wgid % nig) / gsz;
            u.aoff = (long)pm * BM * lda * 2 + (long)pn * a_pn_bytes; u.boff = (long)pn * BM * ldb * 2; u.row0 = pm * BM; u.col0 = pn * BM;
        } else if (mode == 1) {
            const int w = (int)L, t = w % 9, g = (w / 9) & 3, b = w / 36, cs = (t >= 5) ? 1 : 0;
            u.aoff = (long)cs * 256 * 256 * 2; u.boff = ((long)(b * KF + t * 256) * D + g * 256) * 2; u.row0 = b * 1024 + g * 256; u.col0 = t * 256;
        } else if (mode == 3) {
            const int w = (int)L, layer = w >> 4, pm = (w >> 2) & 3, pn = w & 3;
            u.aoff = (long)layer * 9 * 1048576 + (long)pm * 256 * 256 * 2; u.boff = (long)layer * 15 * 1048576 + (long)pn * 256 * 1024 * 2 + pm * 512; u.row0 = layer * 7680 + pm * 256; u.col0 = pn * 256;
        } else {
            int b, pm, pn;
            if (G == 256) { const int xcd = c & 7, loc = c >> 3; b = i * 8 + xcd; pm = loc & 7; pn = loc >> 3; }
            else { const int w = (int)L; b = w >> 5; pm = w & 7; pn = (w >> 3) & 3; }
            u.aoff = (long)pm * 256 * KF * 2; u.boff = ((long)b * 1024 + pn * 256) * KF * 2; u.row0 = b * S + pm * 256; u.col0 = pn * 256;
        }
        return true;
    }
};

__device__ __forceinline__ float row_rstd(const float* rowsq, int row) {
    const f32x4 s = *(const f32x4*)(rowsq + (size_t)row * 4);
    const float t = (s[0] + s[1]) + (s[2] + s[3]);
    return __builtin_amdgcn_rsqf(t * (1.0f / D) + NORM_EPS);
}
template <int ACT> struct EpiBf16 {
    static constexpr bool PERM = true;
    bf16_t* O; int ldc; const float* rowsq; float post;
    template <class Sched> __device__ __forceinline__ void prefill(LAS unsigned char* lds, const Sched& S, int tid) const {
        if (!rowsq) return;
        LAS float* rsl = (LAS float*)(lds + 139264);
        Unit u;
        for (int i = 0; i < 8 && S.next(i, u); ++i) if (tid < 256) rsl[i * 256 + tid] = post * row_rstd(rowsq, u.row0 + tid);
        asm volatile("s_waitcnt vmcnt(0) lgkmcnt(0)" ::: "memory");
    }
    __device__ __forceinline__ void operator()(const f32x4 (&acc)[2][2][4][2], const Unit& u, int wr, int wc, int fr, int fq, LAS unsigned char* lds, int, int ui) const {
        const int row0 = u.row0 + wr * 64 + fr;
        const int col0 = (ACT == 2 ? (u.col0 >> 1) : u.col0) + wc * 32 + 8 * fq;
        const LAS float* rsl = (const LAS float*)(lds + 139264) + (ui & 7) * 256 + wr * 64 + fr;
        float rs[2][4];
#pragma unroll
        for (int ai = 0; ai < 2; ++ai)
#pragma unroll
            for (int m = 0; m < 4; ++m) rs[ai][m] = rowsq ? rsl[ai * HALF + m * 16] : post;
#pragma unroll
        for (int ai = 0; ai < 2; ++ai)
#pragma unroll
            for (int m = 0; m < 4; ++m) {
                const int row = row0 + ai * HALF + m * 16;
                const float sc = rs[ai][m];
                bf16_t* rowp = O + (size_t)row * ldc + col0;
                if (ACT == 2) {
                    f32x4 v0 = acc[ai][0][m][0] * sc, v1 = acc[ai][0][m][1] * sc, g0 = acc[ai][1][m][0] * sc, g1 = acc[ai][1][m][1] * sc;
#pragma unroll
                    for (int i = 0; i < 4; ++i) {
                        v0[i] = v0[i] * __builtin_amdgcn_rcpf(1.0f + __builtin_amdgcn_exp2f(-1.44269504089f * g0[i]));
                        v1[i] = v1[i] * __builtin_amdgcn_rcpf(1.0f + __builtin_amdgcn_exp2f(-1.44269504089f * g1[i])); }
                    u32x4 w; w.x = cvt_pk_bf16(v0[0], v0[1]); w.y = cvt_pk_bf16(v0[2], v0[3]); w.z = cvt_pk_bf16(v1[0], v1[1]); w.w = cvt_pk_bf16(v1[2], v1[3]);
                    *(u32x4*)rowp = w;
                } else {
#pragma unroll
                    for (int bj = 0; bj < 2; ++bj) {
                        f32x4 v0 = acc[ai][bj][m][0] * sc, v1 = acc[ai][bj][m][1] * sc;
                        if (ACT == 1) {
#pragma unroll
                            for (int i = 0; i < 4; ++i) { const float a = fmaxf(v0[i], 0.f), b = fmaxf(v1[i], 0.f); v0[i] = a * a; v1[i] = b * b; } }
                        u32x4 w; w.x = cvt_pk_bf16(v0[0], v0[1]); w.y = cvt_pk_bf16(v0[2], v0[3]); w.z = cvt_pk_bf16(v1[0], v1[1]); w.w = cvt_pk_bf16(v1[2], v1[3]);
                        *(u32x4*)(rowp + bj * HALF) = w; }
                }
                asm volatile("" ::: "memory");
            }
    }
};
struct EpiRes {
    static constexpr bool PERM = true;
    template <class Sched> __device__ __forceinline__ void prefill(LAS unsigned char*, const Sched&, int) const {}
    int mode; const float* xin; bf16_t* xb; float* xout; float* rowsq;
    __device__ __forceinline__ void operator()(const f32x4 (&acc)[2][2][4][2], const Unit& u, int wr, int wc, int fr, int fq, LAS unsigned char* lds, int tid, int) const {
        const int colb = u.col0 + wc * 32 + 8 * fq, pn = u.col0 >> 8;
        LAS float* xch = (LAS float*)(lds + 135168);
        const size_t off0 = (size_t)(u.row0 + wr * 64 + fr) * D + colb;
#define EPIRES_BODY(it_, c0_, c1_) do { const int ai = (it_) >> 2, m = (it_) & 3; const size_t off = off0 + (size_t)(ai * HALF + m * 16) * D; float ss = 0.f; \
            _Pragma("unroll") for (int bj = 0; bj < 2; ++bj) { \
                const f32x4 o0 = (c0_)[bj] + acc[ai][bj][m][0], o1 = (c1_)[bj] + acc[ai][bj][m][1]; \
                ss += ((o0[0] * o0[0] + o0[1] * o0[1]) + (o0[2] * o0[2] + o0[3] * o0[3])) + ((o1[0] * o1[0] + o1[1] * o1[1]) + (o1[2] * o1[2] + o1[3] * o1[3])); \
                if (mode == 2) { *(f32x4*)(xout + off + bj * HALF) = o0; *(f32x4*)(xout + off + bj * HALF + 4) = o1; } \
                else { u32x4 w; w.x = cvt_pk_bf16(o0[0], o0[1]); w.y = cvt_pk_bf16(o0[2], o0[3]); w.z = cvt_pk_bf16(o1[0], o1[1]); w.w = cvt_pk_bf16(o1[2], o1[3]); *(u32x4*)(xb + off + bj * HALF) = w; } } \
            ss += __shfl_xor(ss, 16); ss += __shfl_xor(ss, 32); \
            if (fq == 0) xch[(ai * HALF + wr * 64 + m * 16 + fr) * 4 + wc] = ss; } while (0)
        if (mode != 0) {
            u32x4 xo[8][2];
#pragma unroll
            for (int it = 0; it < 8; ++it)
#pragma unroll
                for (int bj = 0; bj < 2; ++bj) xo[it][bj] = *(const u32x4*)(xb + off0 + (size_t)((it >> 2) * HALF + (it & 3) * 16) * D + bj * HALF);
            asm volatile("" ::: "memory");
#pragma unroll
            for (int it = 0; it < 8; ++it) {
                f32x4 c0[2], c1[2];
#pragma unroll
                for (int bj = 0; bj < 2; ++bj) { const u32x4 w_ = xo[it][bj]; c0[bj] = (f32x4){bflo(w_[0]), bfhi(w_[0]), bflo(w_[1]), bfhi(w_[1])}; c1[bj] = (f32x4){bflo(w_[2]), bfhi(w_[2]), bflo(w_[3]), bfhi(w_[3])}; }
                EPIRES_BODY(it, c0, c1);
            }
        } else {
#pragma unroll
            for (int h = 0; h < 2; ++h) {
                f32x4 xf0[4][2], xf1[4][2];
#pragma unroll
                for (int q = 0; q < 4; ++q)
#pragma unroll
                    for (int bj = 0; bj < 2; ++bj) { const float* p = xin + off0 + (size_t)(h * HALF + q * 16) * D + bj * HALF; xf0[q][bj] = *(const f32x4*)p; xf1[q][bj] = *(const f32x4*)(p + 4); }
                asm volatile("" ::: "memory");
#pragma unroll
                for (int q = 0; q < 4; ++q) EPIRES_BODY(h * 4 + q, xf0[q], xf1[q]);
                asm volatile("" ::: "memory");
            }
        }
#undef EPIRES_BODY
        asm volatile("s_waitcnt lgkmcnt(0)" ::: "memory"); __builtin_amdgcn_s_barrier(); asm volatile("" ::: "memory");
        if (tid < 256) { const f32x4 v = *(const LAS f32x4*)(xch + tid * 4); rowsq[(size_t)(u.row0 + tid) * 4 + pn] = (v[0] + v[1]) + (v[2] + v[3]); }
    }
};

template <class Epi>
__device__ __forceinline__ void gemm_phase(LAS unsigned char* lds, const Gemm g, const Order& S, const Epi& E, const unsigned stag = 0u) {
    int tid_ = threadIdx.x; asm volatile("" : "+v"(tid_));
    const int tid = tid_, wid = __builtin_amdgcn_readfirstlane(tid >> 6), lane = tid & 63, wr = wid >> 2, wc = wid & 3, fr = lane & 15, fq = lane >> 4;
    const int K = g.K, nt = K / BK;
    unsigned voffA[2], voffB[2];
#pragma unroll
    for (int i = 0; i < 2; ++i) { int R, C; stage_rc(tid * 16 + i * 8192, R, C); const int Rb = Epi::PERM ? ((R & ~31) + perm32(R & 31)) : R;
        voffA[i] = (unsigned)(R * g.lda + C) * 2u; voffB[i] = (unsigned)(Rb * g.ldb + C) * 2u; }
    const size_t kstep = (size_t)(BK * 2);
    const size_t hstepA = (size_t)HALF * g.lda * 2, hstepB = (size_t)HALF * g.ldb * 2;
    const unsigned ldsw = (unsigned)wid * 1024u;
    const int aoff = lds_byte(wr * 64 + fr, fq * 8), boff = lds_byte(wc * 32 + fr, fq * 8);
#define PG8_SA(b, h) (((b) * 2 + (h)) * HTB)
#define PG8_SB(b, h) ((4 + (b) * 2 + (h)) * HTB)
#define PG8_STAGE(bufoff, gbase, voff) do { _Pragma("unroll") for (int _i = 0; _i < 2; ++_i) \
        __builtin_amdgcn_global_load_lds((const unsigned*)((const char*)(gbase) + (voff)[_i]), (LAS unsigned*)(lds + (bufoff) + ldsw + _i * 8192), 16, 0, 0); } while (0)
#define PG8_LDA(dst, b, h) do { _Pragma("unroll") for (int m = 0; m < 4; ++m) _Pragma("unroll") for (int k = 0; k < 2; ++k) dst[m][k] = *(const LAS bf16x8*)(lds + PG8_SA(b, h) + aoff + m * 2048 + k * 1024); } while (0)
#define PG8_LDB(dst, b, h) do { _Pragma("unroll") for (int n = 0; n < 2; ++n) _Pragma("unroll") for (int k = 0; k < 2; ++k) dst[n][k] = *(const LAS bf16x8*)(lds + PG8_SB(b, h) + boff + n * 2048 + k * 1024); } while (0)
#define PG8_MMA(ai, bj, At, Bt) do { __builtin_amdgcn_s_setprio(1); _Pragma("unroll") for (int m = 0; m < 4; ++m) _Pragma("unroll") for (int n = 0; n < 2; ++n) _Pragma("unroll") for (int k = 0; k < 2; ++k) \
        acc[ai][bj][m][n] = __builtin_amdgcn_mfma_f32_16x16x32_bf16(Bt[n][k], At[m][k], acc[ai][bj][m][n], 0, 0, 0); __builtin_amdgcn_s_setprio(0); } while (0)
#define PG8_WAIT_V(n) asm volatile("s_waitcnt vmcnt(" #n ")" ::: "memory")
#define PG8_WAIT_L(n) asm volatile("s_waitcnt lgkmcnt(" #n ")" ::: "memory")
#define PG8_BAR __builtin_amdgcn_s_barrier()
#define PG8_SCHED __builtin_amdgcn_sched_barrier(0)
    Unit cur, nxt; int ui = 0;
    if (!S.next(0, cur)) return;
    if (stag) {
        const unsigned long long t0 = __builtin_amdgcn_s_memrealtime(), dl = (unsigned long long)(((unsigned)cur.col0 >> 8) & 3u) * stag;
        while (__builtin_amdgcn_s_memrealtime() - t0 < dl) __builtin_amdgcn_s_sleep(8);
    }
    f32x4 acc[2][2][4][2];
#pragma unroll
    for (int a = 0; a < 2; ++a)
#pragma unroll
        for (int b = 0; b < 2; ++b)
#pragma unroll
            for (int m = 0; m < 4; ++m)
#pragma unroll
                for (int n = 0; n < 2; ++n) acc[a][b][m][n] = (f32x4){0.f, 0.f, 0.f, 0.f};
    E.prefill(lds, S, tid);
    bf16x8 At[4][2], B0[2][2], B1[2][2];
    const char* cA = (const char*)g.A + cur.aoff; const char* cB = (const char*)g.Bt + cur.boff;
    PG8_STAGE(PG8_SB(0, 0), cB, voffB); PG8_STAGE(PG8_SB(0, 1), cB + hstepB, voffB); PG8_STAGE(PG8_SA(0, 0), cA, voffA); PG8_STAGE(PG8_SA(0, 1), cA + hstepA, voffA);
    if (wr == 1) PG8_BAR;
    PG8_WAIT_V(2); PG8_BAR;
    PG8_STAGE(PG8_SB(1, 0), cB + kstep, voffB); PG8_STAGE(PG8_SA(1, 0), cA + kstep, voffA); PG8_STAGE(PG8_SB(1, 1), cB + hstepB + kstep, voffB);
    PG8_WAIT_V(6); PG8_BAR;
    for (;;) {
        const bool has_next = S.next(ui + 1, nxt);
        const char* nA = has_next ? (const char*)g.A + nxt.aoff : cA; const char* nB = has_next ? (const char*)g.Bt + nxt.boff : cB;
        for (int t = 0; t < nt; t += 2) {
            const bool last = (t == nt - 2);
            const char* a1 = cA + (size_t)(t + 1) * kstep;
            const char* a2 = last ? nA : cA + (size_t)(t + 2) * kstep; const char* b2 = last ? nB : cB + (size_t)(t + 2) * kstep;
            const char* a3 = a2 + kstep; const char* b3 = b2 + kstep;
            PG8_LDB(B0, 0, 0); PG8_LDB(B1, 0, 1); PG8_SCHED; PG8_LDA(At, 0, 0); PG8_STAGE(PG8_SA(1, 1), a1 + hstepA, voffA);
            PG8_WAIT_V(8); PG8_WAIT_L(0); PG8_BAR; PG8_MMA(0, 0, At, B0); PG8_MMA(0, 1, At, B1); PG8_BAR; PG8_SCHED;
            PG8_LDA(At, 0, 1); PG8_STAGE(PG8_SB(0, 0), b2, voffB); PG8_STAGE(PG8_SB(0, 1), b2 + hstepB, voffB); PG8_STAGE(PG8_SA(0, 0), a2, voffA);
            PG8_WAIT_V(8); PG8_WAIT_L(0); PG8_BAR; PG8_MMA(1, 0, At, B0); PG8_MMA(1, 1, At, B1); PG8_BAR; PG8_SCHED;
            PG8_LDB(B0, 1, 0); PG8_LDB(B1, 1, 1); PG8_SCHED; PG8_LDA(At, 1, 0); PG8_STAGE(PG8_SA(0, 1), a2 + hstepA, voffA);
            PG8_WAIT_V(8); PG8_WAIT_L(0); PG8_BAR; PG8_MMA(0, 0, At, B0); PG8_MMA(0, 1, At, B1); PG8_BAR; PG8_SCHED;
            PG8_LDA(At, 1, 1); PG8_STAGE(PG8_SB(1, 0), b3, voffB); PG8_STAGE(PG8_SB(1, 1), b3 + hstepB, voffB); PG8_STAGE(PG8_SA(1, 0), a3, voffA);
            PG8_WAIT_V(8); PG8_WAIT_L(0); PG8_BAR; PG8_MMA(1, 0, At, B0); PG8_MMA(1, 1, At, B1); PG8_BAR; PG8_SCHED;
        }
        if (wr == 0) PG8_BAR;
        E(acc, cur, wr, wc, fr, fq, lds, tid, ui);
        if (!has_next) break;
#pragma unroll
        for (int a = 0; a < 2; ++a)
#pragma unroll
            for (int b = 0; b < 2; ++b)
#pragma unroll
                for (int m = 0; m < 4; ++m)
#pragma unroll
                    for (int n = 0; n < 2; ++n) acc[a][b][m][n] = (f32x4){0.f, 0.f, 0.f, 0.f};
        cur = nxt; cA = nA; cB = nB; ++ui;
        if (wr == 1) PG8_BAR;
    }
    PG8_WAIT_V(0);
    PG8_BAR;
#undef PG8_SA
#undef PG8_SB
#undef PG8_STAGE
#undef PG8_LDA
#undef PG8_LDB
#undef PG8_MMA
#undef PG8_WAIT_V
#undef PG8_WAIT_L
#undef PG8_BAR
#undef PG8_SCHED
}
}


#define XB_TMO      128
#define XB_XCNT(j)  (256  + 64 * (j))
#define XB_XSUB(j)  (1280 + 64 * (j))
#define XB_XGEN(j)  (2304 + 64 * (j))
#define XB_TOP      3328
#define XB_TOPGEN   3392
#define XCD_BAR_WORDS 3456
#define XB_SPIN_CAP (1u << 22)
__device__ __forceinline__ unsigned xb_ld(unsigned* p)              { return __hip_atomic_load(p, __ATOMIC_RELAXED, __HIP_MEMORY_SCOPE_AGENT); }
__device__ __forceinline__ unsigned xb_add(unsigned* p, unsigned v) { return __hip_atomic_fetch_add(p, v, __ATOMIC_RELAXED, __HIP_MEMORY_SCOPE_AGENT); }
__device__ __forceinline__ unsigned xb_xcc_id() { return (unsigned)__builtin_amdgcn_s_getreg((3 << 11) | 20) & 0xFu; }
#define XB_SPIN(cond, bar) do { unsigned _sp = 0; while (cond) { __builtin_amdgcn_s_sleep(1); \
    if ((++_sp & 255u) == 0u) { if (xb_ld(&(bar)[XB_TMO])) break; if (_sp > XB_SPIN_CAP) { atomicAdd(&(bar)[XB_TMO], 1u); break; } } } } while (0)
struct XcdBarrier { unsigned* bar; unsigned x; volatile LAS unsigned* st; };
__device__ __forceinline__ XcdBarrier xcd_barrier_post(unsigned* bar, volatile LAS unsigned* st) {
    XcdBarrier b; b.bar = bar; b.x = xb_xcc_id(); b.st = st;
    if (threadIdx.x == 0) (void)xb_add(&bar[XB_XCNT(b.x)], 1u);
    return b;
}
__device__ __forceinline__ void xcd_barrier_complete(unsigned* bar, unsigned x, unsigned& nloc, unsigned& nx) {
    const unsigned G = gridDim.x * gridDim.y * gridDim.z;
    unsigned sum, cnt, mine, sp = 0u;
    for (;;) {
        sum = 0u; cnt = 0u; mine = 0u;
#pragma unroll
        for (unsigned j = 0; j < 16; ++j) { const unsigned c = xb_ld(&bar[XB_XCNT(j)]); sum += c; cnt += (c > 0u) ? 1u : 0u; mine = (j == x) ? c : mine; }
        if (sum == G) break;
        __builtin_amdgcn_s_sleep(1);
        if ((++sp & 255u) == 0u) { if (xb_ld(&bar[XB_TMO])) break; if (sp > XB_SPIN_CAP) { atomicAdd(&bar[XB_TMO], 1u); break; } }
    }
    nloc = mine > 0u ? mine : 1u; nx = cnt > 0u ? cnt : 1u;
}
__device__ __forceinline__ void xcd_barrier(const XcdBarrier& b) {
    asm volatile("s_waitcnt vmcnt(0)" ::: "memory");
    __syncthreads();
    if (threadIdx.x == 0) {
        unsigned* bar = b.bar;
        __builtin_amdgcn_s_waitcnt(0);
        unsigned nloc = b.st[0], nx = b.st[1];
        if (nloc == 0u) { xcd_barrier_complete(bar, b.x, nloc, nx); b.st[0] = nloc; b.st[1] = nx; }
        const unsigned old = xb_add(&bar[XB_XSUB(b.x)], 1u);
        const unsigned gen = old / nloc;
        if (old + 1u == (gen + 1u) * nloc) {
            __builtin_amdgcn_fence(__ATOMIC_RELEASE, "agent");
            asm volatile("s_waitcnt vmcnt(0)" ::: "memory");
            const unsigned og = xb_add(&bar[XB_TOP], 1u);
            const unsigned tg = og / nx;
            if (og + 1u == (tg + 1u) * nx) xb_add(&bar[XB_TOPGEN], 1u);
            else XB_SPIN(xb_ld(&bar[XB_TOPGEN]) == tg, bar);
            __builtin_amdgcn_fence(__ATOMIC_ACQUIRE, "agent");
            xb_add(&bar[XB_XGEN(b.x)], 1u);
            asm volatile("s_waitcnt vmcnt(0)" ::: "memory");
        } else {
            XB_SPIN(xb_ld(&bar[XB_XGEN(b.x)]) == gen, bar);
            __builtin_amdgcn_fence(__ATOMIC_ACQUIRE, "agent");
            asm volatile("s_waitcnt vmcnt(0)" ::: "memory");
        }
    }
    __syncthreads();
}

struct Frame { LAS unsigned char* lds; int G, bid; };
#define OPAQUE_TID() int tid_ = threadIdx.x; asm volatile("" : "+v"(tid_)); const int tid = tid_, lane = tid & 63, wave = __builtin_amdgcn_readfirstlane(tid >> 6); (void)lane; (void)wave
__device__ __forceinline__ float wave_sum(float v) {
#pragma unroll
    for (int o = 1; o < 64; o <<= 1) v += __shfl_xor(v, o);
    return v;
}
#define LDS_WAIT() asm volatile("s_waitcnt lgkmcnt(0)" ::: "memory")

__device__ __forceinline__ void transpose_item(const float* W, int K, int N, bf16_t* WT, int ldt, const float* kscale, const float* nscale, bool glu, LAS float* scr, int item, int lane) {
    const int nblk = N / 32, kb = item / nblk, nb = item % nblk, k0 = 64 * kb, n0 = 32 * nb;
    const int n4 = (lane & 7) * 4, kr = lane >> 3;
    const f32x4 ns = nscale ? *(const f32x4*)(nscale + n0 + n4) : (f32x4){1.f, 1.f, 1.f, 1.f};
    f32x4 v[8];
#pragma unroll
    for (int i = 0; i < 8; ++i) v[i] = *(const f32x4*)(W + (size_t)(k0 + kr + 8 * i) * N + n0 + n4);
#pragma unroll
    for (int i = 0; i < 8; ++i) { const int kk = kr + 8 * i; const float ks = kscale ? kscale[k0 + kk] : 1.0f; const f32x4 t = v[i] * ns * ks;
        LAS float* d = scr + kk * 33 + n4; d[0] = t[0]; d[1] = t[1]; d[2] = t[2]; d[3] = t[3]; }
    LDS_WAIT(); asm volatile("" ::: "memory");
    int r0 = n0; if (glu) { const int c = n0 & 1023, gate = n0 >> 10; r0 = (c >> 7) * 256 + gate * 128 + (c & 127); }
    const int c = lane & 7;
#pragma unroll
    for (int j = 0; j < 4; ++j) { const int n = (lane >> 3) + 8 * j; const LAS float* s = scr + (8 * c) * 33 + n;
        u32x4 o; o.x = cvt_pk_bf16(s[0 * 33], s[1 * 33]); o.y = cvt_pk_bf16(s[2 * 33], s[3 * 33]); o.z = cvt_pk_bf16(s[4 * 33], s[5 * 33]); o.w = cvt_pk_bf16(s[6 * 33], s[7 * 33]);
        *(u32x4*)(WT + (size_t)(r0 + n) * ldt + k0 + 8 * c) = o; }
    LDS_WAIT(); asm volatile("" ::: "memory");
}

struct Args { const float* in[34]; float* out; unsigned char* ws; };

__device__ __forceinline__ void prep_phase(const Frame& F, const Args& a) {
    OPAQUE_TID();
    unsigned char* ws = a.ws;
    LAS float* scr = (LAS float*)(F.lds + wave * 16384);
    const int gw = F.bid * 8 + wave, NGW = F.G * 8;
    constexpr int I_SQ = (D / 64) * (D / 32), I_UP = (D / 64) * (FF / 32), I_DN = (FF / 64) * (D / 32), I_GRP = 4 * (256 / 64) * (256 / 32), I_CIN = (D / 64) * (2 * D / 32);
    constexpr int I_MLP = I_UP + I_DN;
    constexpr int I_POOL = I_SQ + I_GRP + I_MLP, I_CONV = I_CIN + I_SQ + I_MLP, I_FOUR = 2 * I_SQ + I_MLP;
    constexpr int NITEMS = 2 * I_POOL + I_CONV + I_FOUR;
#define JOB(W, K_, N_, DST, LDT, KS, NS, GLU) if (r < ((K_) / 64) * ((N_) / 32)) { transpose_item((W), (K_), (N_), (bf16_t*)(DST), (LDT), (KS), (NS), (GLU), scr, r, lane); continue; } r -= ((K_) / 64) * ((N_) / 32);
#define JOB_MLP(L, i0) JOB(a.in[(i0) + 1], D, FF, ws + WS_WUP + (L) * 16 * MiB, D, a.in[(i0)], nullptr, false) \
                       JOB(a.in[(i0) + 2], FF, D, ws + WS_WDN + (L) * 16 * MiB, FF, nullptr, nullptr, false)
#define JOB_POOL(L, i0) if (r < I_GRP) { const int g = r / (I_GRP / 4); transpose_item(a.in[(i0) + 2] + g * 65536, 256, 256, (bf16_t*)(ws + WS_MIXB + (L) * 3 * MiB) + g * 65536, 256, nullptr, a.in[(i0) + 3] + g * 256, false, scr, r % (I_GRP / 4), lane); continue; } r -= I_GRP; \
                        JOB(a.in[(i0) + 4], D, D, ws + WS_MIXB + (L) * 3 * MiB + MiB, D, nullptr, nullptr, false) \
                        JOB_MLP(L, (i0) + 5)
    for (int it = gw; it < NITEMS; it += NGW) {
        int r = it;
        JOB_POOL(0, 1)
        JOB(a.in[10], D, 2 * D, ws + WS_MIX + 1 * 5 * MiB, D, a.in[9], nullptr, true)
        JOB(a.in[15], D, D, ws + WS_MIXB + 1 * 3 * MiB + MiB, D, nullptr, nullptr, false)
        JOB_MLP(1, 16)
        JOB(a.in[20], D, D, ws + WS_MIX + 2 * 5 * MiB, D, a.in[19], nullptr, false)
        JOB(a.in[21], D, D, ws + WS_MIXB + 2 * 3 * MiB + MiB, D, nullptr, nullptr, false)
        JOB_MLP(2, 22)
        JOB_POOL(3, 25)
    }
#undef JOB
#undef JOB_MLP
#undef JOB_POOL
    {
        const float* x = a.in[0]; bf16_t* XB = (bf16_t*)(ws + WS_XB); float* rowsq = (float*)(ws + WS_ROWSQ);
        for (int m = gw; m < M; m += 2 * NGW) {
            const int m2 = (m + NGW < M) ? m + NGW : m;
            const f32x4* xr = (const f32x4*)(x + (size_t)m * D) + lane; const f32x4* xr2 = (const f32x4*)(x + (size_t)m2 * D) + lane; f32x4 v[4], v2[4]; float s = 0.f, s2 = 0.f;
#pragma unroll
            for (int j = 0; j < 4; ++j) { v[j] = xr[64 * j]; v2[j] = xr2[64 * j]; }
#pragma unroll
            for (int j = 0; j < 4; ++j) { s += (v[j][0] * v[j][0] + v[j][1] * v[j][1]) + (v[j][2] * v[j][2] + v[j][3] * v[j][3]); s2 += (v2[j][0] * v2[j][0] + v2[j][1] * v2[j][1]) + (v2[j][2] * v2[j][2] + v2[j][3] * v2[j][3]); }
            s = wave_sum(s); s2 = wave_sum(s2);
            u32x2* o8 = (u32x2*)(XB + (size_t)m * D) + lane; u32x2* o82 = (u32x2*)(XB + (size_t)m2 * D) + lane;
#pragma unroll
            for (int j = 0; j < 4; ++j) { u32x2 w; w.x = cvt_pk_bf16(v[j][0], v[j][1]); w.y = cvt_pk_bf16(v[j][2], v[j][3]); o8[64 * j] = w;
                                          u32x2 w2; w2.x = cvt_pk_bf16(v2[j][0], v2[j][1]); w2.y = cvt_pk_bf16(v2[j][2], v2[j][3]); o82[64 * j] = w2; }
            if (lane < 4) { rowsq[(size_t)m * 4 + lane] = (lane == 0) ? s : 0.f; rowsq[(size_t)m2 * 4 + lane] = (lane == 0) ? s2 : 0.f; }
        }
    }
    {
        const int gt = F.bid * 512 + tid, GT = F.G * 512;
        for (int it = gt; it < 2 * D * D / 8; it += GT) {
            const int l3 = it >> 17, e0 = (it & 131071) * 8, k = e0 >> 10;
            const float* W = l3 ? a.in[26] : a.in[2]; const float gk = (l3 ? a.in[25] : a.in[1])[k];
            const f32x4 v0 = *(const f32x4*)(W + e0), v1 = *(const f32x4*)(W + e0 + 4);
            u32x4 w; w.x = cvt_pk_bf16(v0[0] * gk, v0[1] * gk); w.y = cvt_pk_bf16(v0[2] * gk, v0[3] * gk); w.z = cvt_pk_bf16(v1[0] * gk, v1[1] * gk); w.w = cvt_pk_bf16(v1[2] * gk, v1[3] * gk);
            *(u32x4*)((bf16_t*)(ws + WS_MIX + (l3 ? 15 : 0) * MiB + 2 * MiB) + e0) = w;
        }
        bf16_t* Dcs = (bf16_t*)(ws + WS_DCS); bf16_t* T = (bf16_t*)(ws + WS_T);
        for (int it = gt; it < 2 * 256 * 256 / 8; it += GT) {
            const int e0 = it * 8, cs = e0 >> 16, j = (e0 >> 8) & 255, c0 = e0 & 255; float v[8];
#pragma unroll
            for (int k = 0; k < 8; ++k) { const float xx = (float)((j * (c0 + k)) & 255) * (1.0f / 128.0f); v[k] = (cs ? sinpif(xx) : cospif(xx)) * 0.0625f; }
            u32x4 w; w.x = cvt_pk_bf16(v[0], v[1]); w.y = cvt_pk_bf16(v[2], v[3]); w.z = cvt_pk_bf16(v[4], v[5]); w.w = cvt_pk_bf16(v[6], v[7]);
            *(u32x4*)(Dcs + e0) = w;
        }
        for (int it = gt; it < 2048 * KF / 8; it += GT) {
            const int e0 = it * 8, p = e0 / KF, q = e0 % KF; float v[8];
#pragma unroll
            for (int k = 0; k < 8; ++k) { const int kk = q + k, cs = kk >= KFE, sidx = cs ? kk - KFE : kk; const float xx = (float)((p * sidx) & 2047) * (1.0f / 1024.0f);
                v[k] = (cs ? -sinpif(xx) : (kk <= 1024 ? cospif(xx) : 0.0f)) * 0.03125f; }
            u32x4 w; w.x = cvt_pk_bf16(v[0], v[1]); w.y = cvt_pk_bf16(v[2], v[3]); w.z = cvt_pk_bf16(v[4], v[5]); w.w = cvt_pk_bf16(v[6], v[7]);
            *(u32x4*)(T + e0) = w;
        }
    }
}

__device__ __forceinline__ void fourier_fold_phase(const Frame& F, const bf16_t* __restrict__ U, bf16_t* __restrict__ FFo) {
    OPAQUE_TID();
    const int gt = F.bid * 512 + tid, GT = F.G * 512;
#pragma unroll 4
    for (int it = gt; it < NB * KF * 128; it += GT) {
        const int ch = it & 127, r = (it >> 7) % KF, b = (it >> 7) / KF;
        const bool sinp = r >= KFE; const int s = sinp ? r - KFE : r;
        const bf16_t* ub = U + (size_t)b * S * D + ch * 8;
        u32x4 o = (u32x4){0u, 0u, 0u, 0u};
        if (s <= 1024 && !(sinp && s == 0) && !(sinp && s == 1024)) {
            const u32x4 a = *(const u32x4*)(ub + (size_t)s * D);
            if (s == 0 || s == 1024) o = a;
            else { const u32x4 c = *(const u32x4*)(ub + (size_t)(S - s) * D); const float sg = sinp ? -1.0f : 1.0f;
#pragma unroll
                for (int k = 0; k < 4; ++k) o[k] = cvt_pk_bf16(bflo(a[k]) + sg * bflo(c[k]), bfhi(a[k]) + sg * bfhi(c[k])); }
        }
        *(u32x4*)(FFo + ((size_t)b * KF + r) * D + ch * 8) = o;
    }
}

template <int HW>
__device__ __forceinline__ void pool_item(const bf16_t* U, bf16_t* P, int b, int seg, int g, int lane) {
    const int s0 = seg * 16;
    const bf16_t* base = U + (size_t)b * S * D + g * 256 + lane * 4;
    u32x2 r[16 + 2 * HW];
#pragma unroll
    for (int i = 0; i < 16 + 2 * HW; ++i) { const int t = s0 - HW + i; r[i] = (u32x2){0u, 0u}; if (t >= 0 && t < S) r[i] = *(const u32x2*)(base + (size_t)t * D); }
    float sum[4] = {0.f, 0.f, 0.f, 0.f};
#pragma unroll
    for (int i = 0; i < 2 * HW; ++i) { sum[0] += bflo(r[i][0]); sum[1] += bfhi(r[i][0]); sum[2] += bflo(r[i][1]); sum[3] += bfhi(r[i][1]); }
    bf16_t* ob = P + (size_t)(b * S + s0) * D + g * 256 + lane * 4;
#pragma unroll
    for (int o = 0; o < 16; ++o) {
        const int s = s0 + o, lo = (s - HW) > 0 ? (s - HW) : 0, hi = (s + HW) < S ? (s + HW) : S;
        const float inv = 1.0f / (float)(hi - lo);
        const u32x2 c = r[o + HW];
        u32x2 w; w.x = cvt_pk_bf16(sum[0] * inv - bflo(c[0]), sum[1] * inv - bfhi(c[0])); w.y = cvt_pk_bf16(sum[2] * inv - bflo(c[1]), sum[3] * inv - bfhi(c[1]));
        *(u32x2*)(ob + (size_t)o * D) = w;
        if (o < 15) { const u32x2 a = r[o + 2 * HW], d = r[o];
            sum[0] += bflo(a[0]) - bflo(d[0]); sum[1] += bfhi(a[0]) - bfhi(d[0]); sum[2] += bflo(a[1]) - bflo(d[1]); sum[3] += bfhi(a[1]) - bfhi(d[1]); }
    }
}
__device__ __forceinline__ void pool_phase(const Frame& F, const bf16_t* U, bf16_t* P) {
    OPAQUE_TID();
    const int gw = F.bid * 8 + wave, NGW = F.G * 8;
    for (int it = gw; it < NB * (S / 16) * 4; it += NGW) {
        const int g = it & 3, seg = (it >> 2) & (S / 16 - 1), b = it >> 9;
        if (g == 0) pool_item<1>(U, P, b, seg, 0, lane);
        else if (g == 1) pool_item<2>(U, P, b, seg, 1, lane);
        else if (g == 2) pool_item<4>(U, P, b, seg, 2, lane);
        else pool_item<8>(U, P, b, seg, 3, lane);
    }
}

__device__ __forceinline__ void conv_dma_rows(LAS unsigned char* tl, const bf16_t* V, int p0, int sbase, int ra, int nrows, int wave, int lane) {
    for (int c = wave; c < 2 * nrows; c += 8) {
        const int r = ra + (c >> 1), t = sbase - 15 + r;
        LAS unsigned char* dst = tl + (r & 63) * (D * 2) + (c & 1) * 1024;
        if (t >= 0 && t < S) __builtin_amdgcn_global_load_lds((const unsigned*)((const char*)V + ((long)(p0 - 15 + r)) * (D * 2) + (c & 1) * 1024 + lane * 16), (LAS unsigned*)dst, 16, 0, 0);
        else *(LAS u32x4*)(dst + lane * 16) = (u32x4){0u, 0u, 0u, 0u};
    }
}
__device__ __forceinline__ void conv_phase(const Frame& F, const bf16_t* V, bf16_t* Aout, const float* dw, const float* dwb, const float* lng, const float* lnb) {
    OPAQUE_TID();
    f32x2 wv[31];
    { const float* p = dw + 2 * tid;
#pragma unroll
      for (int j = 0; j < 31; ++j) { wv[j] = *(const f32x2*)p; p += D; if ((j & 3) == 3) asm volatile("" ::: "memory"); } }
    const f32x2 bb = *(const f32x2*)(dwb + 2 * tid), gg = *(const f32x2*)(lng + 2 * tid), lb = *(const f32x2*)(lnb + 2 * tid);
    LAS unsigned char* tl = F.lds;
    LAS float* part = (LAS float*)(F.lds + 131072 + 1024);
    LAS float* stat = (LAS float*)(F.lds + 131072 + 2048);
    for (int strip = F.bid; strip < M / 128; strip += F.G) {
        const int p0 = strip * 128, sbase = p0 & (S - 1);
        conv_dma_rows(tl, V, p0, sbase, 0, 46, wave, lane);
#pragma unroll 1
        for (int k = 0; k < 8; ++k) {
            asm volatile("s_waitcnt vmcnt(0) lgkmcnt(0)" ::: "memory");
            __syncthreads();
            if (k < 7) conv_dma_rows(tl, V, p0, sbase, 46 + 16 * k, 16, wave, lane);
#pragma unroll 1
            for (int h = 0; h < 2; ++h) {
                const int rb = 16 * k + 8 * h;
                const LAS unsigned char* tlt = tl + tid * 4;
                f32x2 av[8];
#pragma unroll
                for (int o = 0; o < 8; ++o) av[o] = bb;
#pragma unroll
                for (int tt = 0; tt < 38; ++tt) {
                    const unsigned w = *(const LAS unsigned*)(tlt + ((rb + tt) & 63) * (D * 2));
                    const f32x2 xv = (f32x2){bflo(w), bfhi(w)};
#pragma unroll
                    for (int o = 0; o < 8; ++o) { const int j = tt - o; if (j >= 0 && j <= 30) av[o] = __builtin_elementwise_fma(xv, wv[j], av[o]); }
                    if ((tt & 7) == 7) asm volatile("" ::: "memory");
                }
                float vals[16];
#pragma unroll
                for (int o = 0; o < 8; ++o) { vals[o] = av[o][0] + av[o][1]; vals[8 + o] = av[o][0] * av[o][0] + av[o][1] * av[o][1]; }
#pragma unroll
                for (int step = 0; step < 4; ++step) {
                    const int half = 8 >> step; const bool up = (lane >> step) & 1;
#pragma unroll
                    for (int i = 0; i < half; ++i) { const float keep = up ? vals[i + half] : vals[i], send = up ? vals[i] : vals[i + half]; vals[i] = keep + __shfl_xor(send, 1 << step); }
                }
                vals[0] += __shfl_xor(vals[0], 16); vals[0] += __shfl_xor(vals[0], 32);
                if (lane < 16) { const int l = lane; const int idx = ((l & 1) << 3) | ((l & 2) << 1) | ((l & 4) >> 1) | ((l & 8) >> 3); part[wave * 16 + idx] = vals[0]; }
                __syncthreads();
                if (tid < 8) { float s1 = 0.f, s2 = 0.f;
#pragma unroll
                    for (int w = 0; w < 8; ++w) { s1 += part[w * 16 + tid]; s2 += part[w * 16 + 8 + tid]; }
                    const float mean = s1 * (1.0f / D), var = s2 * (1.0f / D) - mean * mean;
                    stat[2 * tid] = mean; stat[2 * tid + 1] = __builtin_amdgcn_rsqf(fmaxf(var, 0.f) + LN_EPS); }
                __syncthreads();
                unsigned* op = (unsigned*)(Aout + (size_t)(p0 + rb) * D) + tid;
#pragma unroll
                for (int o = 0; o < 8; ++o) {
                    const float mean = stat[2 * o], rstd = stat[2 * o + 1];
                    const float y0 = (av[o][0] - mean) * rstd * gg[0] + lb[0], y1 = (av[o][1] - mean) * rstd * gg[1] + lb[1];
                    const float z0 = y0 * __builtin_amdgcn_rcpf(1.0f + __builtin_amdgcn_exp2f(-1.44269504089f * y0)), z1 = y1 * __builtin_amdgcn_rcpf(1.0f + __builtin_amdgcn_exp2f(-1.44269504089f * y1));
                    *op = cvt_pk_bf16(z0, z1); op += D / 2;
                    if ((o & 3) == 3) asm volatile("" ::: "memory");
                }
            }
        }
        __syncthreads();
    }
}

__device__ __forceinline__ void final_phase(const Frame& F, float* out, const bf16_t* xb, const float* rowsq, const float* g) {
    OPAQUE_TID();
    const int gw = F.bid * 8 + wave, NGW = F.G * 8;
    f32x4 gv[4];
#pragma unroll
    for (int j = 0; j < 4; ++j) gv[j] = ((const f32x4*)g)[lane + 64 * j];
    for (int m = gw; m < M; m += 2 * NGW) {
        const int m2 = m + NGW;
        const float q0 = lane < 4 ? rowsq[(size_t)m * 4 + lane] : 0.f, q1 = (m2 < M && lane < 4) ? rowsq[(size_t)m2 * 4 + lane] : 0.f;
        u32x2 a[4], b[4];
#pragma unroll
        for (int j = 0; j < 4; ++j) { a[j] = ((const u32x2*)(xb + (size_t)m * D))[lane + 64 * j]; b[j] = (m2 < M) ? ((const u32x2*)(xb + (size_t)m2 * D))[lane + 64 * j] : (u32x2){0u, 0u}; }
        const float r0 = __builtin_amdgcn_rsqf(wave_sum(q0) * (1.0f / D) + NORM_EPS), r1 = __builtin_amdgcn_rsqf(wave_sum(q1) * (1.0f / D) + NORM_EPS);
        f32x4* o0 = (f32x4*)(out + (size_t)m * D) + lane; f32x4* o1 = (f32x4*)(out + (size_t)m2 * D) + lane;
#pragma unroll
        for (int j = 0; j < 4; ++j) { const f32x4 v = (f32x4){bflo(a[j][0]), bfhi(a[j][0]), bflo(a[j][1]), bfhi(a[j][1])}; o0[64 * j] = v * r0 * gv[j]; }
        if (m2 < M) {
#pragma unroll
            for (int j = 0; j < 4; ++j) { const f32x4 v = (f32x4){bflo(b[j][0]), bfhi(b[j][0]), bflo(b[j][1]), bfhi(b[j][1])}; o1[64 * j] = v * r1 * gv[j]; } }
    }
}

__global__ void __launch_bounds__(512, 2) fwd_megakernel(Args args) {
    extern __shared__ __attribute__((aligned(16))) unsigned char lds_raw[];
    cg::grid_group grid = cg::this_grid();
    Frame F; F.lds = (LAS unsigned char*)lds_raw; F.G = gridDim.x; F.bid = blockIdx.x;
    unsigned char* ws = args.ws;
    float* X = args.out;
    bf16_t* XB = (bf16_t*)(ws + WS_XB); float* ROWSQ = (float*)(ws + WS_ROWSQ);
    bf16_t* ACT1 = (bf16_t*)(ws + WS_ACT1); bf16_t* ACT2 = (bf16_t*)(ws + WS_ACT2); bf16_t* YT = (bf16_t*)(ws + WS_YT); bf16_t* HB = (bf16_t*)(ws + WS_H);
    volatile LAS unsigned* bst = (volatile LAS unsigned*)(F.lds + 131072 + 512);
    if (threadIdx.x < 2) bst[threadIdx.x] = 0u;
    __syncthreads();
    const XcdBarrier xbar = xcd_barrier_post((unsigned*)ws, bst);
#define GSYNC() xcd_barrier(xbar)
#define RUN_GEMM(EPI, A_, B_, LDA, LDB, K_, MODE, MR, NC, APN, ...) RUN_GEMM_S(0u, EPI, A_, B_, LDA, LDB, K_, MODE, MR, NC, APN, __VA_ARGS__)
#define RUN_GEMM_S(STAG, EPI, A_, B_, LDA, LDB, K_, MODE, MR, NC, APN, ...) do { pg8::Gemm g_{(A_), (B_), (LDA), (LDB), (K_)}; pg8::Order S_; S_.init((MODE), (MR), (NC), F.G, F.bid, (LDA), (LDB), (APN)); \
        EPI E_{__VA_ARGS__}; pg8::gemm_phase<EPI>(F.lds, g_, S_, E_, STAG); } while (0)

    if (args.ws == nullptr) grid.sync();
    prep_phase(F, args);
    GSYNC();
    RUN_GEMM(pg8::EpiBf16<0>, (const bf16_t*)(ws + WS_MIXB), (const bf16_t*)(ws + WS_MIX + 2 * MiB), 256, D, 256, 3, 32 * 256, 256, 0, (bf16_t*)(ws + WS_MIX), D, nullptr, 1.0f);
    GSYNC();
#pragma unroll 1
    for (int l = 0; l < 4; ++l) {
        const bf16_t* Win = (const bf16_t*)(ws + WS_MIX + (size_t)l * 5 * MiB);
        const bf16_t* Wout = (const bf16_t*)(ws + WS_MIXB + (size_t)l * 3 * MiB + MiB);
        if (l == 0 || l == 3) {
            RUN_GEMM(pg8::EpiBf16<0>, XB, Win, D, D, D, 0, M, D, 0, ACT1, D, ROWSQ, 1.0f);
            GSYNC();
            pool_phase(F, ACT1, ACT2);
            GSYNC();
            RUN_GEMM(pg8::EpiRes, ACT2, Wout, D, D, D, 0, M, D, 0, (l == 0) ? 0 : 1, args.in[0], XB, X, ROWSQ);
            GSYNC();
        } else if (l == 1) {
            RUN_GEMM(pg8::EpiBf16<2>, XB, Win, D, D, D, 0, M, 2 * D, 0, ACT1, D, ROWSQ, 1.0f);
            GSYNC();
            conv_phase(F, ACT1, ACT2, args.in[11], args.in[12], args.in[13], args.in[14]);
            GSYNC();
            RUN_GEMM(pg8::EpiRes, ACT2, Wout, D, D, D, 0, M, D, 0, (l == 0) ? 0 : 1, args.in[0], XB, X, ROWSQ);
            GSYNC();
        } else {
            RUN_GEMM(pg8::EpiBf16<0>, XB, Win, D, D, D, 0, M, D, 0, ACT1, D, ROWSQ, 1.0f);
            GSYNC();
            fourier_fold_phase(F, ACT1, (bf16_t*)(ws + WS_FF));
            GSYNC();
            RUN_GEMM(pg8::EpiBf16<0>, (const bf16_t*)(ws + WS_DCS), (const bf16_t*)(ws + WS_FF), 256, D, 256, 1, 256 * 576, 256, 0, YT, KF, nullptr, 1.0f);
            GSYNC();
            RUN_GEMM(pg8::EpiBf16<0>, (const bf16_t*)(ws + WS_T), YT, KF, KF, KF, 2, 256 * 512, 256, 0, ACT2, D, nullptr, 0.70710678118f);
            GSYNC();
            RUN_GEMM(pg8::EpiRes, ACT2, Wout, D, D, D, 0, M, D, 0, (l == 0) ? 0 : 1, args.in[0], XB, X, ROWSQ);
            GSYNC();
        }
#pragma unroll 1
        for (int c_ = 0; c_ < 2; ++c_) {
            int c = c_; asm volatile("" : "+s"(c));
            const size_t r0 = (size_t)c * (M / 2);
            RUN_GEMM_S(0u, pg8::EpiBf16<1>, XB + r0 * D, (const bf16_t*)(ws + WS_WUP + (size_t)l * 16 * MiB), D, D, D, 0, M / 2, FF, 0, HB, FF, ROWSQ + r0 * 4, 1.0f);
            GSYNC();
            RUN_GEMM(pg8::EpiRes, HB, (const bf16_t*)(ws + WS_WDN + (size_t)l * 16 * MiB), FF, FF, FF, 0, M / 2, D, 0, 1, args.in[0], XB + r0 * D, X, ROWSQ + r0 * 4);
            GSYNC();
        }
    }
    final_phase(F, X, XB, ROWSQ, args.in[33]);
}

extern "C" void kernel_launch(void* const* d_in, const int* in_sizes, int n_in, void* d_out, int out_size, void* d_ws, size_t ws_size, hipStream_t stream) {
    static int grid = 0;
    if (grid == 0) {
        if (n_in != 34 || out_size != M * D || ws_size < WS_END) { fprintf(stderr, "kernel_launch: unexpected problem (n_in %d, out %d, ws %zu < %zu)\n", n_in, out_size, ws_size, (size_t)WS_END); grid = -1; return; }
        int dev = 0, cus = 0, per_cu = 0;
        if (hipGetDevice(&dev) != hipSuccess || hipDeviceGetAttribute(&cus, hipDeviceAttributeMultiprocessorCount, dev) != hipSuccess) { grid = -1; return; }
        if (hipFuncSetAttribute((const void*)fwd_megakernel, hipFuncAttributeMaxDynamicSharedMemorySize, LDS_BYTES) != hipSuccess) { fprintf(stderr, "hipFuncSetAttribute failed\n"); grid = -1; return; }
        if (hipOccupancyMaxActiveBlocksPerMultiprocessor(&per_cu, (const void*)fwd_megakernel, 512, LDS_BYTES) != hipSuccess || per_cu < 1) { fprintf(stderr, "occupancy query: %d\n", per_cu); }
        (void)hipGetLastError();
        grid = cus;
    }
    if (grid < 0) return;
    if (hipMemsetAsync(d_ws, 0, 16384, stream) != hipSuccess) { fprintf(stderr, "kernel_launch: memset failed\n"); return; }
    Args a{};
    for (int i = 0; i < 34; ++i) a.in[i] = (const float*)d_in[i];
    a.out = (float*)d_out; a.ws = (unsigned char*)d_ws;
    void* kargs[] = {&a};
    hipError_t e = hipLaunchCooperativeKernel((const void*)fwd_megakernel, dim3(grid), dim3(512), kargs, LDS_BYTES, stream);
    if (e != hipSuccess) fprintf(stderr, "cooperative launch failed: %s (grid %d)\n", hipGetErrorString(e), grid);
}
```

```cpp
#include <hip/hip_runtime.h>
#include <hip/hip_cooperative_groups.h>
#include <cstdio>
#include <cstdint>
namespace cg = cooperative_groups;

#define LAS __attribute__((address_space(3)))
typedef unsigned short bf16_t;
typedef short bf16x8 __attribute__((ext_vector_type(8)));
typedef float f32x4 __attribute__((ext_vector_type(4)));
typedef float f32x2 __attribute__((ext_vector_type(2)));
typedef unsigned u32x4 __attribute__((ext_vector_type(4)));
typedef unsigned u32x2 __attribute__((ext_vector_type(2)));

constexpr int NB = 16, S = 2048, D = 1024, M = NB * S, FF = 4096;
constexpr float NORM_EPS = 1e-6f, LN_EPS = 1e-5f;
constexpr size_t MiB = 1u << 20;
constexpr size_t WS_ROWSQ = 1 * MiB;
constexpr size_t WS_DCS = 3 * MiB;
constexpr size_t WS_T = 4 * MiB;
constexpr size_t WS_WUP = 20 * MiB;
constexpr size_t WS_WDN = 28 * MiB;
constexpr size_t WS_MIX = 84 * MiB;
constexpr size_t WS_MIXB = 104 * MiB;
constexpr size_t WS_XB = 116 * MiB;
constexpr size_t WS_H = 180 * MiB;
constexpr size_t WS_ACT1 = WS_H, WS_ACT2 = WS_H + 64 * MiB, WS_FF = WS_H + 64 * MiB, WS_YT = WS_H + 144 * MiB, WS_ACT3 = WS_H + 128 * MiB;
constexpr size_t WS_END = WS_H + 256 * MiB;
constexpr int LDS_BYTES = 147456;
constexpr int KFE = 1280, KF = KFE + 1024;

__device__ __forceinline__ unsigned cvt_pk_bf16(float lo, float hi) { unsigned r; asm volatile("v_cvt_pk_bf16_f32 %0, %1, %2" : "=v"(r) : "v"(lo), "v"(hi)); return r; }
__device__ __forceinline__ float bflo(unsigned w) { return __uint_as_float(w << 16); }
__device__ __forceinline__ float bfhi(unsigned w) { return __uint_as_float(w & 0xffff0000u); }

namespace pg8 {
constexpr int BM = 256, BK = 64, HALF = 128, HTB = HALF * BK * 2, STAGE_BYTES = 8 * HTB, NXCD = 8, WGM = 2;
__host__ __device__ __forceinline__ int lds_byte(int r, int c) { const int st = (r >> 4) * 2 + (c >> 5), rr = r & 15, cc = c & 31, ob = rr * 64 + cc * 2; return st * 1024 + (ob ^ (((ob >> 9) & 1) << 5)); }
__host__ __device__ __forceinline__ void stage_rc(int b, int& R, int& C) { const int st = b / 1024, sb = b % 1024, swz = sb ^ (((sb >> 9) & 1) << 5); R = (st >> 1) * 16 + swz / 64; C = (st & 1) * 32 + (swz % 64) / 2; }
__host__ __device__ __forceinline__ int perm32(int rho) { const int n = rho >> 4, i = rho & 15; return 8 * (i >> 2) + 4 * n + (i & 3); }

struct Unit { long aoff, boff; int row0, col0; };
struct Gemm { const bf16_t* A; const bf16_t* Bt; int lda, ldb, K; };

struct Order {
    int mode, nM, nN, nwg, G, c, lda, ldb; long a_pn_bytes;
    __device__ __forceinline__ void init(int mode_, int Mr, int Nc, int G_, int c_, int lda_, int ldb_, long apn) { mode = mode_; nM = Mr / BM; nN = Nc / BM; nwg = nM * nN; G = G_; c = c_; lda = lda_; ldb = ldb_; a_pn_bytes = apn; }
    __device__ __forceinline__ bool next(int i, Unit& u) const {
        const long L = (long)i * G + c; if (L >= nwg) return false;
        if (mode == 0) {
            int wgid = (int)L; { const int q = nwg / NXCD, r = nwg % NXCD, xcd = wgid % NXCD, off = wgid / NXCD; wgid = (xcd < r ? xcd * (q + 1) : r * (q + 1) + (xcd - r) * q) + off; }
            const int nig = WGM * nN, gid = wgid / nig, fm = gid * WGM, gsz = (nM - fm) < WGM ? (nM - fm) : WGM;
            const int pm = fm + ((wgid % nig) % gsz), pn = (wgid % nig) / gsz;
            u.aoff = (long)pm * BM * lda * 2 + (long)pn * a_pn_bytes; u.boff = (long)pn * BM * ldb * 2; u.row0 = pm * BM; u.col0 = pn * BM;
        } else if (mode == 1) {
            const int w = (int)L, t = w % 9, g = (w / 9) & 3, b = w / 36, cs = (t >= 5) ? 1 : 0;
            u.aoff = (long)cs * 256 * 256 * 2; u.boff = ((long)(b * KF + t * 256) * D + g * 256) * 2; u.row0 = b * 1024 + g * 256; u.col0 = t * 256;
        } else if (mode == 3) {
            const int w = (int)L, layer = w >> 4, pm = (w >> 2) & 3, pn = w & 3;
            u.aoff = (long)layer * 9 * 1048576 + (long)pm * 256 * 256 * 2; u.boff = (long)layer * 15 * 1048576 + (long)pn * 256 * 1024 * 2 + pm * 512; u.row0 = layer * 7680 + pm * 256; u.col0 = pn * 256;
        } else {
            int b, pm, pn;
            if (G == 256) { const int xcd = c & 7, loc = c >> 3; b = i * 8 + xcd; pm = loc & 7; pn = loc >> 3; }
            else { const int w = (int)L; b = w >> 5; pm = w & 7; pn = (w >> 3) & 3; }
            u.aoff = (long)pm * 256 * KF * 2; u.boff = ((long)b * 1024 + pn * 256) * KF * 2; u.row0 = b * S + pm * 256; u.col0 = pn * 256;
        }
        return true;
    }
};

__device__ __forceinline__ float row_rstd(const float* rowsq, int row) {
    const f32x4 s = *(const f32x4*)(rowsq + (size_t)row * 4);
    const float t = (s[0] + s[1]) + (s[2] + s[3]);
    return __builtin_amdgcn_rsqf(t * (1.0f / D) + NORM_EPS);
}
template <int ACT> struct EpiBf16 {
    static constexpr bool PERM = true, WIDE = (ACT != 2);
    bf16_t* O; int ldc; const float* rowsq; float post;
    template <class Sched> __device__ __forceinline__ void prefill(LAS unsigned char* lds, const Sched& S, int tid) const {
        if (!rowsq) return;
        LAS float* rsl = (LAS float*)(lds + 139264);
        Unit u;
        for (int i = 0; i < 8 && S.next(i, u); ++i) if (tid < 256) rsl[i * 256 + tid] = post * row_rstd(rowsq, u.row0 + tid);
        asm volatile("s_waitcnt vmcnt(0) lgkmcnt(0)" ::: "memory");
    }
    __device__ __forceinline__ void operator()(const f32x4 (&acc)[2][2][4][2], const Unit& u, int wr, int wc, int fr, int fq, LAS unsigned char* lds, int, int ui) const {
        const int row0 = u.row0 + wr * 64 + fr;
        const int col0 = (ACT == 2 ? (u.col0 >> 1) : u.col0) + wc * 32 + 8 * fq;
        const LAS float* rsl = (const LAS float*)(lds + 139264) + (ui & 7) * 256 + wr * 64 + fr;
        float rs[2][4];
#pragma unroll
        for (int ai = 0; ai < 2; ++ai)
#pragma unroll
            for (int m = 0; m < 4; ++m) rs[ai][m] = rowsq ? rsl[ai * HALF + m * 16] : post;
#pragma unroll
        for (int ai = 0; ai < 2; ++ai)
#pragma unroll
            for (int m = 0; m < 4; ++m) {
                const int row = row0 + ai * HALF + m * 16;
                const float sc = rs[ai][m];
                bf16_t* rowp = O + (size_t)row * ldc + col0;
                if (ACT == 2) {
                    f32x4 v0 = acc[ai][0][m][0] * sc, v1 = acc[ai][0][m][1] * sc, g0 = acc[ai][1][m][0] * sc, g1 = acc[ai][1][m][1] * sc;
#pragma unroll
                    for (int i = 0; i < 4; ++i) {
                        v0[i] = v0[i] * __builtin_amdgcn_rcpf(1.0f + __builtin_amdgcn_exp2f(-1.44269504089f * g0[i]));
                        v1[i] = v1[i] * __builtin_amdgcn_rcpf(1.0f + __builtin_amdgcn_exp2f(-1.44269504089f * g1[i])); }
                    u32x4 w; w.x = cvt_pk_bf16(v0[0], v0[1]); w.y = cvt_pk_bf16(v0[2], v0[3]); w.z = cvt_pk_bf16(v1[0], v1[1]); w.w = cvt_pk_bf16(v1[2], v1[3]);
                    *(u32x4*)rowp = w;
                } else {
                    u32x4 wp[2];
#pragma unroll
                    for (int bj = 0; bj < 2; ++bj) {
                        f32x4 v0 = acc[ai][bj][m][0] * sc, v1 = acc[ai][bj][m][1] * sc;
                        if (ACT == 1) {
#pragma unroll
                            for (int i = 0; i < 4; ++i) { const float a = fmaxf(v0[i], 0.f), b = fmaxf(v1[i], 0.f); v0[i] = a * a; v1[i] = b * b; } }
                        wp[bj].x = cvt_pk_bf16(v0[0], v0[1]); wp[bj].y = cvt_pk_bf16(v0[2], v0[3]); wp[bj].z = cvt_pk_bf16(v1[0], v1[1]); wp[bj].w = cvt_pk_bf16(v1[2], v1[3]); }
                    const bool lo = fr < 8;
                    u32x4 snd = lo ? wp[1] : wp[0], rcv;
#pragma unroll
                    for (int i = 0; i < 4; ++i) rcv[i] = (unsigned)__shfl_xor((int)snd[i], 8);
                    const u32x4 dA = lo ? wp[0] : rcv, dB = lo ? rcv : wp[1];
                    bf16_t* pa = O + (size_t)(row - fr + (fr & 7)) * ldc + (u.col0 + wc * 64 + 8 * fq + (lo ? 0 : 32));
                    *(u32x4*)pa = dA; *(u32x4*)(pa + (size_t)8 * ldc) = dB;
                }
                asm volatile("" ::: "memory");
            }
    }
};
struct EpiRes {
    static constexpr bool PERM = true, WIDE = false;
    template <class Sched> __device__ __forceinline__ void prefill(LAS unsigned char*, const Sched&, int) const {}
    int mode; const float* xin; bf16_t* xb; float* xout; float* rowsq;
    __device__ __forceinline__ void operator()(const f32x4 (&acc)[2][2][4][2], const Unit& u, int wr, int wc, int fr, int fq, LAS unsigned char* lds, int tid, int) const {
        const int colb = u.col0 + wc * 32 + 8 * fq, pn = u.col0 >> 8;
        LAS float* xch = (LAS float*)(lds + 135168);
        const size_t off0 = (size_t)(u.row0 + wr * 64 + fr) * D + colb;
#define EPIRES_BODY(it_, c0_, c1_) do { const int ai = (it_) >> 2, m = (it_) & 3; const size_t off = off0 + (size_t)(ai * HALF + m * 16) * D; float ss = 0.f; \
            _Pragma("unroll") for (int bj = 0; bj < 2; ++bj) { \
                const f32x4 o0 = (c0_)[bj] + acc[ai][bj][m][0], o1 = (c1_)[bj] + acc[ai][bj][m][1]; \
                ss += ((o0[0] * o0[0] + o0[1] * o0[1]) + (o0[2] * o0[2] + o0[3] * o0[3])) + ((o1[0] * o1[0] + o1[1] * o1[1]) + (o1[2] * o1[2] + o1[3] * o1[3])); \
                if (mode == 2) { *(f32x4*)(xout + off + bj * HALF) = o0; *(f32x4*)(xout + off + bj * HALF + 4) = o1; } \
                else { u32x4 w; w.x = cvt_pk_bf16(o0[0], o0[1]); w.y = cvt_pk_bf16(o0[2], o0[3]); w.z = cvt_pk_bf16(o1[0], o1[1]); w.w = cvt_pk_bf16(o1[2], o1[3]); *(u32x4*)(xb + off + bj * HALF) = w; } } \
            ss += __shfl_xor(ss, 16); ss += __shfl_xor(ss, 32); \
            if (fq == 0) xch[(ai * HALF + wr * 64 + m * 16 + fr) * 4 + wc] = ss; } while (0)
        if (mode != 0) {
            u32x4 xo[8][2];
#pragma unroll
            for (int it = 0; it < 8; ++it)
#pragma unroll
                for (int bj = 0; bj < 2; ++bj) xo[it][bj] = *(const u32x4*)(xb + off0 + (size_t)((it >> 2) * HALF + (it & 3) * 16) * D + bj * HALF);
            asm volatile("" ::: "memory");
#pragma unroll
            for (int it = 0; it < 8; ++it) {
                f32x4 c0[2], c1[2];
#pragma unroll
                for (int bj = 0; bj < 2; ++bj) { const u32x4 w_ = xo[it][bj]; c0[bj] = (f32x4){bflo(w_[0]), bfhi(w_[0]), bflo(w_[1]), bfhi(w_[1])}; c1[bj] = (f32x4){bflo(w_[2]), bfhi(w_[2]), bflo(w_[3]), bfhi(w_[3])}; }
                EPIRES_BODY(it, c0, c1);
            }
        } else {
#pragma unroll
            for (int h = 0; h < 2; ++h) {
                f32x4 xf0[4][2], xf1[4][2];
#pragma unroll
                for (int q = 0; q < 4; ++q)
#pragma unroll
                    for (int bj = 0; bj < 2; ++bj) { const float* p = xin + off0 + (size_t)(h * HALF + q * 16) * D + bj * HALF; xf0[q][bj] = *(const f32x4*)p; xf1[q][bj] = *(const f32x4*)(p + 4); }
                asm volatile("" ::: "memory");
#pragma unroll
                for (int q = 0; q < 4; ++q) EPIRES_BODY(h * 4 + q, xf0[q], xf1[q]);
                asm volatile("" ::: "memory");
            }
        }
#undef EPIRES_BODY
        asm volatile("s_waitcnt lgkmcnt(0)" ::: "memory"); __builtin_amdgcn_s_barrier(); asm volatile("" ::: "memory");
        if (tid < 256) { const f32x4 v = *(const LAS f32x4*)(xch + tid * 4); rowsq[(size_t)(u.row0 + tid) * 4 + pn] = (v[0] + v[1]) + (v[2] + v[3]); }
    }
};

template <class Epi>
__device__ __forceinline__ void gemm_phase(LAS unsigned char* lds, const Gemm g, const Order& S, const Epi& E, const unsigned stag = 0u) {
    int tid_ = threadIdx.x; asm volatile("" : "+v"(tid_));
    const int tid = tid_, wid = __builtin_amdgcn_readfirstlane(tid >> 6), lane = tid & 63, wr = wid >> 2, wc = wid & 3, fr = lane & 15, fq = lane >> 4;
    const int K = g.K, nt = K / BK;
    unsigned voffA[2], voffB[2];
#pragma unroll
    for (int i = 0; i < 2; ++i) { int R, C; stage_rc(tid * 16 + i * 8192, R, C); const int Rb = Epi::WIDE ? (64 * (R >> 5) + perm32(R & 31)) : (Epi::PERM ? ((R & ~31) + perm32(R & 31)) : R);
        voffA[i] = (unsigned)(R * g.lda + C) * 2u; voffB[i] = (unsigned)(Rb * g.ldb + C) * 2u; }
    const size_t kstep = (size_t)(BK * 2);
    const size_t hstepA = (size_t)HALF * g.lda * 2, hstepB = (size_t)(Epi::WIDE ? 32 : HALF) * g.ldb * 2;
    const unsigned ldsw = (unsigned)wid * 1024u;
    const int aoff = lds_byte(wr * 64 + fr, fq * 8), boff = lds_byte(wc * 32 + fr, fq * 8);
#define PG8_SA(b, h) (((b) * 2 + (h)) * HTB)
#define PG8_SB(b, h) ((4 + (b) * 2 + (h)) * HTB)
#define PG8_STAGE(bufoff, gbase, voff) do { _Pragma("unroll") for (int _i = 0; _i < 2; ++_i) \
        __builtin_amdgcn_global_load_lds((const unsigned*)((const char*)(gbase) + (voff)[_i]), (LAS unsigned*)(lds + (bufoff) + ldsw + _i * 8192), 16, 0, 0); } while (0)
#define PG8_LDA(dst, b, h) do { _Pragma("unroll") for (int m = 0; m < 4; ++m) _Pragma("unroll") for (int k = 0; k < 2; ++k) dst[m][k] = *(const LAS bf16x8*)(lds + PG8_SA(b, h) + aoff + m * 2048 + k * 1024); } while (0)
#define PG8_LDB(dst, b, h) do { _Pragma("unroll") for (int n = 0; n < 2; ++n) _Pragma("unroll") for (int k = 0; k < 2; ++k) dst[n][k] = *(const LAS bf16x8*)(lds + PG8_SB(b, h) + boff + n * 2048 + k * 1024); } while (0)
#define PG8_MMA(ai, bj, At, Bt) do { __builtin_amdgcn_s_setprio(1); _Pragma("unroll") for (int m = 0; m < 4; ++m) _Pragma("unroll") for (int n = 0; n < 2; ++n) _Pragma("unroll") for (int k = 0; k < 2; ++k) \
        acc[ai][bj][m][n] = __builtin_amdgcn_mfma_f32_16x16x32_bf16(Bt[n][k], At[m][k], acc[ai][bj][m][n], 0, 0, 0); __builtin_amdgcn_s_setprio(0); } while (0)
#define PG8_WAIT_V(n) asm volatile("s_waitcnt vmcnt(" #n ")" ::: "memory")
#define PG8_WAIT_L(n) asm volatile("s_waitcnt lgkmcnt(" #n ")" ::: "memory")
#define PG8_BAR __builtin_amdgcn_s_barrier()
#define PG8_SCHED __builtin_amdgcn_sched_barrier(0)
    Unit cur, nxt; int ui = 0;
    if (!S.next(0, cur)) return;
    if (stag) {
        const unsigned long long t0 = __builtin_amdgcn_s_memrealtime(), dl = (unsigned long long)(((unsigned)cur.col0 >> 8) & 3u) * stag;
        while (__builtin_amdgcn_s_memrealtime() - t0 < dl) __builtin_amdgcn_s_sleep(8);
    }
    f32x4 acc[2][2][4][2];
#pragma unroll
    for (int a = 0; a < 2; ++a)
#pragma unroll
        for (int b = 0; b < 2; ++b)
#pragma unroll
            for (int m = 0; m < 4; ++m)
#pragma unroll
                for (int n = 0; n < 2; ++n) acc[a][b][m][n] = (f32x4){0.f, 0.f, 0.f, 0.f};
    E.prefill(lds, S, tid);
    bf16x8 At[4][2], B0[2][2], B1[2][2];
    const char* cA = (const char*)g.A + cur.aoff; const char* cB = (const char*)g.Bt + cur.boff;
    PG8_STAGE(PG8_SB(0, 0), cB, voffB); PG8_STAGE(PG8_SB(0, 1), cB + hstepB, voffB); PG8_STAGE(PG8_SA(0, 0), cA, voffA); PG8_STAGE(PG8_SA(0, 1), cA + hstepA, voffA);
    if (wr == 1) PG8_BAR;
    PG8_WAIT_V(2); PG8_BAR;
    PG8_STAGE(PG8_SB(1, 0), cB + kstep, voffB); PG8_STAGE(PG8_SA(1, 0), cA + kstep, voffA); PG8_STAGE(PG8_SB(1, 1), cB + hstepB + kstep, voffB);
    PG8_WAIT_V(6); PG8_BAR;
    for (;;) {
        const bool has_next = S.next(ui + 1, nxt);
        const char* nA = has_next ? (const char*)g.A + nxt.aoff : cA; const char* nB = has_next ? (const char*)g.Bt + nxt.boff : cB;
        for (int t = 0; t < nt; t += 2) {
            const bool last = (t == nt - 2);
            const char* a1 = cA + (size_t)(t + 1) * kstep;
            const char* a2 = last ? nA : cA + (size_t)(t + 2) * kstep; const char* b2 = last ? nB : cB + (size_t)(t + 2) * kstep;
            const char* a3 = a2 + kstep; const char* b3 = b2 + kstep;
            PG8_LDB(B0, 0, 0); PG8_LDB(B1, 0, 1); PG8_SCHED; PG8_LDA(At, 0, 0); PG8_STAGE(PG8_SA(1, 1), a1 + hstepA, voffA);
            PG8_WAIT_V(8); PG8_WAIT_L(0); PG8_BAR; PG8_MMA(0, 0, At, B0); PG8_MMA(0, 1, At, B1); PG8_BAR; PG8_SCHED;
            PG8_LDA(At, 0, 1); PG8_STAGE(PG8_SB(0, 0), b2, voffB); PG8_STAGE(PG8_SB(0, 1), b2 + hstepB, voffB); PG8_STAGE(PG8_SA(0, 0), a2, voffA);
            PG8_WAIT_V(8); PG8_WAIT_L(0); PG8_BAR; PG8_MMA(1, 0, At, B0); PG8_MMA(1, 1, At, B1); PG8_BAR; PG8_SCHED;
            PG8_LDB(B0, 1, 0); PG8_LDB(B1, 1, 1); PG8_SCHED; PG8_LDA(At, 1, 0); PG8_STAGE(PG8_SA(0, 1), a2 + hstepA, voffA);
            PG8_WAIT_V(8); PG8_WAIT_L(0); PG8_BAR; PG8_MMA(0, 0, At, B0); PG8_MMA(0, 1, At, B1); PG8_BAR; PG8_SCHED;
            PG8_LDA(At, 1, 1); PG8_STAGE(PG8_SB(1, 0), b3, voffB); PG8_STAGE(PG8_SB(1, 1), b3 + hstepB, voffB); PG8_STAGE(PG8_SA(1, 0), a3, voffA);
            PG8_WAIT_V(8); PG8_WAIT_L(0); PG8_BAR; PG8_MMA(1, 0, At, B0); PG8_MMA(1, 1, At, B1); PG8_BAR; PG8_SCHED;
        }
        if (wr == 0) PG8_BAR;
        E(acc, cur, wr, wc, fr, fq, lds, tid, ui);
        if (!has_next) break;
#pragma unroll
        for (int a = 0; a < 2; ++a)
#pragma unroll
            for (int b = 0; b < 2; ++b)
#pragma unroll
                for (int m = 0; m < 4; ++m)
#pragma unroll
                    for (int n = 0; n < 2; ++n) acc[a][b][m][n] = (f32x4){0.f, 0.f, 0.f, 0.f};
        cur = nxt; cA = nA; cB = nB; ++ui;
        if (wr == 1) PG8_BAR;
    }
    PG8_WAIT_V(0);
    PG8_BAR;
#undef PG8_SA
#undef PG8_SB
#undef PG8_STAGE
#undef PG8_LDA
#undef PG8_LDB
#undef PG8_MMA
#undef PG8_WAIT_V
#undef PG8_WAIT_L
#undef PG8_BAR
#undef PG8_SCHED
}
}


#define XB_TMO      128
#define XB_XCNT(j)  (256  + 64 * (j))
#define XB_XSUB(j)  (1280 + 64 * (j))
#define XB_XGEN(j)  (2304 + 64 * (j))
#define XB_TOP      3328
#define XB_TOPGEN   3392
#define XCD_BAR_WORDS 3456
#define XB_SPIN_CAP (1u << 22)
__device__ __forceinline__ unsigned xb_ld(unsigned* p)              { return __hip_atomic_load(p, __ATOMIC_RELAXED, __HIP_MEMORY_SCOPE_AGENT); }
__device__ __forceinline__ unsigned xb_add(unsigned* p, unsigned v) { return __hip_atomic_fetch_add(p, v, __ATOMIC_RELAXED, __HIP_MEMORY_SCOPE_AGENT); }
__device__ __forceinline__ unsigned xb_xcc_id() { return (unsigned)__builtin_amdgcn_s_getreg((3 << 11) | 20) & 0xFu; }
#define XB_SPIN(cond, bar) do { unsigned _sp = 0; while (cond) { __builtin_amdgcn_s_sleep(1); \
    if ((++_sp & 255u) == 0u) { if (xb_ld(&(bar)[XB_TMO])) break; if (_sp > XB_SPIN_CAP) { atomicAdd(&(bar)[XB_TMO], 1u); break; } } } } while (0)
struct XcdBarrier { unsigned* bar; unsigned x; volatile LAS unsigned* st; };
__device__ __forceinline__ XcdBarrier xcd_barrier_post(unsigned* bar, volatile LAS unsigned* st) {
    XcdBarrier b; b.bar = bar; b.x = xb_xcc_id(); b.st = st;
    if (threadIdx.x == 0) (void)xb_add(&bar[XB_XCNT(b.x)], 1u);
    return b;
}
__device__ __forceinline__ void xcd_barrier_complete(unsigned* bar, unsigned x, unsigned& nloc, unsigned& nx) {
    const unsigned G = gridDim.x * gridDim.y * gridDim.z;
    unsigned sum, cnt, mine, sp = 0u;
    for (;;) {
        sum = 0u; cnt = 0u; mine = 0u;
#pragma unroll
        for (unsigned j = 0; j < 16; ++j) { const unsigned c = xb_ld(&bar[XB_XCNT(j)]); sum += c; cnt += (c > 0u) ? 1u : 0u; mine = (j == x) ? c : mine; }
        if (sum == G) break;
        __builtin_amdgcn_s_sleep(1);
        if ((++sp & 255u) == 0u) { if (xb_ld(&bar[XB_TMO])) break; if (sp > XB_SPIN_CAP) { atomicAdd(&bar[XB_TMO], 1u); break; } }
    }
    nloc = mine > 0u ? mine : 1u; nx = cnt > 0u ? cnt : 1u;
}
__device__ __forceinline__ void xcd_barrier(const XcdBarrier& b) {
    asm volatile("s_waitcnt vmcnt(0)" ::: "memory");
    __syncthreads();
    if (threadIdx.x == 0) {
        unsigned* bar = b.bar;
        __builtin_amdgcn_s_waitcnt(0);
        unsigned nloc = b.st[0], nx = b.st[1];
        if (nloc == 0u) { xcd_barrier_complete(bar, b.x, nloc, nx); b.st[0] = nloc; b.st[1] = nx; }
        const unsigned old = xb_add(&bar[XB_XSUB(b.x)], 1u);
        const unsigned gen = old / nloc;
        if (old + 1u == (gen + 1u) * nloc) {
            __builtin_amdgcn_fence(__ATOMIC_RELEASE, "agent");
            asm volatile("s_waitcnt vmcnt(0)" ::: "memory");
            const unsigned og = xb_add(&bar[XB_TOP], 1u);
            const unsigned tg = og / nx;
            if (og + 1u == (tg + 1u) * nx) xb_add(&bar[XB_TOPGEN], 1u);
            else XB_SPIN(xb_ld(&bar[XB_TOPGEN]) == tg, bar);
            __builtin_amdgcn_fence(__ATOMIC_ACQUIRE, "agent");
            xb_add(&bar[XB_XGEN(b.x)], 1u);
            asm volatile("s_waitcnt vmcnt(0)" ::: "memory");
        } else {
            XB_SPIN(xb_ld(&bar[XB_XGEN(b.x)]) == gen, bar);
            __builtin_amdgcn_fence(__ATOMIC_ACQUIRE, "agent");
            asm volatile("s_waitcnt vmcnt(0)" ::: "memory");
        }
    }
    __syncthreads();
}

struct Frame { LAS unsigned char* lds; int G, bid; };
#define OPAQUE_TID() int tid_ = threadIdx.x; asm volatile("" : "+v"(tid_)); const int tid = tid_, lane = tid & 63, wave = __builtin_amdgcn_readfirstlane(tid >> 6); (void)lane; (void)wave
__device__ __forceinline__ float wave_sum(float v) {
#pragma unroll
    for (int o = 1; o < 64; o <<= 1) v += __shfl_xor(v, o);
    return v;
}
#define LDS_WAIT() asm volatile("s_waitcnt lgkmcnt(0)" ::: "memory")

__device__ __forceinline__ void transpose_item(const float* W, int K, int N, bf16_t* WT, int ldt, const float* kscale, const float* nscale, bool glu, LAS float* scr, int item, int lane) {
    const int nblk = N / 32, kb = item / nblk, nb = item % nblk, k0 = 64 * kb, n0 = 32 * nb;
    const int n4 = (lane & 7) * 4, kr = lane >> 3;
    const f32x4 ns = nscale ? *(const f32x4*)(nscale + n0 + n4) : (f32x4){1.f, 1.f, 1.f, 1.f};
    f32x4 v[8];
#pragma unroll
    for (int i = 0; i < 8; ++i) v[i] = *(const f32x4*)(W + (size_t)(k0 + kr + 8 * i) * N + n0 + n4);
#pragma unroll
    for (int i = 0; i < 8; ++i) { const int kk = kr + 8 * i; const float ks = kscale ? kscale[k0 + kk] : 1.0f; const f32x4 t = v[i] * ns * ks;
        LAS float* d = scr + kk * 33 + n4; d[0] = t[0]; d[1] = t[1]; d[2] = t[2]; d[3] = t[3]; }
    LDS_WAIT(); asm volatile("" ::: "memory");
    int r0 = n0; if (glu) { const int c = n0 & 1023, gate = n0 >> 10; r0 = (c >> 7) * 256 + gate * 128 + (c & 127); }
    const int c = lane & 7;
#pragma unroll
    for (int j = 0; j < 4; ++j) { const int n = (lane >> 3) + 8 * j; const LAS float* s = scr + (8 * c) * 33 + n;
        u32x4 o; o.x = cvt_pk_bf16(s[0 * 33], s[1 * 33]); o.y = cvt_pk_bf16(s[2 * 33], s[3 * 33]); o.z = cvt_pk_bf16(s[4 * 33], s[5 * 33]); o.w = cvt_pk_bf16(s[6 * 33], s[7 * 33]);
        *(u32x4*)(WT + (size_t)(r0 + n) * ldt + k0 + 8 * c) = o; }
    LDS_WAIT(); asm volatile("" ::: "memory");
}

struct Args { const float* in[34]; float* out; unsigned char* ws; };

__device__ __forceinline__ void prep_phase(const Frame& F, const Args& a) {
    OPAQUE_TID();
    unsigned char* ws = a.ws;
    LAS float* scr = (LAS float*)(F.lds + wave * 16384);
    const int gw = F.bid * 8 + wave, NGW = F.G * 8;
    constexpr int I_SQ = (D / 64) * (D / 32), I_UP = (D / 64) * (FF / 32), I_DN = (FF / 64) * (D / 32), I_GRP = 4 * (256 / 64) * (256 / 32), I_CIN = (D / 64) * (2 * D / 32);
    constexpr int I_MLP = I_UP + I_DN;
    constexpr int I_POOL = I_SQ + I_GRP + I_MLP, I_CONV = I_CIN + I_SQ + I_MLP, I_FOUR = 2 * I_SQ + I_MLP;
    constexpr int NITEMS = 2 * I_POOL + I_CONV + I_FOUR;
#define JOB(W, K_, N_, DST, LDT, KS, NS, GLU) if (r < ((K_) / 64) * ((N_) / 32)) { transpose_item((W), (K_), (N_), (bf16_t*)(DST), (LDT), (KS), (NS), (GLU), scr, r, lane); continue; } r -= ((K_) / 64) * ((N_) / 32);
#define JOB_MLP(L, i0) JOB(a.in[(i0) + 1], D, FF, ws + WS_WUP + (L) * 16 * MiB, D, a.in[(i0)], nullptr, false) \
                       JOB(a.in[(i0) + 2], FF, D, ws + WS_WDN + (L) * 16 * MiB, FF, nullptr, nullptr, false)
#define JOB_POOL(L, i0) if (r < I_GRP) { const int g = r / (I_GRP / 4); transpose_item(a.in[(i0) + 2] + g * 65536, 256, 256, (bf16_t*)(ws + WS_MIXB + (L) * 3 * MiB) + g * 65536, 256, nullptr, a.in[(i0) + 3] + g * 256, false, scr, r % (I_GRP / 4), lane); continue; } r -= I_GRP; \
                        JOB(a.in[(i0) + 4], D, D, ws + WS_MIXB + (L) * 3 * MiB + MiB, D, nullptr, nullptr, false) \
                        JOB_MLP(L, (i0) + 5)
    for (int it = gw; it < NITEMS; it += NGW) {
        int r = it;
        JOB_POOL(0, 1)
        JOB(a.in[10], D, 2 * D, ws + WS_MIX + 1 * 5 * MiB, D, a.in[9], nullptr, true)
        JOB(a.in[15], D, D, ws + WS_MIXB + 1 * 3 * MiB + MiB, D, nullptr, nullptr, false)
        JOB_MLP(1, 16)
        JOB(a.in[20], D, D, ws + WS_MIX + 2 * 5 * MiB, D, a.in[19], nullptr, false)
        JOB(a.in[21], D, D, ws + WS_MIXB + 2 * 3 * MiB + MiB, D, nullptr, nullptr, false)
        JOB_MLP(2, 22)
        JOB_POOL(3, 25)
    }
#undef JOB
#undef JOB_MLP
#undef JOB_POOL
    {
        const float* x = a.in[0]; bf16_t* XB = (bf16_t*)(ws + WS_XB); float* rowsq = (float*)(ws + WS_ROWSQ);
        for (int m = gw; m < M; m += 2 * NGW) {
            const int m2 = (m + NGW < M) ? m + NGW : m;
            const f32x4* xr = (const f32x4*)(x + (size_t)m * D) + lane; const f32x4* xr2 = (const f32x4*)(x + (size_t)m2 * D) + lane; f32x4 v[4], v2[4]; float s = 0.f, s2 = 0.f;
#pragma unroll
            for (int j = 0; j < 4; ++j) { v[j] = xr[64 * j]; v2[j] = xr2[64 * j]; }
#pragma unroll
            for (int j = 0; j < 4; ++j) { s += (v[j][0] * v[j][0] + v[j][1] * v[j][1]) + (v[j][2] * v[j][2] + v[j][3] * v[j][3]); s2 += (v2[j][0] * v2[j][0] + v2[j][1] * v2[j][1]) + (v2[j][2] * v2[j][2] + v2[j][3] * v2[j][3]); }
            s = wave_sum(s); s2 = wave_sum(s2);
            u32x2* o8 = (u32x2*)(XB + (size_t)m * D) + lane; u32x2* o82 = (u32x2*)(XB + (size_t)m2 * D) + lane;
#pragma unroll
            for (int j = 0; j < 4; ++j) { u32x2 w; w.x = cvt_pk_bf16(v[j][0], v[j][1]); w.y = cvt_pk_bf16(v[j][2], v[j][3]); o8[64 * j] = w;
                                          u32x2 w2; w2.x = cvt_pk_bf16(v2[j][0], v2[j][1]); w2.y = cvt_pk_bf16(v2[j][2], v2[j][3]); o82[64 * j] = w2; }
            if (lane < 4) { rowsq[(size_t)m * 4 + lane] = (lane == 0) ? s : 0.f; rowsq[(size_t)m2 * 4 + lane] = (lane == 0) ? s2 : 0.f; }
        }
    }
    {
        const int gt = F.bid * 512 + tid, GT = F.G * 512;
        for (int it = gt; it < 2 * D * D / 8; it += GT) {
            const int l3 = it >> 17, e0 = (it & 131071) * 8, k = e0 >> 10;
            const float* W = l3 ? a.in[26] : a.in[2]; const float gk = (l3 ? a.in[25] : a.in[1])[k];
            const f32x4 v0 = *(const f32x4*)(W + e0), v1 = *(const f32x4*)(W + e0 + 4);
            u32x4 w; w.x = cvt_pk_bf16(v0[0] * gk, v0[1] * gk); w.y = cvt_pk_bf16(v0[2] * gk, v0[3] * gk); w.z = cvt_pk_bf16(v1[0] * gk, v1[1] * gk); w.w = cvt_pk_bf16(v1[2] * gk, v1[3] * gk);
            *(u32x4*)((bf16_t*)(ws + WS_MIX + (l3 ? 15 : 0) * MiB + 2 * MiB) + e0) = w;
        }
        bf16_t* Dcs = (bf16_t*)(ws + WS_DCS); bf16_t* T = (bf16_t*)(ws + WS_T);
        for (int it = gt; it < 2 * 256 * 256 / 8; it += GT) {
            const int e0 = it * 8, cs = e0 >> 16, j = (e0 >> 8) & 255, c0 = e0 & 255; float v[8];
#pragma unroll
            for (int k = 0; k < 8; ++k) { const float xx = (float)((j * (c0 + k)) & 255) * (1.0f / 128.0f); v[k] = (cs ? sinpif(xx) : cospif(xx)) * 0.0625f; }
            u32x4 w; w.x = cvt_pk_bf16(v[0], v[1]); w.y = cvt_pk_bf16(v[2], v[3]); w.z = cvt_pk_bf16(v[4], v[5]); w.w = cvt_pk_bf16(v[6], v[7]);
            *(u32x4*)(Dcs + e0) = w;
        }
        for (int it = gt; it < 2048 * KF / 8; it += GT) {
            const int e0 = it * 8, p = e0 / KF, q = e0 % KF; float v[8];
#pragma unroll
            for (int k = 0; k < 8; ++k) { const int kk = q + k, cs = kk >= KFE, sidx = cs ? kk - KFE : kk; const float xx = (float)((p * sidx) & 2047) * (1.0f / 1024.0f);
                v[k] = (cs ? -sinpif(xx) : (kk <= 1024 ? cospif(xx) : 0.0f)) * 0.03125f; }
            u32x4 w; w.x = cvt_pk_bf16(v[0], v[1]); w.y = cvt_pk_bf16(v[2], v[3]); w.z = cvt_pk_bf16(v[4], v[5]); w.w = cvt_pk_bf16(v[6], v[7]);
            *(u32x4*)(T + e0) = w;
        }
    }
}

__device__ __forceinline__ void fourier_fold_phase(const Frame& F, const bf16_t* __restrict__ U, bf16_t* __restrict__ FFo) {
    OPAQUE_TID();
    const int gt = F.bid * 512 + tid, GT = F.G * 512;
#pragma unroll 4
    for (int it = gt; it < NB * KF * 128; it += GT) {
        const int ch = it & 127, r = (it >> 7) % KF, b = (it >> 7) / KF;
        const bool sinp = r >= KFE; const int s = sinp ? r - KFE : r;
        const bf16_t* ub = U + (size_t)b * S * D + ch * 8;
        u32x4 o = (u32x4){0u, 0u, 0u, 0u};
        if (s <= 1024 && !(sinp && s == 0) && !(sinp && s == 1024)) {
            const u32x4 a = *(const u32x4*)(ub + (size_t)s * D);
            if (s == 0 || s == 1024) o = a;
            else { const u32x4 c = *(const u32x4*)(ub + (size_t)(S - s) * D); const float sg = sinp ? -1.0f : 1.0f;
#pragma unroll
                for (int k = 0; k < 4; ++k) o[k] = cvt_pk_bf16(bflo(a[k]) + sg * bflo(c[k]), bfhi(a[k]) + sg * bfhi(c[k])); }
        }
        *(u32x4*)(FFo + ((size_t)b * KF + r) * D + ch * 8) = o;
    }
}

template <int HW>
__device__ __forceinline__ void pool_item(const bf16_t* U, bf16_t* P, int b, int seg, int g, int lane) {
    const int s0 = seg * 16;
    const bf16_t* base = U + (size_t)b * S * D + g * 256 + lane * 4;
    u32x2 r[16 + 2 * HW];
#pragma unroll
    for (int i = 0; i < 16 + 2 * HW; ++i) { const int t = s0 - HW + i; r[i] = (u32x2){0u, 0u}; if (t >= 0 && t < S) r[i] = *(const u32x2*)(base + (size_t)t * D); }
    float sum[4] = {0.f, 0.f, 0.f, 0.f};
#pragma unroll
    for (int i = 0; i < 2 * HW; ++i) { sum[0] += bflo(r[i][0]); sum[1] += bfhi(r[i][0]); sum[2] += bflo(r[i][1]); sum[3] += bfhi(r[i][1]); }
    bf16_t* ob = P + (size_t)(b * S + s0) * D + g * 256 + lane * 4;
#pragma unroll
    for (int o = 0; o < 16; ++o) {
        const int s = s0 + o, lo = (s - HW) > 0 ? (s - HW) : 0, hi = (s + HW) < S ? (s + HW) : S;
        const float inv = 1.0f / (float)(hi - lo);
        const u32x2 c = r[o + HW];
        u32x2 w; w.x = cvt_pk_bf16(sum[0] * inv - bflo(c[0]), sum[1] * inv - bfhi(c[0])); w.y = cvt_pk_bf16(sum[2] * inv - bflo(c[1]), sum[3] * inv - bfhi(c[1]));
        *(u32x2*)(ob + (size_t)o * D) = w;
        if (o < 15) { const u32x2 a = r[o + 2 * HW], d = r[o];
            sum[0] += bflo(a[0]) - bflo(d[0]); sum[1] += bfhi(a[0]) - bfhi(d[0]); sum[2] += bflo(a[1]) - bflo(d[1]); sum[3] += bfhi(a[1]) - bfhi(d[1]); }
    }
}
__device__ __forceinline__ void pool_phase(const Frame& F, const bf16_t* U, bf16_t* P) {
    OPAQUE_TID();
    const int gw = F.bid * 8 + wave, NGW = F.G * 8;
    for (int it = gw; it < NB * (S / 16) * 4; it += NGW) {
        const int g = it & 3, seg = (it >> 2) & (S / 16 - 1), b = it >> 9;
        if (g == 0) pool_item<1>(U, P, b, seg, 0, lane);
        else if (g == 1) pool_item<2>(U, P, b, seg, 1, lane);
        else if (g == 2) pool_item<4>(U, P, b, seg, 2, lane);
        else pool_item<8>(U, P, b, seg, 3, lane);
    }
}

__device__ __forceinline__ void conv_dma_rows(LAS unsigned char* tl, const bf16_t* V, int p0, int sbase, int ra, int nrows, int wave, int lane) {
    for (int c = wave; c < 2 * nrows; c += 8) {
        const int r = ra + (c >> 1), t = sbase - 15 + r;
        LAS unsigned char* dst = tl + (r & 63) * (D * 2) + (c & 1) * 1024;
        if (t >= 0 && t < S) __builtin_amdgcn_global_load_lds((const unsigned*)((const char*)V + ((long)(p0 - 15 + r)) * (D * 2) + (c & 1) * 1024 + lane * 16), (LAS unsigned*)dst, 16, 0, 0);
        else *(LAS u32x4*)(dst + lane * 16) = (u32x4){0u, 0u, 0u, 0u};
    }
}
__device__ __forceinline__ void conv_phase(const Frame& F, const bf16_t* V, bf16_t* Aout, const float* dw, const float* dwb, const float* lng, const float* lnb) {
    OPAQUE_TID();
    f32x2 wv[31];
    { const float* p = dw + 2 * tid;
#pragma unroll
      for (int j = 0; j < 31; ++j) { wv[j] = *(const f32x2*)p; p += D; if ((j & 3) == 3) asm volatile("" ::: "memory"); } }
    const f32x2 bb = *(const f32x2*)(dwb + 2 * tid), gg = *(const f32x2*)(lng + 2 * tid), lb = *(const f32x2*)(lnb + 2 * tid);
    LAS unsigned char* tl = F.lds;
    LAS float* part = (LAS float*)(F.lds + 131072 + 1024);
    LAS float* stat = (LAS float*)(F.lds + 131072 + 2048);
    for (int strip = F.bid; strip < M / 128; strip += F.G) {
        const int p0 = strip * 128, sbase = p0 & (S - 1);
        conv_dma_rows(tl, V, p0, sbase, 0, 46, wave, lane);
#pragma unroll 1
        for (int k = 0; k < 8; ++k) {
            asm volatile("s_waitcnt vmcnt(0) lgkmcnt(0)" ::: "memory");
            __syncthreads();
            if (k < 7) conv_dma_rows(tl, V, p0, sbase, 46 + 16 * k, 16, wave, lane);
#pragma unroll 1
            for (int h = 0; h < 2; ++h) {
                const int rb = 16 * k + 8 * h;
                const LAS unsigned char* tlt = tl + tid * 4;
                f32x2 av[8];
#pragma unroll
                for (int o = 0; o < 8; ++o) av[o] = bb;
#pragma unroll
                for (int tt = 0; tt < 38; ++tt) {
                    const unsigned w = *(const LAS unsigned*)(tlt + ((rb + tt) & 63) * (D * 2));
                    const f32x2 xv = (f32x2){bflo(w), bfhi(w)};
#pragma unroll
                    for (int o = 0; o < 8; ++o) { const int j = tt - o; if (j >= 0 && j <= 30) av[o] = __builtin_elementwise_fma(xv, wv[j], av[o]); }
                    if ((tt & 7) == 7) asm volatile("" ::: "memory");
                }
                float vals[16];
#pragma unroll
                for (int o = 0; o < 8; ++o) { vals[o] = av[o][0] + av[o][1]; vals[8 + o] = av[o][0] * av[o][0] + av[o][1] * av[o][1]; }
#pragma unroll
                for (int step = 0; step < 4; ++step) {
                    const int half = 8 >> step; const bool up = (lane >> step) & 1;
#pragma unroll
                    for (int i = 0; i < half; ++i) { const float keep = up ? vals[i + half] : vals[i], send = up ? vals[i] : vals[i + half]; vals[i] = keep + __shfl_xor(send, 1 << step); }
                }
                vals[0] += __shfl_xor(vals[0], 16); vals[0] += __shfl_xor(vals[0], 32);
                if (lane < 16) { const int l = lane; const int idx = ((l & 1) << 3) | ((l & 2) << 1) | ((l & 4) >> 1) | ((l & 8) >> 3); part[wave * 16 + idx] = vals[0]; }
                __syncthreads();
                if (tid < 8) { float s1 = 0.f, s2 = 0.f;
#pragma unroll
                    for (int w = 0; w < 8; ++w) { s1 += part[w * 16 + tid]; s2 += part[w * 16 + 8 + tid]; }
                    const float mean = s1 * (1.0f / D), var = s2 * (1.0f / D) - mean * mean;
                    stat[2 * tid] = mean; stat[2 * tid + 1] = __builtin_amdgcn_rsqf(fmaxf(var, 0.f) + LN_EPS); }
                __syncthreads();
                unsigned* op = (unsigned*)(Aout + (size_t)(p0 + rb) * D) + tid;
#pragma unroll
                for (int o = 0; o < 8; ++o) {
                    const float mean = stat[2 * o], rstd = stat[2 * o + 1];
                    const float y0 = (av[o][0] - mean) * rstd * gg[0] + lb[0], y1 = (av[o][1] - mean) * rstd * gg[1] + lb[1];
                    const float z0 = y0 * __builtin_amdgcn_rcpf(1.0f + __builtin_amdgcn_exp2f(-1.44269504089f * y0)), z1 = y1 * __builtin_amdgcn_rcpf(1.0f + __builtin_amdgcn_exp2f(-1.44269504089f * y1));
                    *op = cvt_pk_bf16(z0, z1); op += D / 2;
                    if ((o & 3) == 3) asm volatile("" ::: "memory");
                }
            }
        }
        __syncthreads();
    }
}

__device__ __forceinline__ void final_phase(const Frame& F, float* out, const bf16_t* xb, const float* rowsq, const float* g) {
    OPAQUE_TID();
    const int gw = F.bid * 8 + wave, NGW = F.G * 8;
    f32x4 gv[4];
#pragma unroll
    for (int j = 0; j < 4; ++j) gv[j] = ((const f32x4*)g)[lane + 64 * j];
    for (int m = gw; m < M; m += 2 * NGW) {
        const int m2 = m + NGW;
        const float q0 = lane < 4 ? rowsq[(size_t)m * 4 + lane] : 0.f, q1 = (m2 < M && lane < 4) ? rowsq[(size_t)m2 * 4 + lane] : 0.f;
        u32x2 a[4], b[4];
#pragma unroll
        for (int j = 0; j < 4; ++j) { a[j] = ((const u32x2*)(xb + (size_t)m * D))[lane + 64 * j]; b[j] = (m2 < M) ? ((const u32x2*)(xb + (size_t)m2 * D))[lane + 64 * j] : (u32x2){0u, 0u}; }
        const float r0 = __builtin_amdgcn_rsqf(wave_sum(q0) * (1.0f / D) + NORM_EPS), r1 = __builtin_amdgcn_rsqf(wave_sum(q1) * (1.0f / D) + NORM_EPS);
        f32x4* o0 = (f32x4*)(out + (size_t)m * D) + lane; f32x4* o1 = (f32x4*)(out + (size_t)m2 * D) + lane;
#pragma unroll
        for (int j = 0; j < 4; ++j) { const f32x4 v = (f32x4){bflo(a[j][0]), bfhi(a[j][0]), bflo(a[j][1]), bfhi(a[j][1])}; o0[64 * j] = v * r0 * gv[j]; }
        if (m2 < M) {
#pragma unroll
            for (int j = 0; j < 4; ++j) { const f32x4 v = (f32x4){bflo(b[j][0]), bfhi(b[j][0]), bflo(b[j][1]), bfhi(b[j][1])}; o1[64 * j] = v * r1 * gv[j]; } }
    }
}

__global__ void __launch_bounds__(512, 2) fwd_megakernel(Args args) {
    extern __shared__ __attribute__((aligned(16))) unsigned char lds_raw[];
    cg::grid_group grid = cg::this_grid();
    Frame F; F.lds = (LAS unsigned char*)lds_raw; F.G = gridDim.x; F.bid = blockIdx.x;
    unsigned char* ws = args.ws;
    float* X = args.out;
    bf16_t* XB = (bf16_t*)(ws + WS_XB); float* ROWSQ = (float*)(ws + WS_ROWSQ);
    bf16_t* ACT1 = (bf16_t*)(ws + WS_ACT1); bf16_t* ACT2 = (bf16_t*)(ws + WS_ACT2); bf16_t* YT = (bf16_t*)(ws + WS_YT); bf16_t* HB = (bf16_t*)(ws + WS_H);
    volatile LAS unsigned* bst = (volatile LAS unsigned*)(F.lds + 131072 + 512);
    if (threadIdx.x < 2) bst[threadIdx.x] = 0u;
    __syncthreads();
    const XcdBarrier xbar = xcd_barrier_post((unsigned*)ws, bst);
#define GSYNC() xcd_barrier(xbar)
#define RUN_GEMM(EPI, A_, B_, LDA, LDB, K_, MODE, MR, NC, APN, ...) RUN_GEMM_S(0u, EPI, A_, B_, LDA, LDB, K_, MODE, MR, NC, APN, __VA_ARGS__)
#define RUN_GEMM_S(STAG, EPI, A_, B_, LDA, LDB, K_, MODE, MR, NC, APN, ...) do { pg8::Gemm g_{(A_), (B_), (LDA), (LDB), (K_)}; pg8::Order S_; S_.init((MODE), (MR), (NC), F.G, F.bid, (LDA), (LDB), (APN)); \
        EPI E_{__VA_ARGS__}; pg8::gemm_phase<EPI>(F.lds, g_, S_, E_, STAG); } while (0)

    if (args.ws == nullptr) grid.sync();
    prep_phase(F, args);
    GSYNC();
    RUN_GEMM(pg8::EpiBf16<0>, (const bf16_t*)(ws + WS_MIXB), (const bf16_t*)(ws + WS_MIX + 2 * MiB), 256, D, 256, 3, 32 * 256, 256, 0, (bf16_t*)(ws + WS_MIX), D, nullptr, 1.0f);
    GSYNC();
#pragma unroll 1
    for (int l = 0; l < 4; ++l) {
        const bf16_t* Win = (const bf16_t*)(ws + WS_MIX + (size_t)l * 5 * MiB);
        const bf16_t* Wout = (const bf16_t*)(ws + WS_MIXB + (size_t)l * 3 * MiB + MiB);
        if (l == 0 || l == 3) {
            RUN_GEMM(pg8::EpiBf16<0>, XB, Win, D, D, D, 0, M, D, 0, ACT1, D, ROWSQ, 1.0f);
            GSYNC();
            pool_phase(F, ACT1, ACT2);
            GSYNC();
            RUN_GEMM(pg8::EpiRes, ACT2, Wout, D, D, D, 0, M, D, 0, (l == 0) ? 0 : 1, args.in[0], XB, X, ROWSQ);
            GSYNC();
        } else if (l == 1) {
            RUN_GEMM(pg8::EpiBf16<2>, XB, Win, D, D, D, 0, M, 2 * D, 0, ACT1, D, ROWSQ, 1.0f);
            GSYNC();
            conv_phase(F, ACT1, ACT2, args.in[11], args.in[12], args.in[13], args.in[14]);
            GSYNC();
            RUN_GEMM(pg8::EpiRes, ACT2, Wout, D, D, D, 0, M, D, 0, (l == 0) ? 0 : 1, args.in[0], XB, X, ROWSQ);
            GSYNC();
        } else {
            RUN_GEMM(pg8::EpiBf16<0>, XB, Win, D, D, D, 0, M, D, 0, ACT1, D, ROWSQ, 1.0f);
            GSYNC();
            fourier_fold_phase(F, ACT1, (bf16_t*)(ws + WS_FF));
            GSYNC();
            RUN_GEMM(pg8::EpiBf16<0>, (const bf16_t*)(ws + WS_DCS), (const bf16_t*)(ws + WS_FF), 256, D, 256, 1, 256 * 576, 256, 0, YT, KF, nullptr, 1.0f);
            GSYNC();
            RUN_GEMM(pg8::EpiBf16<0>, (const bf16_t*)(ws + WS_T), YT, KF, KF, KF, 2, 256 * 512, 256, 0, ACT2, D, nullptr, 0.70710678118f);
            GSYNC();
            RUN_GEMM(pg8::EpiRes, ACT2, Wout, D, D, D, 0, M, D, 0, (l == 0) ? 0 : 1, args.in[0], XB, X, ROWSQ);
            GSYNC();
        }
#pragma unroll 1
        for (int c_ = 0; c_ < 2; ++c_) {
            int c = c_; asm volatile("" : "+s"(c));
            const size_t r0 = (size_t)c * (M / 2);
            RUN_GEMM_S(0u, pg8::EpiBf16<1>, XB + r0 * D, (const bf16_t*)(ws + WS_WUP + (size_t)l * 16 * MiB), D, D, D, 0, M / 2, FF, 0, HB, FF, ROWSQ + r0 * 4, 1.0f);
            GSYNC();
            RUN_GEMM(pg8::EpiRes, HB, (const bf16_t*)(ws + WS_WDN + (size_t)l * 16 * MiB), FF, FF, FF, 0, M / 2, D, 0, 1, args.in[0], XB + r0 * D, X, ROWSQ + r0 * 4);
            GSYNC();
        }
    }
    final_phase(F, X, XB, ROWSQ, args.in[33]);
}

extern "C" void kernel_launch(void* const* d_in, const int* in_sizes, int n_in, void* d_out, int out_size, void* d_ws, size_t ws_size, hipStream_t stream) {
    static int grid = 0;
    if (grid == 0) {
        if (n_in != 34 || out_size != M * D || ws_size < WS_END) { fprintf(stderr, "kernel_launch: unexpected problem (n_in %d, out %d, ws %zu < %zu)\n", n_in, out_size, ws_size, (size_t)WS_END); grid = -1; return; }
        int dev = 0, cus = 0, per_cu = 0;
        if (hipGetDevice(&dev) != hipSuccess || hipDeviceGetAttribute(&cus, hipDeviceAttributeMultiprocessorCount, dev) != hipSuccess) { grid = -1; return; }
        if (hipFuncSetAttribute((const void*)fwd_megakernel, hipFuncAttributeMaxDynamicSharedMemorySize, LDS_BYTES) != hipSuccess) { fprintf(stderr, "hipFuncSetAttribute failed\n"); grid = -1; return; }
        if (hipOccupancyMaxActiveBlocksPerMultiprocessor(&per_cu, (const void*)fwd_megakernel, 512, LDS_BYTES) != hipSuccess || per_cu < 1) { fprintf(stderr, "occupancy query: %d\n", per_cu); }
        (void)hipGetLastError();
        grid = cus;
    }
    if (grid < 0) return;
    if (hipMemsetAsync(d_ws, 0, 16384, stream) != hipSuccess) { fprintf(stderr, "kernel_launch: memset failed\n"); return; }
    Args a{};
    for (int i = 0; i < 34; ++i) a.in[i] = (const float*)d_in[i];
    a.out = (float*)d_out; a.ws = (unsigned char*)d_ws;
    void* kargs[] = {&a};
    hipError_t e = hipLaunchCooperativeKernel((const void*)fwd_megakernel, dim3(grid), dim3(512), kargs, LDS_BYTES, stream);
    if (e != hipSuccess) fprintf(stderr, "cooperative launch failed: %s (grid %d)\n", hipGetErrorString(e), grid);
}
```

```cpp
#include <hip/hip_runtime.h>
#include <hip/hip_cooperative_groups.h>
#include <cstdio>
#include <cstdint>
namespace cg = cooperative_groups;

#define LAS __attribute__((address_space(3)))
typedef unsigned short bf16_t;
typedef short bf16x8 __attribute__((ext_vector_type(8)));
typedef float f32x4 __attribute__((ext_vector_type(4)));
typedef float f32x2 __attribute__((ext_vector_type(2)));
typedef unsigned u32x4 __attribute__((ext_vector_type(4)));
typedef unsigned u32x2 __attribute__((ext_vector_type(2)));

constexpr int NB = 16, S = 2048, D = 1024, M = NB * S, FF = 4096;
constexpr float NORM_EPS = 1e-6f, LN_EPS = 1e-5f;
constexpr size_t MiB = 1u << 20;
constexpr size_t WS_ROWSQ = 1 * MiB;
constexpr size_t WS_DCS = 3 * MiB;
constexpr size_t WS_T = 4 * MiB;
constexpr size_t WS_WUP = 20 * MiB;
constexpr size_t WS_WDN = 28 * MiB;
constexpr size_t WS_MIX = 84 * MiB;
constexpr size_t WS_MIXB = 104 * MiB;
constexpr size_t WS_XB = 116 * MiB;
constexpr size_t WS_H = 180 * MiB;
constexpr size_t WS_ACT1 = WS_H, WS_ACT2 = WS_H + 64 * MiB, WS_FF = WS_H + 64 * MiB, WS_YT = WS_H + 144 * MiB, WS_ACT3 = WS_H + 128 * MiB;
constexpr size_t WS_END = WS_H + 256 * MiB;
constexpr int LDS_BYTES = 147456;
constexpr int KFE = 1280, KF = KFE + 1024;

__device__ __forceinline__ unsigned cvt_pk_bf16(float lo, float hi) { unsigned r; asm volatile("v_cvt_pk_bf16_f32 %0, %1, %2" : "=v"(r) : "v"(lo), "v"(hi)); return r; }
__device__ __forceinline__ float bflo(unsigned w) { return __uint_as_float(w << 16); }
__device__ __forceinline__ float bfhi(unsigned w) { return __uint_as_float(w & 0xffff0000u); }

namespace pg8 {
constexpr int BM = 256, BK = 64, HALF = 128, HTB = HALF * BK * 2, STAGE_BYTES = 8 * HTB, NXCD = 8, WGM = 4;
__host__ __device__ __forceinline__ int lds_byte(int r, int c) { const int st = (r >> 4) * 2 + (c >> 5), rr = r & 15, cc = c & 31, ob = rr * 64 + cc * 2; return st * 1024 + (ob ^ (((ob >> 9) & 1) << 5)); }
__host__ __device__ __forceinline__ void stage_rc(int b, int& R, int& C) { const int st = b / 1024, sb = b % 1024, swz = sb ^ (((sb >> 9) & 1) << 5); R = (st >> 1) * 16 + swz / 64; C = (st & 1) * 32 + (swz % 64) / 2; }
__host__ __device__ __forceinline__ int perm32(int rho) { const int n = rho >> 4, i = rho & 15; return 8 * (i >> 2) + 4 * n + (i & 3); }

struct Unit { long aoff, boff; int row0, col0; };
struct Gemm { const bf16_t* A; const bf16_t* Bt; int lda, ldb, K; };

struct Order {
    int mode, nM, nN, nwg, G, c, lda, ldb; long a_pn_bytes;
    __device__ __forceinline__ void init(int mode_, int Mr, int Nc, int G_, int c_, int lda_, int ldb_, long apn) { mode = mode_; nM = Mr / BM; nN = Nc / BM; nwg = nM * nN; G = G_; c = c_; lda = lda_; ldb = ldb_; a_pn_bytes = apn; }
    __device__ __forceinline__ bool next(int i, Unit& u) const {
        const long L = (long)i * G + c; if (L >= nwg) return false;
        if (mode == 0) {
            int wgid = (int)L; { const int q = nwg / NXCD, r = nwg % NXCD, xcd = wgid % NXCD, off = wgid / NXCD; wgid = (xcd < r ? xcd * (q + 1) : r * (q + 1) + (xcd - r) * q) + off; }
            const int nig = WGM * nN, gid = wgid / nig, fm = gid * WGM, gsz = (nM - fm) < WGM ? (nM - fm) : WGM;
            const int pm = fm + ((wgid % nig) % gsz), pn = (wgid % nig) / gsz;
            u.aoff = (long)pm * BM * lda * 2 + (long)pn * a_pn_bytes; u.boff = (long)pn * BM * ldb * 2; u.row0 = pm * BM; u.col0 = pn * BM;
        } else if (mode == 1) {
            const int w = (int)L, t = w % 9, g = (w / 9) & 3, b = w / 36, cs = (t >= 5) ? 1 : 0;
            u.aoff = (long)cs * 256 * 256 * 2; u.boff = ((long)(b * KF + t * 256) * D + g * 256) * 2; u.row0 = b * 1024 + g * 256; u.col0 = t * 256;
        } else if (mode == 3) {
            const int w = (int)L, layer = w >> 4, pm = (w >> 2) & 3, pn = w & 3;
            u.aoff = (long)layer * 9 * 1048576 + (long)pm * 256 * 256 * 2; u.boff = (long)layer * 15 * 1048576 + (long)pn * 256 * 1024 * 2 + pm * 512; u.row0 = layer * 7680 + pm * 256; u.col0 = pn * 256;
        } else {
            int b, pm, pn;
            if (G == 256) { const int xcd = c & 7, loc = c >> 3; b = i * 8 + xcd; pm = loc & 7; pn = loc >> 3; }
            else { const int w = (int)L; b = w >> 5; pm = w & 7; pn = (w >> 3) & 3; }
            u.aoff = (long)pm * 256 * KF * 2; u.boff = ((long)b * 1024 + pn * 256) * KF * 2; u.row0 = b * S + pm * 256; u.col0 = pn * 256;
        }
        return true;
    }
};

__device__ __forceinline__ float row_rstd(const float* rowsq, int row) {
    const f32x4 s = *(const f32x4*)(rowsq + (size_t)row * 4);
    const float t = (s[0] + s[1]) + (s[2] + s[3]);
    return __builtin_amdgcn_rsqf(t * (1.0f / D) + NORM_EPS);
}
template <int ACT> struct EpiBf16 {
    static constexpr bool PERM = true, WIDE = (ACT != 2);
    bf16_t* O; int ldc; const float* rowsq; float post;
    template <class Sched> __device__ __forceinline__ void prefill(LAS unsigned char* lds, const Sched& S, int tid) const {
        if (!rowsq) return;
        LAS float* rsl = (LAS float*)(lds + 139264);
        Unit u;
        for (int i = 0; i < 8 && S.next(i, u); ++i) if (tid < 256) rsl[i * 256 + tid] = post * row_rstd(rowsq, u.row0 + tid);
        asm volatile("s_waitcnt vmcnt(0) lgkmcnt(0)" ::: "memory");
    }
    __device__ __forceinline__ void operator()(const f32x4 (&acc)[2][2][4][2], const Unit& u, int wr, int wc, int fr, int fq, LAS unsigned char* lds, int, int ui) const {
        const int row0 = u.row0 + wr * 64 + fr;
        const int col0 = (ACT == 2 ? (u.col0 >> 1) : u.col0) + wc * 32 + 8 * fq;
        const LAS float* rsl = (const LAS float*)(lds + 139264) + (ui & 7) * 256 + wr * 64 + fr;
        float rs[2][4];
#pragma unroll
        for (int ai = 0; ai < 2; ++ai)
#pragma unroll
            for (int m = 0; m < 4; ++m) rs[ai][m] = rowsq ? rsl[ai * HALF + m * 16] : post;
#pragma unroll
        for (int ai = 0; ai < 2; ++ai)
#pragma unroll
            for (int m = 0; m < 4; ++m) {
                const int row = row0 + ai * HALF + m * 16;
                const float sc = rs[ai][m];
                bf16_t* rowp = O + (size_t)row * ldc + col0;
                if (ACT == 2) {
                    f32x4 v0 = acc[ai][0][m][0] * sc, v1 = acc[ai][0][m][1] * sc, g0 = acc[ai][1][m][0] * sc, g1 = acc[ai][1][m][1] * sc;
#pragma unroll
                    for (int i = 0; i < 4; ++i) {
                        v0[i] = v0[i] * __builtin_amdgcn_rcpf(1.0f + __builtin_amdgcn_exp2f(-1.44269504089f * g0[i]));
                        v1[i] = v1[i] * __builtin_amdgcn_rcpf(1.0f + __builtin_amdgcn_exp2f(-1.44269504089f * g1[i])); }
                    u32x4 w; w.x = cvt_pk_bf16(v0[0], v0[1]); w.y = cvt_pk_bf16(v0[2], v0[3]); w.z = cvt_pk_bf16(v1[0], v1[1]); w.w = cvt_pk_bf16(v1[2], v1[3]);
                    *(u32x4*)rowp = w;
                } else {
                    u32x4 wp[2];
#pragma unroll
                    for (int bj = 0; bj < 2; ++bj) {
                        f32x4 v0 = acc[ai][bj][m][0] * sc, v1 = acc[ai][bj][m][1] * sc;
                        if (ACT == 1) {
#pragma unroll
                            for (int i = 0; i < 4; ++i) { const float a = fmaxf(v0[i], 0.f), b = fmaxf(v1[i], 0.f); v0[i] = a * a; v1[i] = b * b; } }
                        wp[bj].x = cvt_pk_bf16(v0[0], v0[1]); wp[bj].y = cvt_pk_bf16(v0[2], v0[3]); wp[bj].z = cvt_pk_bf16(v1[0], v1[1]); wp[bj].w = cvt_pk_bf16(v1[2], v1[3]); }
                    const bool lo = fr < 8;
                    u32x4 snd = lo ? wp[1] : wp[0], rcv;
#pragma unroll
                    for (int i = 0; i < 4; ++i) rcv[i] = (unsigned)__shfl_xor((int)snd[i], 8);
                    const u32x4 dA = lo ? wp[0] : rcv, dB = lo ? rcv : wp[1];
                    bf16_t* pa = O + (size_t)(row - fr + (fr & 7)) * ldc + (u.col0 + wc * 64 + 8 * fq + (lo ? 0 : 32));
                    *(u32x4*)pa = dA; *(u32x4*)(pa + (size_t)8 * ldc) = dB;
                }
                asm volatile("" ::: "memory");
            }
    }
};
struct EpiRes {
    static constexpr bool PERM = true, WIDE = false;
    template <class Sched> __device__ __forceinline__ void prefill(LAS unsigned char*, const Sched&, int) const {}
    int mode; const float* xin; bf16_t* xb; float* xout; float* rowsq;
    __device__ __forceinline__ void operator()(const f32x4 (&acc)[2][2][4][2], const Unit& u, int wr, int wc, int fr, int fq, LAS unsigned char* lds, int tid, int) const {
        const int colb = u.col0 + wc * 32 + 8 * fq, pn = u.col0 >> 8;
        LAS float* xch = (LAS float*)(lds + 135168);
        const size_t off0 = (size_t)(u.row0 + wr * 64 + fr) * D + colb;
#define EPIRES_BODY(it_, c0_, c1_) do { const int ai = (it_) >> 2, m = (it_) & 3; const size_t off = off0 + (size_t)(ai * HALF + m * 16) * D; float ss = 0.f; \
            _Pragma("unroll") for (int bj = 0; bj < 2; ++bj) { \
                const f32x4 o0 = (c0_)[bj] + acc[ai][bj][m][0], o1 = (c1_)[bj] + acc[ai][bj][m][1]; \
                ss += ((o0[0] * o0[0] + o0[1] * o0[1]) + (o0[2] * o0[2] + o0[3] * o0[3])) + ((o1[0] * o1[0] + o1[1] * o1[1]) + (o1[2] * o1[2] + o1[3] * o1[3])); \
                if (mode == 2) { *(f32x4*)(xout + off + bj * HALF) = o0; *(f32x4*)(xout + off + bj * HALF + 4) = o1; } \
                else { u32x4 w; w.x = cvt_pk_bf16(o0[0], o0[1]); w.y = cvt_pk_bf16(o0[2], o0[3]); w.z = cvt_pk_bf16(o1[0], o1[1]); w.w = cvt_pk_bf16(o1[2], o1[3]); *(u32x4*)(xb + off + bj * HALF) = w; } } \
            ss += __shfl_xor(ss, 16); ss += __shfl_xor(ss, 32); \
            if (fq == 0) xch[(ai * HALF + wr * 64 + m * 16 + fr) * 4 + wc] = ss; } while (0)
        if (mode != 0) {
            u32x4 xo[8][2];
#pragma unroll
            for (int it = 0; it < 8; ++it)
#pragma unroll
                for (int bj = 0; bj < 2; ++bj) xo[it][bj] = *(const u32x4*)(xb + off0 + (size_t)((it >> 2) * HALF + (it & 3) * 16) * D + bj * HALF);
            asm volatile("" ::: "memory");
#pragma unroll
            for (int it = 0; it < 8; ++it) {
                f32x4 c0[2], c1[2];
#pragma unroll
                for (int bj = 0; bj < 2; ++bj) { const u32x4 w_ = xo[it][bj]; c0[bj] = (f32x4){bflo(w_[0]), bfhi(w_[0]), bflo(w_[1]), bfhi(w_[1])}; c1[bj] = (f32x4){bflo(w_[2]), bfhi(w_[2]), bflo(w_[3]), bfhi(w_[3])}; }
                EPIRES_BODY(it, c0, c1);
            }
        } else {
#pragma unroll
            for (int h = 0; h < 2; ++h) {
                f32x4 xf0[4][2], xf1[4][2];
#pragma unroll
                for (int q = 0; q < 4; ++q)
#pragma unroll
                    for (int bj = 0; bj < 2; ++bj) { const float* p = xin + off0 + (size_t)(h * HALF + q * 16) * D + bj * HALF; xf0[q][bj] = *(const f32x4*)p; xf1[q][bj] = *(const f32x4*)(p + 4); }
                asm volatile("" ::: "memory");
#pragma unroll
                for (int q = 0; q < 4; ++q) EPIRES_BODY(h * 4 + q, xf0[q], xf1[q]);
                asm volatile("" ::: "memory");
            }
        }
#undef EPIRES_BODY
        asm volatile("s_waitcnt lgkmcnt(0)" ::: "memory"); __builtin_amdgcn_s_barrier(); asm volatile("" ::: "memory");
        if (tid < 256) { const f32x4 v = *(const LAS f32x4*)(xch + tid * 4); rowsq[(size_t)(u.row0 + tid) * 4 + pn] = (v[0] + v[1]) + (v[2] + v[3]); }
    }
};

template <class Epi>
__device__ __forceinline__ void gemm_phase(LAS unsigned char* lds, const Gemm g, const Order& S, const Epi& E, const unsigned stag = 0u) {
    int tid_ = threadIdx.x; asm volatile("" : "+v"(tid_));
    const int tid = tid_, wid = __builtin_amdgcn_readfirstlane(tid >> 6), lane = tid & 63, wr = wid >> 2, wc = wid & 3, fr = lane & 15, fq = lane >> 4;
    const int K = g.K, nt = K / BK;
    unsigned voffA[2], voffB[2];
#pragma unroll
    for (int i = 0; i < 2; ++i) { int R, C; stage_rc(tid * 16 + i * 8192, R, C); const int Rb = Epi::WIDE ? (64 * (R >> 5) + perm32(R & 31)) : (Epi::PERM ? ((R & ~31) + perm32(R & 31)) : R);
        voffA[i] = (unsigned)(R * g.lda + C) * 2u; voffB[i] = (unsigned)(Rb * g.ldb + C) * 2u; }
    const size_t kstep = (size_t)(BK * 2);
    const size_t hstepA = (size_t)HALF * g.lda * 2, hstepB = (size_t)(Epi::WIDE ? 32 : HALF) * g.ldb * 2;
    const unsigned ldsw = (unsigned)wid * 1024u;
    const int aoff = lds_byte(wr * 64 + fr, fq * 8), boff = lds_byte(wc * 32 + fr, fq * 8);
#define PG8_SA(b, h) (((b) * 2 + (h)) * HTB)
#define PG8_SB(b, h) ((4 + (b) * 2 + (h)) * HTB)
#define PG8_STAGE(bufoff, gbase, voff) do { _Pragma("unroll") for (int _i = 0; _i < 2; ++_i) \
        __builtin_amdgcn_global_load_lds((const unsigned*)((const char*)(gbase) + (voff)[_i]), (LAS unsigned*)(lds + (bufoff) + ldsw + _i * 8192), 16, 0, 0); } while (0)
#define PG8_LDA(dst, b, h) do { _Pragma("unroll") for (int m = 0; m < 4; ++m) _Pragma("unroll") for (int k = 0; k < 2; ++k) dst[m][k] = *(const LAS bf16x8*)(lds + PG8_SA(b, h) + aoff + m * 2048 + k * 1024); } while (0)
#define PG8_LDB(dst, b, h) do { _Pragma("unroll") for (int n = 0; n < 2; ++n) _Pragma("unroll") for (int k = 0; k < 2; ++k) dst[n][k] = *(const LAS bf16x8*)(lds + PG8_SB(b, h) + boff + n * 2048 + k * 1024); } while (0)
#define PG8_MMA(ai, bj, At, Bt) do { __builtin_amdgcn_s_setprio(1); _Pragma("unroll") for (int m = 0; m < 4; ++m) _Pragma("unroll") for (int n = 0; n < 2; ++n) _Pragma("unroll") for (int k = 0; k < 2; ++k) \
        acc[ai][bj][m][n] = __builtin_amdgcn_mfma_f32_16x16x32_bf16(Bt[n][k], At[m][k], acc[ai][bj][m][n], 0, 0, 0); __builtin_amdgcn_s_setprio(0); } while (0)
#define PG8_WAIT_V(n) asm volatile("s_waitcnt vmcnt(" #n ")" ::: "memory")
#define PG8_WAIT_L(n) asm volatile("s_waitcnt lgkmcnt(" #n ")" ::: "memory")
#define PG8_BAR __builtin_amdgcn_s_barrier()
#define PG8_SCHED __builtin_amdgcn_sched_barrier(0)
    Unit cur, nxt; int ui = 0;
    if (!S.next(0, cur)) return;
    if (stag) {
        const unsigned long long t0 = __builtin_amdgcn_s_memrealtime(), dl = (unsigned long long)(((unsigned)cur.col0 >> 8) & 3u) * stag;
        while (__builtin_amdgcn_s_memrealtime() - t0 < dl) __builtin_amdgcn_s_sleep(8);
    }
    f32x4 acc[2][2][4][2];
#pragma unroll
    for (int a = 0; a < 2; ++a)
#pragma unroll
        for (int b = 0; b < 2; ++b)
#pragma unroll
            for (int m = 0; m < 4; ++m)
#pragma unroll
                for (int n = 0; n < 2; ++n) acc[a][b][m][n] = (f32x4){0.f, 0.f, 0.f, 0.f};
    E.prefill(lds, S, tid);
    bf16x8 At[4][2], B0[2][2], B1[2][2];
    const char* cA = (const char*)g.A + cur.aoff; const char* cB = (const char*)g.Bt + cur.boff;
    PG8_STAGE(PG8_SB(0, 0), cB, voffB); PG8_STAGE(PG8_SB(0, 1), cB + hstepB, voffB); PG8_STAGE(PG8_SA(0, 0), cA, voffA); PG8_STAGE(PG8_SA(0, 1), cA + hstepA, voffA);
    if (wr == 1) PG8_BAR;
    PG8_WAIT_V(2); PG8_BAR;
    PG8_STAGE(PG8_SB(1, 0), cB + kstep, voffB); PG8_STAGE(PG8_SA(1, 0), cA + kstep, voffA); PG8_STAGE(PG8_SB(1, 1), cB + hstepB + kstep, voffB);
    PG8_WAIT_V(6); PG8_BAR;
    for (;;) {
        const bool has_next = S.next(ui + 1, nxt);
        const char* nA = has_next ? (const char*)g.A + nxt.aoff : cA; const char* nB = has_next ? (const char*)g.Bt + nxt.boff : cB;
        for (int t = 0; t < nt; t += 2) {
            const bool last = (t == nt - 2);
            const char* a1 = cA + (size_t)(t + 1) * kstep;
            const char* a2 = last ? nA : cA + (size_t)(t + 2) * kstep; const char* b2 = last ? nB : cB + (size_t)(t + 2) * kstep;
            const char* a3 = a2 + kstep; const char* b3 = b2 + kstep;
            PG8_LDB(B0, 0, 0); PG8_LDB(B1, 0, 1); PG8_SCHED; PG8_LDA(At, 0, 0); PG8_STAGE(PG8_SA(1, 1), a1 + hstepA, voffA);
            PG8_WAIT_V(8); PG8_WAIT_L(0); PG8_BAR; PG8_MMA(0, 0, At, B0); PG8_MMA(0, 1, At, B1); PG8_BAR; PG8_SCHED;
            PG8_LDA(At, 0, 1); PG8_STAGE(PG8_SB(0, 0), b2, voffB); PG8_STAGE(PG8_SB(0, 1), b2 + hstepB, voffB); PG8_STAGE(PG8_SA(0, 0), a2, voffA);
            PG8_WAIT_V(8); PG8_WAIT_L(0); PG8_BAR; PG8_MMA(1, 0, At, B0); PG8_MMA(1, 1, At, B1); PG8_BAR; PG8_SCHED;
            PG8_LDB(B0, 1, 0); PG8_LDB(B1, 1, 1); PG8_SCHED; PG8_LDA(At, 1, 0); PG8_STAGE(PG8_SA(0, 1), a2 + hstepA, voffA);
            PG8_WAIT_V(8); PG8_WAIT_L(0); PG8_BAR; PG8_MMA(0, 0, At, B0); PG8_MMA(0, 1, At, B1); PG8_BAR; PG8_SCHED;
            PG8_LDA(At, 1, 1); PG8_STAGE(PG8_SB(1, 0), b3, voffB); PG8_STAGE(PG8_SB(1, 1), b3 + hstepB, voffB); PG8_STAGE(PG8_SA(1, 0), a3, voffA);
            PG8_WAIT_V(8); PG8_WAIT_L(0); PG8_BAR; PG8_MMA(1, 0, At, B0); PG8_MMA(1, 1, At, B1); PG8_BAR; PG8_SCHED;
        }
        if (wr == 0) PG8_BAR;
        E(acc, cur, wr, wc, fr, fq, lds, tid, ui);
        if (!has_next) break;
#pragma unroll
        for (int a = 0; a < 2; ++a)
#pragma unroll
            for (int b = 0; b < 2; ++b)
#pragma unroll
                for (int m = 0; m < 4; ++m)
#pragma unroll
                    for (int n = 0; n < 2; ++n) acc[a][b][m][n] = (f32x4){0.f, 0.f, 0.f, 0.f};
        cur = nxt; cA = nA; cB = nB; ++ui;
        if (wr == 1) PG8_BAR;
    }
    PG8_WAIT_V(0);
    PG8_BAR;
#undef PG8_SA
#undef PG8_SB
#undef PG8_STAGE
#undef PG8_LDA
#undef PG8_LDB
#undef PG8_MMA
#undef PG8_WAIT_V
#undef PG8_WAIT_L
#undef PG8_BAR
#undef PG8_SCHED
}
}


#define XB_TMO      128
#define XB_XCNT(j)  (256  + 64 * (j))
#define XB_XSUB(j)  (1280 + 64 * (j))
#define XB_XGEN(j)  (2304 + 64 * (j))
#define XB_TOP      3328
#define XB_TOPGEN   3392
#define XCD_BAR_WORDS 3456
#define XB_SPIN_CAP (1u << 22)
__device__ __forceinline__ unsigned xb_ld(unsigned* p)              { return __hip_atomic_load(p, __ATOMIC_RELAXED, __HIP_MEMORY_SCOPE_AGENT); }
__device__ __forceinline__ unsigned xb_add(unsigned* p, unsigned v) { return __hip_atomic_fetch_add(p, v, __ATOMIC_RELAXED, __HIP_MEMORY_SCOPE_AGENT); }
__device__ __forceinline__ unsigned xb_xcc_id() { return (unsigned)__builtin_amdgcn_s_getreg((3 << 11) | 20) & 0xFu; }
#define XB_SPIN(cond, bar) do { unsigned _sp = 0; while (cond) { __builtin_amdgcn_s_sleep(1); \
    if ((++_sp & 255u) == 0u) { if (xb_ld(&(bar)[XB_TMO])) break; if (_sp > XB_SPIN_CAP) { atomicAdd(&(bar)[XB_TMO], 1u); break; } } } } while (0)
struct XcdBarrier { unsigned* bar; unsigned x; volatile LAS unsigned* st; };
__device__ __forceinline__ XcdBarrier xcd_barrier_post(unsigned* bar, volatile LAS unsigned* st) {
    XcdBarrier b; b.bar = bar; b.x = xb_xcc_id(); b.st = st;
    if (threadIdx.x == 0) (void)xb_add(&bar[XB_XCNT(b.x)], 1u);
    return b;
}
__device__ __forceinline__ void xcd_barrier_complete(unsigned* bar, unsigned x, unsigned& nloc, unsigned& nx) {
    const unsigned G = gridDim.x * gridDim.y * gridDim.z;
    unsigned sum, cnt, mine, sp = 0u;
    for (;;) {
        sum = 0u; cnt = 0u; mine = 0u;
#pragma unroll
        for (unsigned j = 0; j < 16; ++j) { const unsigned c = xb_ld(&bar[XB_XCNT(j)]); sum += c; cnt += (c > 0u) ? 1u : 0u; mine = (j == x) ? c : mine; }
        if (sum == G) break;
        __builtin_amdgcn_s_sleep(1);
        if ((++sp & 255u) == 0u) { if (xb_ld(&bar[XB_TMO])) break; if (sp > XB_SPIN_CAP) { atomicAdd(&bar[XB_TMO], 1u); break; } }
    }
    nloc = mine > 0u ? mine : 1u; nx = cnt > 0u ? cnt : 1u;
}
__device__ __forceinline__ void xcd_barrier(const XcdBarrier& b) {
    asm volatile("s_waitcnt vmcnt(0)" ::: "memory");
    __syncthreads();
    if (threadIdx.x == 0) {
        unsigned* bar = b.bar;
        __builtin_amdgcn_s_waitcnt(0);
        unsigned nloc = b.st[0], nx = b.st[1];
        if (nloc == 0u) { xcd_barrier_complete(bar, b.x, nloc, nx); b.st[0] = nloc; b.st[1] = nx; }
        const unsigned old = xb_add(&bar[XB_XSUB(b.x)], 1u);
        const unsigned gen = old / nloc;
        if (old + 1u == (gen + 1u) * nloc) {
            __builtin_amdgcn_fence(__ATOMIC_RELEASE, "agent");
            asm volatile("s_waitcnt vmcnt(0)" ::: "memory");
            const unsigned og = xb_add(&bar[XB_TOP], 1u);
            const unsigned tg = og / nx;
            if (og + 1u == (tg + 1u) * nx) xb_add(&bar[XB_TOPGEN], 1u);
            else XB_SPIN(xb_ld(&bar[XB_TOPGEN]) == tg, bar);
            __builtin_amdgcn_fence(__ATOMIC_ACQUIRE, "agent");
            xb_add(&bar[XB_XGEN(b.x)], 1u);
            asm volatile("s_waitcnt vmcnt(0)" ::: "memory");
        } else {
            XB_SPIN(xb_ld(&bar[XB_XGEN(b.x)]) == gen, bar);
            __builtin_amdgcn_fence(__ATOMIC_ACQUIRE, "agent");
            asm volatile("s_waitcnt vmcnt(0)" ::: "memory");
        }
    }
    __syncthreads();
}

struct Frame { LAS unsigned char* lds; int G, bid; };
#define OPAQUE_TID() int tid_ = threadIdx.x; asm volatile("" : "+v"(tid_)); const int tid = tid_, lane = tid & 63, wave = __builtin_amdgcn_readfirstlane(tid >> 6); (void)lane; (void)wave
__device__ __forceinline__ float wave_sum(float v) {
#pragma unroll
    for (int o = 1; o < 64; o <<= 1) v += __shfl_xor(v, o);
    return v;
}
#define LDS_WAIT() asm volatile("s_waitcnt lgkmcnt(0)" ::: "memory")

__device__ __forceinline__ void transpose_item(const float* W, int K, int N, bf16_t* WT, int ldt, const float* kscale, const float* nscale, bool glu, LAS float* scr, int item, int lane) {
    const int nblk = N / 32, kb = item / nblk, nb = item % nblk, k0 = 64 * kb, n0 = 32 * nb;
    const int n4 = (lane & 7) * 4, kr = lane >> 3;
    const f32x4 ns = nscale ? *(const f32x4*)(nscale + n0 + n4) : (f32x4){1.f, 1.f, 1.f, 1.f};
    f32x4 v[8];
#pragma unroll
    for (int i = 0; i < 8; ++i) v[i] = *(const f32x4*)(W + (size_t)(k0 + kr + 8 * i) * N + n0 + n4);
#pragma unroll
    for (int i = 0; i < 8; ++i) { const int kk = kr + 8 * i; const float ks = kscale ? kscale[k0 + kk] : 1.0f; const f32x4 t = v[i] * ns * ks;
        LAS float* d = scr + kk * 33 + n4; d[0] = t[0]; d[1] = t[1]; d[2] = t[2]; d[3] = t[3]; }
    LDS_WAIT(); asm volatile("" ::: "memory");
    int r0 = n0; if (glu) { const int c = n0 & 1023, gate = n0 >> 10; r0 = (c >> 7) * 256 + gate * 128 + (c & 127); }
    const int c = lane & 7;
#pragma unroll
    for (int j = 0; j < 4; ++j) { const int n = (lane >> 3) + 8 * j; const LAS float* s = scr + (8 * c) * 33 + n;
        u32x4 o; o.x = cvt_pk_bf16(s[0 * 33], s[1 * 33]); o.y = cvt_pk_bf16(s[2 * 33], s[3 * 33]); o.z = cvt_pk_bf16(s[4 * 33], s[5 * 33]); o.w = cvt_pk_bf16(s[6 * 33], s[7 * 33]);
        *(u32x4*)(WT + (size_t)(r0 + n) * ldt + k0 + 8 * c) = o; }
    LDS_WAIT(); asm volatile("" ::: "memory");
}

struct Args { const float* in[34]; float* out; unsigned char* ws; };

__device__ __forceinline__ void prep_phase(const Frame& F, const Args& a) {
    OPAQUE_TID();
    unsigned char* ws = a.ws;
    LAS float* scr = (LAS float*)(F.lds + wave * 16384);
    const int gw = F.bid * 8 + wave, NGW = F.G * 8;
    constexpr int I_SQ = (D / 64) * (D / 32), I_UP = (D / 64) * (FF / 32), I_DN = (FF / 64) * (D / 32), I_GRP = 4 * (256 / 64) * (256 / 32), I_CIN = (D / 64) * (2 * D / 32);
    constexpr int I_MLP = I_UP + I_DN;
    constexpr int I_POOL = I_SQ + I_GRP + I_MLP, I_CONV = I_CIN + I_SQ + I_MLP, I_FOUR = 2 * I_SQ + I_MLP;
    constexpr int NITEMS = 2 * I_POOL + I_CONV + I_FOUR;
#define JOB(W, K_, N_, DST, LDT, KS, NS, GLU) if (r < ((K_) / 64) * ((N_) / 32)) { transpose_item((W), (K_), (N_), (bf16_t*)(DST), (LDT), (KS), (NS), (GLU), scr, r, lane); continue; } r -= ((K_) / 64) * ((N_) / 32);
#define JOB_MLP(L, i0) JOB(a.in[(i0) + 1], D, FF, ws + WS_WUP + (L) * 16 * MiB, D, a.in[(i0)], nullptr, false) \
                       JOB(a.in[(i0) + 2], FF, D, ws + WS_WDN + (L) * 16 * MiB, FF, nullptr, nullptr, false)
#define JOB_POOL(L, i0) if (r < I_GRP) { const int g = r / (I_GRP / 4); transpose_item(a.in[(i0) + 2] + g * 65536, 256, 256, (bf16_t*)(ws + WS_MIXB + (L) * 3 * MiB) + g * 65536, 256, nullptr, a.in[(i0) + 3] + g * 256, false, scr, r % (I_GRP / 4), lane); continue; } r -= I_GRP; \
                        JOB(a.in[(i0) + 4], D, D, ws + WS_MIXB + (L) * 3 * MiB + MiB, D, nullptr, nullptr, false) \
                        JOB_MLP(L, (i0) + 5)
    for (int it = gw; it < NITEMS; it += NGW) {
        int r = it;
        JOB_POOL(0, 1)
        JOB(a.in[10], D, 2 * D, ws + WS_MIX + 1 * 5 * MiB, D, a.in[9], nullptr, true)
        JOB(a.in[15], D, D, ws + WS_MIXB + 1 * 3 * MiB + MiB, D, nullptr, nullptr, false)
        JOB_MLP(1, 16)
        JOB(a.in[20], D, D, ws + WS_MIX + 2 * 5 * MiB, D, a.in[19], nullptr, false)
        JOB(a.in[21], D, D, ws + WS_MIXB + 2 * 3 * MiB + MiB, D, nullptr, nullptr, false)
        JOB_MLP(2, 22)
        JOB_POOL(3, 25)
    }
#undef JOB
#undef JOB_MLP
#undef JOB_POOL
    {
        const float* x = a.in[0]; bf16_t* XB = (bf16_t*)(ws + WS_XB); float* rowsq = (float*)(ws + WS_ROWSQ);
        for (int m = gw; m < M; m += 2 * NGW) {
            const int m2 = (m + NGW < M) ? m + NGW : m;
            const f32x4* xr = (const f32x4*)(x + (size_t)m * D) + lane; const f32x4* xr2 = (const f32x4*)(x + (size_t)m2 * D) + lane; f32x4 v[4], v2[4]; float s = 0.f, s2 = 0.f;
#pragma unroll
            for (int j = 0; j < 4; ++j) { v[j] = xr[64 * j]; v2[j] = xr2[64 * j]; }
#pragma unroll
            for (int j = 0; j < 4; ++j) { s += (v[j][0] * v[j][0] + v[j][1] * v[j][1]) + (v[j][2] * v[j][2] + v[j][3] * v[j][3]); s2 += (v2[j][0] * v2[j][0] + v2[j][1] * v2[j][1]) + (v2[j][2] * v2[j][2] + v2[j][3] * v2[j][3]); }
            s = wave_sum(s); s2 = wave_sum(s2);
            u32x2* o8 = (u32x2*)(XB + (size_t)m * D) + lane; u32x2* o82 = (u32x2*)(XB + (size_t)m2 * D) + lane;
#pragma unroll
            for (int j = 0; j < 4; ++j) { u32x2 w; w.x = cvt_pk_bf16(v[j][0], v[j][1]); w.y = cvt_pk_bf16(v[j][2], v[j][3]); o8[64 * j] = w;
                                          u32x2 w2; w2.x = cvt_pk_bf16(v2[j][0], v2[j][1]); w2.y = cvt_pk_bf16(v2[j][2], v2[j][3]); o82[64 * j] = w2; }
            if (lane < 4) { rowsq[(size_t)m * 4 + lane] = (lane == 0) ? s : 0.f; rowsq[(size_t)m2 * 4 + lane] = (lane == 0) ? s2 : 0.f; }
        }
    }
    {
        const int gt = F.bid * 512 + tid, GT = F.G * 512;
        for (int it = gt; it < 2 * D * D / 8; it += GT) {
            const int l3 = it >> 17, e0 = (it & 131071) * 8, k = e0 >> 10;
            const float* W = l3 ? a.in[26] : a.in[2]; const float gk = (l3 ? a.in[25] : a.in[1])[k];
            const f32x4 v0 = *(const f32x4*)(W + e0), v1 = *(const f32x4*)(W + e0 + 4);
            u32x4 w; w.x = cvt_pk_bf16(v0[0] * gk, v0[1] * gk); w.y = cvt_pk_bf16(v0[2] * gk, v0[3] * gk); w.z = cvt_pk_bf16(v1[0] * gk, v1[1] * gk); w.w = cvt_pk_bf16(v1[2] * gk, v1[3] * gk);
            *(u32x4*)((bf16_t*)(ws + WS_MIX + (l3 ? 15 : 0) * MiB + 2 * MiB) + e0) = w;
        }
        bf16_t* Dcs = (bf16_t*)(ws + WS_DCS); bf16_t* T = (bf16_t*)(ws + WS_T);
        for (int it = gt; it < 2 * 256 * 256 / 8; it += GT) {
            const int e0 = it * 8, cs = e0 >> 16, j = (e0 >> 8) & 255, c0 = e0 & 255; float v[8];
#pragma unroll
            for (int k = 0; k < 8; ++k) { const float xx = (float)((j * (c0 + k)) & 255) * (1.0f / 128.0f); v[k] = (cs ? sinpif(xx) : cospif(xx)) * 0.0625f; }
            u32x4 w; w.x = cvt_pk_bf16(v[0], v[1]); w.y = cvt_pk_bf16(v[2], v[3]); w.z = cvt_pk_bf16(v[4], v[5]); w.w = cvt_pk_bf16(v[6], v[7]);
            *(u32x4*)(Dcs + e0) = w;
        }
        for (int it = gt; it < 2048 * KF / 8; it += GT) {
            const int e0 = it * 8, p = e0 / KF, q = e0 % KF; float v[8];
#pragma unroll
            for (int k = 0; k < 8; ++k) { const int kk = q + k, cs = kk >= KFE, sidx = cs ? kk - KFE : kk; const float xx = (float)((p * sidx) & 2047) * (1.0f / 1024.0f);
                v[k] = (cs ? -sinpif(xx) : (kk <= 1024 ? cospif(xx) : 0.0f)) * 0.03125f; }
            u32x4 w; w.x = cvt_pk_bf16(v[0], v[1]); w.y = cvt_pk_bf16(v[2], v[3]); w.z = cvt_pk_bf16(v[4], v[5]); w.w = cvt_pk_bf16(v[6], v[7]);
            *(u32x4*)(T + e0) = w;
        }
    }
}

__device__ __forceinline__ void fourier_fold_phase(const Frame& F, const bf16_t* __restrict__ U, bf16_t* __restrict__ FFo) {
    OPAQUE_TID();
    const int gt = F.bid * 512 + tid, GT = F.G * 512;
#pragma unroll 4
    for (int it = gt; it < NB * KF * 128; it += GT) {
        const int ch = it & 127, r = (it >> 7) % KF, b = (it >> 7) / KF;
        const bool sinp = r >= KFE; const int s = sinp ? r - KFE : r;
        const bf16_t* ub = U + (size_t)b * S * D + ch * 8;
        u32x4 o = (u32x4){0u, 0u, 0u, 0u};
        if (s <= 1024 && !(sinp && s == 0) && !(sinp && s == 1024)) {
            const u32x4 a = *(const u32x4*)(ub + (size_t)s * D);
            if (s == 0 || s == 1024) o = a;
            else { const u32x4 c = *(const u32x4*)(ub + (size_t)(S - s) * D); const float sg = sinp ? -1.0f : 1.0f;
#pragma unroll
                for (int k = 0; k < 4; ++k) o[k] = cvt_pk_bf16(bflo(a[k]) + sg * bflo(c[k]), bfhi(a[k]) + sg * bfhi(c[k])); }
        }
        *(u32x4*)(FFo + ((size_t)b * KF + r) * D + ch * 8) = o;
    }
}

template <int HW>
__device__ __forceinline__ void pool_item(const bf16_t* U, bf16_t* P, int b, int seg, int g, int lane) {
    const int s0 = seg * 16;
    const bf16_t* base = U + (size_t)b * S * D + g * 256 + lane * 4;
    u32x2 r[16 + 2 * HW];
#pragma unroll
    for (int i = 0; i < 16 + 2 * HW; ++i) { const int t = s0 - HW + i; r[i] = (u32x2){0u, 0u}; if (t >= 0 && t < S) r[i] = *(const u32x2*)(base + (size_t)t * D); }
    float sum[4] = {0.f, 0.f, 0.f, 0.f};
#pragma unroll
    for (int i = 0; i < 2 * HW; ++i) { sum[0] += bflo(r[i][0]); sum[1] += bfhi(r[i][0]); sum[2] += bflo(r[i][1]); sum[3] += bfhi(r[i][1]); }
    bf16_t* ob = P + (size_t)(b * S + s0) * D + g * 256 + lane * 4;
#pragma unroll
    for (int o = 0; o < 16; ++o) {
        const int s = s0 + o, lo = (s - HW) > 0 ? (s - HW) : 0, hi = (s + HW) < S ? (s + HW) : S;
        const float inv = 1.0f / (float)(hi - lo);
        const u32x2 c = r[o + HW];
        u32x2 w; w.x = cvt_pk_bf16(sum[0] * inv - bflo(c[0]), sum[1] * inv - bfhi(c[0])); w.y = cvt_pk_bf16(sum[2] * inv - bflo(c[1]), sum[3] * inv - bfhi(c[1]));
        *(u32x2*)(ob + (size_t)o * D) = w;
        if (o < 15) { const u32x2 a = r[o + 2 * HW], d = r[o];
            sum[0] += bflo(a[0]) - bflo(d[0]); sum[1] += bfhi(a[0]) - bfhi(d[0]); sum[2] += bflo(a[1]) - bflo(d[1]); sum[3] += bfhi(a[1]) - bfhi(d[1]); }
    }
}
__device__ __forceinline__ void pool_phase(const Frame& F, const bf16_t* U, bf16_t* P) {
    OPAQUE_TID();
    const int gw = F.bid * 8 + wave, NGW = F.G * 8;
    for (int it = gw; it < NB * (S / 16) * 4; it += NGW) {
        const int g = it & 3, seg = (it >> 2) & (S / 16 - 1), b = it >> 9;
        if (g == 0) pool_item<1>(U, P, b, seg, 0, lane);
        else if (g == 1) pool_item<2>(U, P, b, seg, 1, lane);
        else if (g == 2) pool_item<4>(U, P, b, seg, 2, lane);
        else pool_item<8>(U, P, b, seg, 3, lane);
    }
}

__device__ __forceinline__ void conv_dma_rows(LAS unsigned char* tl, const bf16_t* V, int p0, int sbase, int ra, int nrows, int wave, int lane) {
    for (int c = wave; c < 2 * nrows; c += 8) {
        const int r = ra + (c >> 1), t = sbase - 15 + r;
        LAS unsigned char* dst = tl + (r & 63) * (D * 2) + (c & 1) * 1024;
        if (t >= 0 && t < S) __builtin_amdgcn_global_load_lds((const unsigned*)((const char*)V + ((long)(p0 - 15 + r)) * (D * 2) + (c & 1) * 1024 + lane * 16), (LAS unsigned*)dst, 16, 0, 0);
        else *(LAS u32x4*)(dst + lane * 16) = (u32x4){0u, 0u, 0u, 0u};
    }
}
__device__ __forceinline__ void conv_phase(const Frame& F, const bf16_t* V, bf16_t* Aout, const float* dw, const float* dwb, const float* lng, const float* lnb) {
    OPAQUE_TID();
    f32x2 wv[31];
    { const float* p = dw + 2 * tid;
#pragma unroll
      for (int j = 0; j < 31; ++j) { wv[j] = *(const f32x2*)p; p += D; if ((j & 3) == 3) asm volatile("" ::: "memory"); } }
    const f32x2 bb = *(const f32x2*)(dwb + 2 * tid), gg = *(const f32x2*)(lng + 2 * tid), lb = *(const f32x2*)(lnb + 2 * tid);
    LAS unsigned char* tl = F.lds;
    LAS float* part = (LAS float*)(F.lds + 131072 + 1024);
    LAS float* stat = (LAS float*)(F.lds + 131072 + 2048);
    for (int strip = F.bid; strip < M / 128; strip += F.G) {
        const int p0 = strip * 128, sbase = p0 & (S - 1);
        conv_dma_rows(tl, V, p0, sbase, 0, 46, wave, lane);
#pragma unroll 1
        for (int k = 0; k < 8; ++k) {
            asm volatile("s_waitcnt vmcnt(0) lgkmcnt(0)" ::: "memory");
            __syncthreads();
            if (k < 7) conv_dma_rows(tl, V, p0, sbase, 46 + 16 * k, 16, wave, lane);
#pragma unroll 1
            for (int h = 0; h < 2; ++h) {
                const int rb = 16 * k + 8 * h;
                const LAS unsigned char* tlt = tl + tid * 4;
                f32x2 av[8];
#pragma unroll
                for (int o = 0; o < 8; ++o) av[o] = bb;
#pragma unroll
                for (int tt = 0; tt < 38; ++tt) {
                    const unsigned w = *(const LAS unsigned*)(tlt + ((rb + tt) & 63) * (D * 2));
                    const f32x2 xv = (f32x2){bflo(w), bfhi(w)};
#pragma unroll
                    for (int o = 0; o < 8; ++o) { const int j = tt - o; if (j >= 0 && j <= 30) av[o] = __builtin_elementwise_fma(xv, wv[j], av[o]); }
                    if ((tt & 7) == 7) asm volatile("" ::: "memory");
                }
                float vals[16];
#pragma unroll
                for (int o = 0; o < 8; ++o) { vals[o] = av[o][0] + av[o][1]; vals[8 + o] = av[o][0] * av[o][0] + av[o][1] * av[o][1]; }
#pragma unroll
                for (int step = 0; step < 4; ++step) {
                    const int half = 8 >> step; const bool up = (lane >> step) & 1;
#pragma unroll
                    for (int i = 0; i < half; ++i) { const float keep = up ? vals[i + half] : vals[i], send = up ? vals[i] : vals[i + half]; vals[i] = keep + __shfl_xor(send, 1 << step); }
                }
                vals[0] += __shfl_xor(vals[0], 16); vals[0] += __shfl_xor(vals[0], 32);
                if (lane < 16) { const int l = lane; const int idx = ((l & 1) << 3) | ((l & 2) << 1) | ((l & 4) >> 1) | ((l & 8) >> 3); part[wave * 16 + idx] = vals[0]; }
                __syncthreads();
                if (tid < 8) { float s1 = 0.f, s2 = 0.f;
#pragma unroll
                    for (int w = 0; w < 8; ++w) { s1 += part[w * 16 + tid]; s2 += part[w * 16 + 8 + tid]; }
                    const float mean = s1 * (1.0f / D), var = s2 * (1.0f / D) - mean * mean;
                    stat[2 * tid] = mean; stat[2 * tid + 1] = __builtin_amdgcn_rsqf(fmaxf(var, 0.f) + LN_EPS); }
                __syncthreads();
                unsigned* op = (unsigned*)(Aout + (size_t)(p0 + rb) * D) + tid;
#pragma unroll
                for (int o = 0; o < 8; ++o) {
                    const float mean = stat[2 * o], rstd = stat[2 * o + 1];
                    const float y0 = (av[o][0] - mean) * rstd * gg[0] + lb[0], y1 = (av[o][1] - mean) * rstd * gg[1] + lb[1];
                    const float z0 = y0 * __builtin_amdgcn_rcpf(1.0f + __builtin_amdgcn_exp2f(-1.44269504089f * y0)), z1 = y1 * __builtin_amdgcn_rcpf(1.0f + __builtin_amdgcn_exp2f(-1.44269504089f * y1));
                    *op = cvt_pk_bf16(z0, z1); op += D / 2;
                    if ((o & 3) == 3) asm volatile("" ::: "memory");
                }
            }
        }
        __syncthreads();
    }
}

__device__ __forceinline__ void final_phase(const Frame& F, float* out, const bf16_t* xb, const float* rowsq, const float* g) {
    OPAQUE_TID();
    const int gw = F.bid * 8 + wave, NGW = F.G * 8;
    f32x4 gv[4];
#pragma unroll
    for (int j = 0; j < 4; ++j) gv[j] = ((const f32x4*)g)[lane + 64 * j];
    for (int m = gw; m < M; m += 2 * NGW) {
        const int m2 = m + NGW;
        const float q0 = lane < 4 ? rowsq[(size_t)m * 4 + lane] : 0.f, q1 = (m2 < M && lane < 4) ? rowsq[(size_t)m2 * 4 + lane] : 0.f;
        u32x2 a[4], b[4];
#pragma unroll
        for (int j = 0; j < 4; ++j) { a[j] = ((const u32x2*)(xb + (size_t)m * D))[lane + 64 * j]; b[j] = (m2 < M) ? ((const u32x2*)(xb + (size_t)m2 * D))[lane + 64 * j] : (u32x2){0u, 0u}; }
        const float r0 = __builtin_amdgcn_rsqf(wave_sum(q0) * (1.0f / D) + NORM_EPS), r1 = __builtin_amdgcn_rsqf(wave_sum(q1) * (1.0f / D) + NORM_EPS);
        f32x4* o0 = (f32x4*)(out + (size_t)m * D) + lane; f32x4* o1 = (f32x4*)(out + (size_t)m2 * D) + lane;
#pragma unroll
        for (int j = 0; j < 4; ++j) { const f32x4 v = (f32x4){bflo(a[j][0]), bfhi(a[j][0]), bflo(a[j][1]), bfhi(a[j][1])}; o0[64 * j] = v * r0 * gv[j]; }
        if (m2 < M) {
#pragma unroll
            for (int j = 0; j < 4; ++j) { const f32x4 v = (f32x4){bflo(b[j][0]), bfhi(b[j][0]), bflo(b[j][1]), bfhi(b[j][1])}; o1[64 * j] = v * r1 * gv[j]; } }
    }
}

__global__ void __launch_bounds__(512, 2) fwd_megakernel(Args args) {
    extern __shared__ __attribute__((aligned(16))) unsigned char lds_raw[];
    cg::grid_group grid = cg::this_grid();
    Frame F; F.lds = (LAS unsigned char*)lds_raw; F.G = gridDim.x; F.bid = blockIdx.x;
    unsigned char* ws = args.ws;
    float* X = args.out;
    bf16_t* XB = (bf16_t*)(ws + WS_XB); float* ROWSQ = (float*)(ws + WS_ROWSQ);
    bf16_t* ACT1 = (bf16_t*)(ws + WS_ACT1); bf16_t* ACT2 = (bf16_t*)(ws + WS_ACT2); bf16_t* YT = (bf16_t*)(ws + WS_YT); bf16_t* HB = (bf16_t*)(ws + WS_H);
    volatile LAS unsigned* bst = (volatile LAS unsigned*)(F.lds + 131072 + 512);
    if (threadIdx.x < 2) bst[threadIdx.x] = 0u;
    __syncthreads();
    const XcdBarrier xbar = xcd_barrier_post((unsigned*)ws, bst);
#define GSYNC() xcd_barrier(xbar)
#define RUN_GEMM(EPI, A_, B_, LDA, LDB, K_, MODE, MR, NC, APN, ...) RUN_GEMM_S(0u, EPI, A_, B_, LDA, LDB, K_, MODE, MR, NC, APN, __VA_ARGS__)
#define RUN_GEMM_S(STAG, EPI, A_, B_, LDA, LDB, K_, MODE, MR, NC, APN, ...) do { pg8::Gemm g_{(A_), (B_), (LDA), (LDB), (K_)}; pg8::Order S_; S_.init((MODE), (MR), (NC), F.G, F.bid, (LDA), (LDB), (APN)); \
        EPI E_{__VA_ARGS__}; pg8::gemm_phase<EPI>(F.lds, g_, S_, E_, STAG); } while (0)

    if (args.ws == nullptr) grid.sync();
    prep_phase(F, args);
    GSYNC();
    RUN_GEMM(pg8::EpiBf16<0>, (const bf16_t*)(ws + WS_MIXB), (const bf16_t*)(ws + WS_MIX + 2 * MiB), 256, D, 256, 3, 32 * 256, 256, 0, (bf16_t*)(ws + WS_MIX), D, nullptr, 1.0f);
    GSYNC();
#pragma unroll 1
    for (int l = 0; l < 4; ++l) {
        const bf16_t* Win = (const bf16_t*)(ws + WS_MIX + (size_t)l * 5 * MiB);
        const bf16_t* Wout = (const bf16_t*)(ws + WS_MIXB + (size_t)l * 3 * MiB + MiB);
        if (l == 0 || l == 3) {
            RUN_GEMM(pg8::EpiBf16<0>, XB, Win, D, D, D, 0, M, D, 0, ACT1, D, ROWSQ, 1.0f);
            GSYNC();
            pool_phase(F, ACT1, ACT2);
            GSYNC();
            RUN_GEMM(pg8::EpiRes, ACT2, Wout, D, D, D, 0, M, D, 0, (l == 0) ? 0 : 1, args.in[0], XB, X, ROWSQ);
            GSYNC();
        } else if (l == 1) {
            RUN_GEMM(pg8::EpiBf16<2>, XB, Win, D, D, D, 0, M, 2 * D, 0, ACT1, D, ROWSQ, 1.0f);
            GSYNC();
            conv_phase(F, ACT1, ACT2, args.in[11], args.in[12], args.in[13], args.in[14]);
            GSYNC();
            RUN_GEMM(pg8::EpiRes, ACT2, Wout, D, D, D, 0, M, D, 0, (l == 0) ? 0 : 1, args.in[0], XB, X, ROWSQ);
            GSYNC();
        } else {
            RUN_GEMM(pg8::EpiBf16<0>, XB, Win, D, D, D, 0, M, D, 0, ACT1, D, ROWSQ, 1.0f);
            GSYNC();
            fourier_fold_phase(F, ACT1, (bf16_t*)(ws + WS_FF));
            GSYNC();
            RUN_GEMM(pg8::EpiBf16<0>, (const bf16_t*)(ws + WS_DCS), (const bf16_t*)(ws + WS_FF), 256, D, 256, 1, 256 * 576, 256, 0, YT, KF, nullptr, 1.0f);
            GSYNC();
            RUN_GEMM(pg8::EpiBf16<0>, (const bf16_t*)(ws + WS_T), YT, KF, KF, KF, 2, 256 * 512, 256, 0, ACT2, D, nullptr, 0.70710678118f);
            GSYNC();
            RUN_GEMM(pg8::EpiRes, ACT2, Wout, D, D, D, 0, M, D, 0, (l == 0) ? 0 : 1, args.in[0], XB, X, ROWSQ);
            GSYNC();
        }
#pragma unroll 1
        for (int c_ = 0; c_ < 2; ++c_) {
            int c = c_; asm volatile("" : "+s"(c));
            const size_t r0 = (size_t)c * (M / 2);
            RUN_GEMM_S(0u, pg8::EpiBf16<1>, XB + r0 * D, (const bf16_t*)(ws + WS_WUP + (size_t)l * 16 * MiB), D, D, D, 0, M / 2, FF, 0, HB, FF, ROWSQ + r0 * 4, 1.0f);
            GSYNC();
            RUN_GEMM(pg8::EpiRes, HB, (const bf16_t*)(ws + WS_WDN + (size_t)l * 16 * MiB), FF, FF, FF, 0, M / 2, D, 0, 1, args.in[0], XB + r0 * D, X, ROWSQ + r0 * 4);
            GSYNC();
        }
    }
    final_phase(F, X, XB, ROWSQ, args.in[33]);
}

extern "C" void kernel_launch(void* const* d_in, const int* in_sizes, int n_in, void* d_out, int out_size, void* d_ws, size_t ws_size, hipStream_t stream) {
    static int grid = 0;
    if (grid == 0) {
        if (n_in != 34 || out_size != M * D || ws_size < WS_END) { fprintf(stderr, "kernel_launch: unexpected problem (n_in %d, out %d, ws %zu < %zu)\n", n_in, out_size, ws_size, (size_t)WS_END); grid = -1; return; }
        int dev = 0, cus = 0, per_cu = 0;
        if (hipGetDevice(&dev) != hipSuccess || hipDeviceGetAttribute(&cus, hipDeviceAttributeMultiprocessorCount, dev) != hipSuccess) { grid = -1; return; }
        if (hipFuncSetAttribute((const void*)fwd_megakernel, hipFuncAttributeMaxDynamicSharedMemorySize, LDS_BYTES) != hipSuccess) { fprintf(stderr, "hipFuncSetAttribute failed\n"); grid = -1; return; }
        if (hipOccupancyMaxActiveBlocksPerMultiprocessor(&per_cu, (const void*)fwd_megakernel, 512, LDS_BYTES) != hipSuccess || per_cu < 1) { fprintf(stderr, "occupancy query: %d\n", per_cu); }
        (void)hipGetLastError();
        grid = cus;
    }
    if (grid < 0) return;
    if (hipMemsetAsync(d_ws, 0, 16384, stream) != hipSuccess) { fprintf(stderr, "kernel_launch: memset failed\n"); return; }
    Args a{};
    for (int i = 0; i < 34; ++i) a.in[i] = (const float*)d_in[i];
    a.out = (float*)d_out; a.ws = (unsigned char*)d_ws;
    void* kargs[] = {&a};
    hipError_t e = hipLaunchCooperativeKernel((const void*)fwd_megakernel, dim3(grid), dim3(512), kargs, LDS_BYTES, stream);
    if (e != hipSuccess) fprintf(stderr, "cooperative launch failed: %s (grid %d)\n", hipGetErrorString(e), grid);
}
```
